# Optimizing an MI355X kernel written in HIP

```python
import jax, jax.numpy as jnp
from jax import lax
import numpy as np

D_MODEL = 2048
BATCH = 4
SEQ = 4096
DEPTH = 1

PLE_DIM = 256
EPS = 1e-6
NEG = -1e30
FORCE = 1e3
MAX_POS_OFFSET = 1024

M_WIDTH = D_MODEL // 2
M_HEADS = 4
M_HEAD_DIM = M_WIDTH // M_HEADS
M_CONV = 4
M_CHUNK = 64

N_WIDTH = D_MODEL - M_WIDTH
N_HEAD_DIM = 64
N_HEADS = N_WIDTH // N_HEAD_DIM
N_KV = 4
CMP_BLOCK = 32
CMP_STRIDE = 16
CMP_HIDDEN = 128
SEL_BLOCK = 64
N_SELECT = 16
WINDOW = 512
NSA_Q_BLOCK = 64
ROPE_THETA = 500000.0
ROT_DIM = N_HEAD_DIM // 4

D_MIX = M_WIDTH + N_WIDTH
KV_W = N_KV * N_HEAD_DIM
IN_SPLITS = (M_WIDTH,) * 5 + (M_HEADS, M_HEADS) + (N_WIDTH,) + (KV_W,) * 6 + (3 * N_HEADS, N_WIDTH)
D_IN = sum(IN_SPLITS)

kernel_name = "hybrid_mlstm_nsa_parallel_heads"


def rmsnorm(x, g):
    xf = x.astype(jnp.float32)
    y = xf * lax.rsqrt(jnp.mean(xf * xf, axis=-1, keepdims=True) + EPS)
    return (y * g.astype(jnp.float32)).astype(x.dtype)


def split_cols(h, sizes):
    cuts = [int(c) for c in np.cumsum(sizes)[:-1]]
    return jnp.split(h, cuts, axis=-1)


def heads(a, n):
    return a.reshape(a.shape[0], a.shape[1], n, -1)


def partial_rope(x, positions):
    half = ROT_DIM // 2
    inv = ROPE_THETA ** (-(jnp.arange(half, dtype=jnp.float32) * 2.0 / ROT_DIM))
    ang = positions.astype(jnp.float32)[..., None] * inv
    cos = jnp.cos(ang)[:, :, None, :]
    sin = jnp.sin(ang)[:, :, None, :]
    xr = x[..., :ROT_DIM].astype(jnp.float32)
    x1, x2 = xr[..., :half], xr[..., half:]
    rot = jnp.concatenate([x1 * cos - x2 * sin, x2 * cos + x1 * sin], axis=-1).astype(x.dtype)
    return jnp.concatenate([rot, x[..., ROT_DIM:]], axis=-1)


def causal_conv(a, w, b):
    S = a.shape[1]
    ap = jnp.pad(a, ((0, 0), (M_CONV - 1, 0), (0, 0)))
    y = b + w[M_CONV - 1] * a
    for j in range(M_CONV - 1):
        y = y + w[j] * ap[:, j:j + S]
    return y


def head_layernorm(h, g):
    mu = jnp.mean(h, axis=-1, keepdims=True)
    var = jnp.mean(jnp.square(h - mu), axis=-1, keepdims=True)
    y = (h - mu) * lax.rsqrt(var + EPS)
    return y.reshape(h.shape[0], h.shape[1], -1) * g.astype(jnp.float32)


def mlstm_chunk_step(carry, xs):
    C, n, m = carry
    q, k, v, ig, lf = xs
    L = q.shape[2]
    b = jnp.cumsum(lf, axis=-1)
    causal = jnp.tril(jnp.ones((L, L), dtype=bool))
    D = jnp.where(causal, b[..., :, None] - b[..., None, :] + ig[..., None, :], NEG)
    m_inter = b + m[..., None]
    m_t = jnp.maximum(m_inter, jnp.max(D, axis=-1))
    A = jnp.exp(D - m_t[..., None]) * jnp.einsum('bhtd,bhsd->bhts', q, k)
    inter = jnp.exp(m_inter - m_t)
    num = jnp.einsum('bhts,bhsd->bhtd', A, v) + inter[..., None] * jnp.einsum('bhtk,bhvk->bhtv', q, C)
    den = jnp.sum(A, axis=-1) + inter * jnp.einsum('bhtk,bhk->bht', q, n)
    h = num / jnp.maximum(jnp.abs(den), 1.0)[..., None]
    bL = b[..., -1]
    w_end = bL[..., None] - b + ig
    m_new = jnp.maximum(bL + m, jnp.max(w_end, axis=-1))
    w_s = jnp.exp(w_end - m_new[..., None])
    decay = jnp.exp(bL + m - m_new)
    C = decay[..., None, None] * C + jnp.einsum('bhs,bhsv,bhsk->bhvk', w_s, v, k)
    n = decay[..., None] * n + jnp.einsum('bhs,bhsk->bhk', w_s, k)
    return (C, n, m_new), h


def mlstm_mixer(q, k, v, ig, lf):
    B, S, H, dh = q.shape
    L = M_CHUNK
    NC = S // L

    def chunks(a):
        return a.reshape(B, NC, L, H, dh).transpose(1, 0, 3, 2, 4)

    def gchunks(a):
        return a.reshape(B, NC, L, H).transpose(1, 0, 3, 2)

    init = (jnp.zeros((B, H, dh, dh), jnp.float32), jnp.zeros((B, H, dh), jnp.float32),
            jnp.zeros((B, H), jnp.float32))
    _, hs = lax.scan(mlstm_chunk_step, init, (chunks(q), chunks(k), chunks(v), gchunks(ig), gchunks(lf)))
    return hs.transpose(1, 0, 3, 2, 4).reshape(B, S, H, dh)


def compress(a, pos, w1, w2):
    B, S, G, dh = a.shape
    R = CMP_BLOCK // CMP_STRIDE
    n16 = S // CMP_STRIDE
    nc = n16 - R + 1
    a16 = a.reshape(B, n16, CMP_STRIDE, G, dh)
    blocks = jnp.concatenate([a16[:, r:r + nc] for r in range(R)], axis=2)
    blocks = blocks + pos[None, None, :, None, :]
    flat = blocks.transpose(0, 1, 3, 2, 4).reshape(B, nc, G, CMP_BLOCK * dh)
    return jax.nn.gelu(flat @ w1) @ w2


def sel_overlap(nc, nsel):
    tok = np.arange(nc)[:, None] * CMP_STRIDE + np.arange(CMP_BLOCK)[None, :]
    onehot = (tok[..., None] // SEL_BLOCK) == np.arange(nsel)
    return jnp.asarray(onehot.mean(axis=1).astype(np.float32))


def nsa_mixer(q, kc, vc, ks, vs, kw, vw, gates, pos_k, pos_v, ck_w1, ck_w2, cv_w1, cv_w2):
    B, S, H, dh = q.shape
    G = kc.shape[2]
    J = H // G
    QB = NSA_Q_BLOCK
    NB = S // QB
    kcmp = compress(kc, pos_k, ck_w1, ck_w2)
    vcmp = compress(vc, pos_v, cv_w1, cv_w2)
    nc = kcmp.shape[1]
    c_end = jnp.arange(nc) * CMP_STRIDE + CMP_BLOCK - 1
    nsel = S // SEL_BLOCK
    n_top = min(N_SELECT, nsel)
    overlap = sel_overlap(nc, nsel)
    ksb = ks.reshape(B, nsel, SEL_BLOCK, G, dh).transpose(0, 3, 1, 2, 4)
    vsb = vs.reshape(B, nsel, SEL_BLOCK, G, dh).transpose(0, 3, 1, 2, 4)
    kw_pad = jnp.pad(kw, ((0, 0), (WINDOW, 0), (0, 0), (0, 0)))
    vw_pad = jnp.pad(vw, ((0, 0), (WINDOW, 0), (0, 0), (0, 0)))
    bi = jnp.arange(B)[:, None, None, None]
    gi = jnp.arange(G)[None, :, None, None]
    blk = jnp.arange(nsel)

    def block_fn(args):
        c, qc, gc = args
        t = c * QB + jnp.arange(QB)
        qg = qc.reshape(B, QB, G, J, dh).transpose(0, 2, 3, 1, 4)
        mask_c = c_end[None, :] <= t[:, None]
        s = jnp.einsum('bgjqd,bcgd->bgjqc', qg, kcmp).astype(jnp.float32)
        p_c = jax.nn.softmax(jnp.where(mask_c, s, NEG), axis=-1) * mask_c
        o_cmp = jnp.einsum('bgjqc,bcgd->bgjqd', p_c.astype(vcmp.dtype), vcmp)
        imp = jnp.einsum('bgjqc,cn->bgqn', p_c, overlap)
        cur = (t // SEL_BLOCK)[:, None]
        valid = blk[None, :] * SEL_BLOCK <= t[:, None]
        forced = (blk[None, :] == 0) | (blk[None, :] == cur) | (blk[None, :] == cur - 1)
        score = jnp.where(valid, imp + jnp.where(forced, FORCE, 0.0), NEG)
        _, idx = lax.top_k(score, n_top)
        kg = ksb[bi, gi, idx]
        vg = vsb[bi, gi, idx]
        kpos = idx[..., None] * SEL_BLOCK + jnp.arange(SEL_BLOCK)
        mask_s = (kpos <= t[:, None, None])[:, :, None]
        s = jnp.einsum('bgjqd,bgqnld->bgjqnl', qg, kg).astype(jnp.float32)
        s = jnp.where(mask_s, s, NEG).reshape(B, G, J, QB, n_top * SEL_BLOCK)
        p_s = jax.nn.softmax(s, axis=-1).reshape(B, G, J, QB, n_top, SEL_BLOCK)
        o_sel = jnp.einsum('bgjqnl,bgqnld->bgjqd', p_s.astype(vg.dtype), vg)
        kwc = lax.dynamic_slice_in_dim(kw_pad, c * QB, QB + WINDOW, axis=1)
        vwc = lax.dynamic_slice_in_dim(vw_pad, c * QB, QB + WINDOW, axis=1)
        kp = c * QB - WINDOW + jnp.arange(QB + WINDOW)
        mask_w = (kp[None, :] <= t[:, None]) & (kp[None, :] > t[:, None] - WINDOW) & (kp[None, :] >= 0)
        s = jnp.einsum('bgjqd,bkgd->bgjqk', qg, kwc).astype(jnp.float32)
        p_w = jax.nn.softmax(jnp.where(mask_w, s, NEG), axis=-1)
        o_win = jnp.einsum('bgjqk,bkgd->bgjqd', p_w.astype(vwc.dtype), vwc)
        g = gc.reshape(B, QB, G, J, 3).transpose(0, 2, 3, 1, 4)
        o = g[..., 0:1] * o_cmp + g[..., 1:2] * o_sel + g[..., 2:3] * o_win
        return o.transpose(0, 3, 1, 2, 4).reshape(B, QB, H * dh)

    q_blocks = q.reshape(B, NB, QB, H, dh).swapaxes(0, 1)
    g_blocks = gates.reshape(B, NB, QB, H, 3).swapaxes(0, 1)
    out = lax.map(block_fn, (jnp.arange(NB), q_blocks, g_blocks))
    return out.swapaxes(0, 1).reshape(B, S, H * dh)


def setup_inputs(seed: int = 0) -> dict:
    key = jax.random.key(seed)
    k = jax.random.split(key, 24)
    f32 = jnp.float32

    def nrm(kk, shape, scale):
        return jax.random.normal(kk, shape, f32) * scale

    x = nrm(k[0], (BATCH, SEQ, D_MODEL), 1.0)
    p = nrm(k[1], (DEPTH, BATCH, SEQ, PLE_DIM), 1.0)
    offset = jax.random.randint(k[2], (BATCH, 1), 0, MAX_POS_OFFSET, dtype=jnp.int32)
    positions = offset + jnp.arange(SEQ, dtype=jnp.int32)[None, :]
    norm_g = 1.0 + nrm(k[3], (DEPTH, D_MODEL), 0.02)
    w_in = nrm(k[4], (DEPTH, D_MODEL, D_IN), D_MODEL ** -0.5)
    conv_w = nrm(k[5], (DEPTH, M_CONV, 2 * M_WIDTH), M_CONV ** -0.5)
    conv_b = nrm(k[6], (DEPTH, 2 * M_WIDTH), 0.01)
    b_igate = nrm(k[7], (DEPTH, M_HEADS), 0.1)
    b_fgate = jnp.linspace(3.0, 6.0, M_HEADS, dtype=f32)[None, :] + nrm(k[8], (DEPTH, M_HEADS), 0.1)
    m_norm_g = 1.0 + nrm(k[9], (DEPTH, M_WIDTH), 0.02)
    cmp_pos_k = nrm(k[10], (DEPTH, CMP_BLOCK, N_HEAD_DIM), 0.02)
    cmp_pos_v = nrm(k[11], (DEPTH, CMP_BLOCK, N_HEAD_DIM), 0.02)
    cmp_k_w1 = nrm(k[12], (DEPTH, CMP_BLOCK * N_HEAD_DIM, CMP_HIDDEN), (CMP_BLOCK * N_HEAD_DIM) ** -0.5)
    cmp_k_w2 = nrm(k[13], (DEPTH, CMP_HIDDEN, N_HEAD_DIM), CMP_HIDDEN ** -0.5)
    cmp_v_w1 = nrm(k[14], (DEPTH, CMP_BLOCK * N_HEAD_DIM, CMP_HIDDEN), (CMP_BLOCK * N_HEAD_DIM) ** -0.5)
    cmp_v_w2 = nrm(k[15], (DEPTH, CMP_HIDDEN, N_HEAD_DIM), CMP_HIDDEN ** -0.5)
    w_out = nrm(k[16], (DEPTH, D_MIX, D_MODEL), D_MIX ** -0.5)
    ple_gate_w = nrm(k[17], (DEPTH, D_MODEL, D_MODEL), D_MODEL ** -0.5)
    ple_proj_w = nrm(k[18], (DEPTH, PLE_DIM, D_MODEL), PLE_DIM ** -0.5)
    ple_norm_g = 1.0 + nrm(k[19], (DEPTH, D_MODEL), 0.02)
    final_norm_g = 1.0 + nrm(k[20], (D_MODEL,), 0.02)
    return {"x": x, "p": p, "positions": positions, "norm_g": norm_g, "w_in": w_in,
            "conv_w": conv_w, "conv_b": conv_b, "b_igate": b_igate, "b_fgate": b_fgate,
            "m_norm_g": m_norm_g, "cmp_pos_k": cmp_pos_k, "cmp_pos_v": cmp_pos_v,
            "cmp_k_w1": cmp_k_w1, "cmp_k_w2": cmp_k_w2, "cmp_v_w1": cmp_v_w1, "cmp_v_w2": cmp_v_w2,
            "w_out": w_out, "ple_gate_w": ple_gate_w, "ple_proj_w": ple_proj_w,
            "ple_norm_g": ple_norm_g, "final_norm_g": final_norm_g}


def reference(x, p, positions, norm_g, w_in, conv_w, conv_b, b_igate, b_fgate, m_norm_g,
              cmp_pos_k, cmp_pos_v, cmp_k_w1, cmp_k_w2, cmp_v_w1, cmp_v_w2, w_out,
              ple_gate_w, ple_proj_w, ple_norm_g, final_norm_g):
    B, S, _ = x.shape
    f32 = jnp.float32
    for l in range(DEPTH):
        h = rmsnorm(x, norm_g[l])
        (mq, mk, mv, mo, mz, mi, mf, nq, kc, vc, ks, vs, kw, vw, ng, nz) = split_cols(h @ w_in[l], IN_SPLITS)
        qk = jax.nn.silu(causal_conv(jnp.concatenate([mq, mk], axis=-1), conv_w[l], conv_b[l]))
        mq_c, mk_c = qk[..., :M_WIDTH], qk[..., M_WIDTH:]
        ig = mi.astype(f32) + b_igate[l].astype(f32)
        lf = jax.nn.log_sigmoid(mf.astype(f32) + b_fgate[l].astype(f32))
        hm = mlstm_mixer(heads(mq_c, M_HEADS).astype(f32),
                         (heads(mk_c, M_HEADS) * (M_HEAD_DIM ** -0.5)).astype(f32),
                         heads(mv, M_HEADS).astype(f32), ig, lf)
        hm = head_layernorm(hm, m_norm_g[l]).astype(x.dtype)
        m_out = hm * jax.nn.sigmoid(mo) * jax.nn.silu(mz)
        q = partial_rope(heads(nq, N_HEADS) * (N_HEAD_DIM ** -0.5), positions)
        n_att = nsa_mixer(q,
                          partial_rope(heads(kc, N_KV), positions), heads(vc, N_KV),
                          partial_rope(heads(ks, N_KV), positions), heads(vs, N_KV),
                          partial_rope(heads(kw, N_KV), positions), heads(vw, N_KV),
                          jax.nn.sigmoid(ng).reshape(B, S, N_HEADS, 3),
                          cmp_pos_k[l], cmp_pos_v[l], cmp_k_w1[l], cmp_k_w2[l], cmp_v_w1[l], cmp_v_w2[l])
        n_out = n_att * jax.nn.silu(nz)
        x = x + jnp.concatenate([m_out, n_out], axis=-1) @ w_out[l]
        ple = rmsnorm(p[l] @ ple_proj_w[l], ple_norm_g[l])
        x = x + jax.nn.sigmoid(x @ ple_gate_w[l]) * ple
    return rmsnorm(x, final_norm_g)
```

```cpp
#include <hip/hip_runtime.h>
#include <hip/hip_cooperative_groups.h>
#include <cstdio>
#include <cstdint>
namespace cg = cooperative_groups;

namespace pg8 {
#define PG8_LAS __attribute__((address_space(3)))
typedef unsigned short bf16_t;
typedef short bf16x8 __attribute__((ext_vector_type(8)));
typedef float f32x4 __attribute__((ext_vector_type(4)));
typedef unsigned u32x4 __attribute__((ext_vector_type(4)));
constexpr int BM = 256, BK = 64, HALF = 128, HTB = HALF * BK * 2, STAGE_BYTES = 8 * HTB, NXCD = 8, WGM = 8;

__host__ __device__ __forceinline__ int lds_byte(int r, int c) { const int st = (r >> 4) * 2 + (c >> 5), rr = r & 15, cc = c & 31, ob = rr * 64 + cc * 2; return st * 1024 + (ob ^ (((ob >> 9) & 1) << 5)); }
__host__ __device__ __forceinline__ void stage_rc(int b, int& R, int& C) { const int st = b / 1024, sb = b % 1024, swz = sb ^ (((sb >> 9) & 1) << 5); R = (st >> 1) * 16 + swz / 64; C = (st & 1) * 32 + (swz % 64) / 2; }
__host__ __device__ __forceinline__ int perm32(int rho) { const int n = rho >> 4, i = rho & 15; return 8 * (i >> 2) + 4 * n + (i & 3); }

struct Unit { int pm, pn; };
struct Gemm { const bf16_t* A; const bf16_t* Bt; int M, N, K; };

struct StaticOrder {
    int nM, nN, nwg, G, c;
    __host__ __device__ void init(int M, int N, int G_, int c_) { nM = M / BM; nN = N / BM; nwg = nM * nN; G = G_; c = c_; }
    __host__ __device__ bool next(int i, Unit& u) const {
        const long L = (long)i * G + c; if (L >= nwg) return false;
        int wgid = (int)L; { const int q = nwg / NXCD, r = nwg % NXCD, xcd = wgid % NXCD, off = wgid / NXCD; wgid = (xcd < r ? xcd * (q + 1) : r * (q + 1) + (xcd - r) * q) + off; }
        const int nig = WGM * nN, gid = wgid / nig, fm = gid * WGM, gsz = (nM - fm) < WGM ? (nM - fm) : WGM;
        u.pm = fm + ((wgid % nig) % gsz); u.pn = (wgid % nig) / gsz; return true;
    }
    __device__ __forceinline__ void a_ready(const Unit&) const {}
    __device__ __forceinline__ void done(const Unit&) const {}
};

template <class Epi, class Sched, bool ALIGN_EPI = false, bool SP2 = false>
__device__ __forceinline__ void gemm_phase(PG8_LAS unsigned char* lds, const Gemm g, const Sched& S, const Epi& E) {
    int tid = threadIdx.x; asm volatile("" : "+v"(tid));
    const int wid = __builtin_amdgcn_readfirstlane(tid >> 6), lane = tid & 63, wr = wid >> 2, wc = wid & 3, fr = lane & 15, fq = lane >> 4;
    const int K = g.K, nt = K / BK;
    unsigned voffA[2], voffB[2];
#pragma unroll
    for (int i = 0; i < 2; ++i) { int R, C; stage_rc(tid * 16 + i * 8192, R, C); const int Rb = Epi::PERM ? ((R & ~31) + perm32(R & 31)) : R;
        voffA[i] = (unsigned)(R * K + C) * 2u; voffB[i] = (unsigned)(Rb * K + C) * 2u; }
    const size_t kstep = (size_t)(BK * 2);
    const size_t hstep = (size_t)HALF * K * 2;
    const size_t tstep = 2 * hstep;
    const unsigned ldsw = (unsigned)wid * 1024u;
    const int aoff = lds_byte(wr * 64 + fr, fq * 8), boff = lds_byte(wc * 32 + fr, fq * 8);
#define PG8_SA(b, h) (((b) * 2 + (h)) * HTB)
#define PG8_SB(b, h) ((4 + (b) * 2 + (h)) * HTB)
#define PG8_STAGE(bufoff, gbase, voff) do { _Pragma("unroll") for (int _i = 0; _i < 2; ++_i) \
        __builtin_amdgcn_global_load_lds((const unsigned*)((const char*)(gbase) + (voff)[_i]), (PG8_LAS unsigned*)(lds + (bufoff) + ldsw + _i * 8192), 16, 0, 0); } while (0)
#define PG8_LDA(dst, b, h) do { _Pragma("unroll") for (int m = 0; m < 4; ++m) _Pragma("unroll") for (int k = 0; k < 2; ++k) dst[m][k] = *(const PG8_LAS bf16x8*)(lds + PG8_SA(b, h) + aoff + m * 2048 + k * 1024); } while (0)
#define PG8_LDB(dst, b, h) do { _Pragma("unroll") for (int n = 0; n < 2; ++n) _Pragma("unroll") for (int k = 0; k < 2; ++k) dst[n][k] = *(const PG8_LAS bf16x8*)(lds + PG8_SB(b, h) + boff + n * 2048 + k * 1024); } while (0)
#define PG8_MMA(ai, bj, At, Bt) do { __builtin_amdgcn_s_setprio(1); _Pragma("unroll") for (int m = 0; m < 4; ++m) _Pragma("unroll") for (int n = 0; n < 2; ++n) _Pragma("unroll") for (int k = 0; k < 2; ++k) \
        acc[ai][bj][m][n] = __builtin_amdgcn_mfma_f32_16x16x32_bf16(Bt[n][k], At[m][k], acc[ai][bj][m][n], 0, 0, 0); __builtin_amdgcn_s_setprio(0); } while (0)
#define PG8_WAIT_V(n) asm volatile("s_waitcnt vmcnt(" #n ")" ::: "memory")
#define PG8_WAIT_L(n) asm volatile("s_waitcnt lgkmcnt(" #n ")" ::: "memory")
#define PG8_BAR __builtin_amdgcn_s_barrier()
#define PG8_SCHED __builtin_amdgcn_sched_barrier(0)
    Unit cur, nxt; int ui = 0;
    if (!S.next(0, cur)) return;
    f32x4 acc[2][2][4][2];
#pragma unroll
    for (int a = 0; a < 2; ++a)
#pragma unroll
        for (int b = 0; b < 2; ++b)
#pragma unroll
            for (int m = 0; m < 4; ++m)
#pragma unroll
                for (int n = 0; n < 2; ++n) acc[a][b][m][n] = (f32x4){0.f, 0.f, 0.f, 0.f};
    bf16x8 At[4][2], B0[2][2], B1[2][2];
    const char* cA = (const char*)g.A + (size_t)cur.pm * tstep; const char* cB = (const char*)g.Bt + (size_t)cur.pn * tstep;
    S.a_ready(cur);
    if constexpr (SP2) {
        PG8_STAGE(PG8_SB(0, 0), cB, voffB); PG8_STAGE(PG8_SB(0, 1), cB + hstep, voffB); PG8_STAGE(PG8_SA(0, 0), cA, voffA); PG8_STAGE(PG8_SA(0, 1), cA + hstep, voffA);
        if (wr == 1) PG8_BAR;
        PG8_WAIT_V(2); PG8_BAR;
        PG8_STAGE(PG8_SB(1, 0), cB + kstep, voffB); PG8_STAGE(PG8_SA(1, 0), cA + kstep, voffA); PG8_STAGE(PG8_SB(1, 1), cB + hstep + kstep, voffB);
        PG8_WAIT_V(6); PG8_BAR;
    } else {
        PG8_STAGE(PG8_SB(0, 0), cB, voffB); PG8_STAGE(PG8_SA(0, 0), cA, voffA); PG8_STAGE(PG8_SB(0, 1), cB + hstep, voffB); PG8_STAGE(PG8_SA(0, 1), cA + hstep, voffA);
        if (wr == 1) PG8_BAR;
        PG8_WAIT_V(4); PG8_BAR;
        PG8_STAGE(PG8_SB(1, 0), cB + kstep, voffB); PG8_STAGE(PG8_SA(1, 0), cA + kstep, voffA); PG8_STAGE(PG8_SB(1, 1), cB + hstep + kstep, voffB);
        PG8_WAIT_V(6); PG8_BAR;
    }
    for (;;) {
        const bool has_next = S.next(ui + 1, nxt);
        const char* nA = has_next ? (const char*)g.A + (size_t)nxt.pm * tstep : cA; const char* nB = has_next ? (const char*)g.Bt + (size_t)nxt.pn * tstep : cB;
        for (int t = 0; t < nt; t += 2) {
            const bool last = (t == nt - 2);
            const char* a1 = cA + (size_t)(t + 1) * kstep;
            const char* a2 = last ? nA : cA + (size_t)(t + 2) * kstep; const char* b2 = last ? nB : cB + (size_t)(t + 2) * kstep;
            const char* a3 = a2 + kstep; const char* b3 = b2 + kstep;
            if (last && has_next) S.a_ready(nxt);
            if constexpr (SP2) {
            PG8_LDB(B0, 0, 0); PG8_LDB(B1, 0, 1); PG8_SCHED; PG8_LDA(At, 0, 0); PG8_STAGE(PG8_SA(1, 1), a1 + hstep, voffA);
            PG8_WAIT_V(8); PG8_WAIT_L(0); PG8_BAR; PG8_MMA(0, 0, At, B0); PG8_MMA(0, 1, At, B1); PG8_BAR; PG8_SCHED;
            PG8_LDA(At, 0, 1); PG8_STAGE(PG8_SB(0, 0), b2, voffB); PG8_STAGE(PG8_SB(0, 1), b2 + hstep, voffB); PG8_STAGE(PG8_SA(0, 0), a2, voffA);
            PG8_WAIT_V(8); PG8_WAIT_L(0); PG8_BAR; PG8_MMA(1, 0, At, B0); PG8_MMA(1, 1, At, B1); PG8_BAR; PG8_SCHED;
            PG8_LDB(B0, 1, 0); PG8_LDB(B1, 1, 1); PG8_SCHED; PG8_LDA(At, 1, 0); PG8_STAGE(PG8_SA(0, 1), a2 + hstep, voffA);
            PG8_WAIT_V(8); PG8_WAIT_L(0); PG8_BAR; PG8_MMA(0, 0, At, B0); PG8_MMA(0, 1, At, B1); PG8_BAR; PG8_SCHED;
            PG8_LDA(At, 1, 1); PG8_STAGE(PG8_SB(1, 0), b3, voffB); PG8_STAGE(PG8_SB(1, 1), b3 + hstep, voffB); PG8_STAGE(PG8_SA(1, 0), a3, voffA);
            PG8_WAIT_V(8); PG8_WAIT_L(0); PG8_BAR; PG8_MMA(1, 0, At, B0); PG8_MMA(1, 1, At, B1); PG8_BAR; PG8_SCHED;
            } else {
            PG8_LDB(B0, 0, 0); PG8_SCHED; PG8_LDA(At, 0, 0); PG8_STAGE(PG8_SA(1, 1), a1 + hstep, voffA);
            PG8_WAIT_L(8); PG8_BAR; PG8_WAIT_L(0); PG8_MMA(0, 0, At, B0); PG8_BAR; PG8_SCHED;
            PG8_LDB(B1, 0, 1); PG8_STAGE(PG8_SB(0, 0), b2, voffB);
            PG8_BAR; PG8_WAIT_L(0); PG8_MMA(0, 1, At, B1); PG8_BAR;
            PG8_LDA(At, 0, 1); PG8_STAGE(PG8_SA(0, 0), a2, voffA);
            PG8_BAR; PG8_WAIT_L(0); PG8_MMA(1, 0, At, B0); PG8_BAR; PG8_SCHED;
            PG8_STAGE(PG8_SB(0, 1), b2 + hstep, voffB);
            PG8_WAIT_V(6); PG8_BAR; PG8_MMA(1, 1, At, B1); PG8_BAR;
            PG8_LDB(B0, 1, 0); PG8_SCHED; PG8_LDA(At, 1, 0); PG8_STAGE(PG8_SA(0, 1), a2 + hstep, voffA);
            PG8_WAIT_L(8); PG8_BAR; PG8_WAIT_L(0); PG8_MMA(0, 0, At, B0); PG8_BAR; PG8_SCHED;
            PG8_LDB(B1, 1, 1); PG8_STAGE(PG8_SB(1, 0), b3, voffB);
            PG8_BAR; PG8_WAIT_L(0); PG8_MMA(0, 1, At, B1); PG8_BAR;
            PG8_LDA(At, 1, 1); PG8_STAGE(PG8_SA(1, 0), a3, voffA);
            PG8_BAR; PG8_WAIT_L(0); PG8_MMA(1, 0, At, B0); PG8_BAR; PG8_SCHED;
            PG8_STAGE(PG8_SB(1, 1), b3 + hstep, voffB);
            PG8_WAIT_V(6); PG8_BAR; PG8_MMA(1, 1, At, B1); PG8_BAR;
            }
        }
        if constexpr (ALIGN_EPI) { if (wr == 0) PG8_BAR; }
        E(acc, cur, wr, wc, fr, fq);
        if (!has_next) break;
#pragma unroll
        for (int a = 0; a < 2; ++a)
#pragma unroll
            for (int b = 0; b < 2; ++b)
#pragma unroll
                for (int m = 0; m < 4; ++m)
#pragma unroll
                    for (int n = 0; n < 2; ++n) acc[a][b][m][n] = (f32x4){0.f, 0.f, 0.f, 0.f};
        cur = nxt; cA = nA; cB = nB; ++ui;
        if constexpr (ALIGN_EPI) { if (wr == 1) PG8_BAR; }
    }
    PG8_WAIT_V(0);
    if constexpr (!ALIGN_EPI) { if (wr == 0) PG8_BAR; }
    PG8_BAR;
#undef PG8_SA
#undef PG8_SB
#undef PG8_STAGE
#undef PG8_LDA
#undef PG8_LDB
#undef PG8_MMA
#undef PG8_WAIT_V
#undef PG8_WAIT_L
#undef PG8_BAR
#undef PG8_SCHED
}
}

constexpr int NB = 4, SEQ = 4096, DM = 2048, NT = NB * SEQ, PLE = 256;
constexpr int MH = 4, MDH = 256;
constexpr int NHD = 64, NH = 16, NKV = 4;
constexpr int DIN = 8760, DINP = 8960;
constexpr int C_MQ = 0, C_MK = 1024, C_MV = 2048, C_MO = 3072, C_MZ = 4096, C_NQ = 5120, C_KC = 6144, C_VC = 6400, C_KS = 6656, C_VS = 6912,
              C_KW = 7168, C_VW = 7424, C_NZ = 7680, C_NG = 8704, C_GATE = 8752;
constexpr float EPSV = 1e-6f, NEGV = -1e30f, LOG2E = 1.4426950408889634f;
constexpr int NWAVES = 8, NTHREADS = 512;
constexpr int LDS_BYTES = 147456;
constexpr int LDS_MISC = 135168;
constexpr int STG_PITCH = 260;

constexpr size_t MiB = 1u << 20;
constexpr size_t WS_GATES = 1 * MiB;
constexpr size_t WS_ROPE  = 2 * MiB;
constexpr size_t WS_U2    = 3 * MiB;
constexpr size_t WS_MX2   = 3 * MiB + 512 * 1024;
constexpr size_t WS_PLSS  = 4 * MiB;
constexpr size_t WS_X2SS  = 6 * MiB;
constexpr size_t WS_WOUT  = 8 * MiB;
constexpr size_t WS_WGATE = 16 * MiB;
constexpr size_t WS_WPLE  = 24 * MiB;
constexpr size_t WS_WC1   = 25 * MiB;
constexpr size_t WS_HID   = 26 * MiB;
constexpr size_t WS_KVC   = 30 * MiB;
constexpr size_t WS_PB    = 32 * MiB;
constexpr size_t WS_WIN   = 40 * MiB;
constexpr size_t WS_XN    = 76 * MiB;
constexpr size_t WS_PROJ  = 140 * MiB;
constexpr size_t WS_MIX   = 420 * MiB;
constexpr size_t WS_END   = 484 * MiB;

#define LAS __attribute__((address_space(3)))
#define DI __device__ __forceinline__
typedef unsigned short bf16;
typedef unsigned v4u __attribute__((ext_vector_type(4)));
typedef unsigned v2u __attribute__((ext_vector_type(2)));
typedef float f32x4 __attribute__((ext_vector_type(4)));
typedef float f32x16 __attribute__((ext_vector_type(16)));
typedef short bf16x8 __attribute__((ext_vector_type(8)));
typedef short s16x4 __attribute__((ext_vector_type(4)));
typedef float f32x2_t __attribute__((ext_vector_type(2)));
typedef __bf16 bf16x2_t __attribute__((ext_vector_type(2)));

DI unsigned pk2(float lo, float hi) { f32x2_t v = {lo, hi}; bf16x2_t b = __builtin_convertvector(v, bf16x2_t); return __builtin_bit_cast(unsigned, b); }
DI float bflo(unsigned w) { return __uint_as_float(w << 16); }
DI float bfhi(unsigned w) { return __uint_as_float(w & 0xffff0000u); }
DI float bf2f(bf16 h) { return __uint_as_float((unsigned)h << 16); }
DI float ex2(float x) { return __builtin_amdgcn_exp2f(x); }
DI float fsigmoid(float x) { return __builtin_amdgcn_rcpf(1.f + ex2(-LOG2E * x)); }
DI float fsilu(float x) { return x * fsigmoid(x); }
DI float fgelu_tanh(float x) { const float z = 0.7978845608028654f * (x + 0.044715f * x * x * x); return x * fsigmoid(2.f * z); }
DI int crow(int r, int h) { return (r & 3) + 8 * (r >> 2) + 4 * h; }
DI void unpack8(v4u w, float (&f)[8]) { f[0] = bflo(w.x); f[1] = bfhi(w.x); f[2] = bflo(w.y); f[3] = bfhi(w.y); f[4] = bflo(w.z); f[5] = bfhi(w.z); f[6] = bflo(w.w); f[7] = bfhi(w.w); }
DI v4u pack8(const float (&f)[8]) { v4u w; w.x = pk2(f[0], f[1]); w.y = pk2(f[2], f[3]); w.z = pk2(f[4], f[5]); w.w = pk2(f[6], f[7]); return w; }
DI float wave_sum(float v) {
#pragma unroll
    for (int o = 1; o < 64; o <<= 1) v += __shfl_xor(v, o);
    return v;
}
DI void glds16(const void* gsrc, LAS unsigned char* dst_wave_uniform) {
    __builtin_amdgcn_global_load_lds((const unsigned*)gsrc, (LAS unsigned*)dst_wave_uniform, 16, 0, 0);
}
#define VM_WAIT() asm volatile("s_waitcnt vmcnt(0)" ::: "memory")
#define MFMA32(a, b, c) __builtin_amdgcn_mfma_f32_32x32x16_bf16((a), (b), (c), 0, 0, 0)

struct Ctx {
    const float *x, *p; const int* positions; const float *norm_g, *w_in, *conv_w, *conv_b, *b_ig, *b_fg, *m_norm_g, *pos_k, *pos_v, *ck_w1, *ck_w2, *cv_w1, *cv_w2,
                *w_out, *gate_w, *ple_w, *ple_g, *final_g;
    float* out;
    float *gates, *rope, *u2, *mx2, *plss, *x2ss;
    bf16 *WoutT, *WgateT, *WpleT, *Wc1T, *HID, *KVC, *PB, *WinT, *CA, *XN, *QC, *KC, *PROJ, *PL, *X1B, *MIX;
    int vcu, G;
};

DI int map_in(int np) { return np < 5120 ? np : (np < 7680 ? np + 8 : (np < 8704 ? np + 56 : (np < 8752 ? np - 1016 : (np < 8760 ? np - 3632 : -1)))); }
DI void transpose_item(const float* W, int K, int N, int mode, bf16* WT, int row_off, LAS float* scr, int item, int nblk, int lane) {
    const int kb = item / nblk, nb = item % nblk, k0 = 64 * kb, n0 = 32 * nb;
    const int np = n0 + (lane & 31);
    const int src = mode ? map_in(np) : np;
#pragma unroll 8
    for (int i = 0; i < 32; ++i) { const int kk = 2 * i + (lane >> 5); scr[kk * 33 + (lane & 31)] = (src >= 0) ? W[(size_t)(k0 + kk) * N + src] : 0.f; }
    __builtin_amdgcn_fence(__ATOMIC_RELEASE, "wavefront"); __builtin_amdgcn_wave_barrier(); __builtin_amdgcn_fence(__ATOMIC_ACQUIRE, "wavefront");
    const int c = lane & 7;
#pragma unroll
    for (int j = 0; j < 4; ++j) { const int n = (lane >> 3) + 8 * j; const LAS float* s = scr + (8 * c) * 33 + n;
        v4u o; o.x = pk2(s[0 * 33], s[1 * 33]); o.y = pk2(s[2 * 33], s[3 * 33]); o.z = pk2(s[4 * 33], s[5 * 33]); o.w = pk2(s[6 * 33], s[7 * 33]);
        *(v4u*)(WT + (size_t)(row_off + n0 + n) * K + k0 + 8 * c) = o; }
    __builtin_amdgcn_fence(__ATOMIC_RELEASE, "wavefront"); __builtin_amdgcn_wave_barrier(); __builtin_amdgcn_fence(__ATOMIC_ACQUIRE, "wavefront");
}
DI void phase0(const Ctx& C, LAS unsigned char* lds) {
    int tid = threadIdx.x; asm volatile("" : "+v"(tid));
    const int lane = tid & 63, wave = __builtin_amdgcn_readfirstlane(tid >> 6);
    LAS float* scr = (LAS float*)(lds + wave * 16384);
    const int gw = C.vcu * NWAVES + wave, NGW = C.G * NWAVES;
    constexpr int I_IN = 32 * 280, I_OUT = 32 * 64, I_GATE = 32 * 64, I_PLE = 4 * 64, I_C1 = 32 * 4;
    constexpr int NITEMS = I_IN + I_OUT + I_GATE + I_PLE + 2 * I_C1;
    for (int it = gw; it < NITEMS; it += NGW) {
        int r = it;
        if (r < I_IN) { transpose_item(C.w_in, DM, DIN, 1, C.WinT, 0, scr, r, 280, lane); continue; } r -= I_IN;
        if (r < I_OUT) { transpose_item(C.w_out, DM, DM, 0, C.WoutT, 0, scr, r, 64, lane); continue; } r -= I_OUT;
        if (r < I_GATE) { transpose_item(C.gate_w, DM, DM, 0, C.WgateT, 0, scr, r, 64, lane); continue; } r -= I_GATE;
        if (r < I_PLE) { transpose_item(C.ple_w, PLE, DM, 0, C.WpleT, 0, scr, r, 64, lane); continue; } r -= I_PLE;
        if (r < I_C1) { transpose_item(C.ck_w1, DM, 128, 0, C.Wc1T, 0, scr, r, 4, lane); continue; } r -= I_C1;
        transpose_item(C.cv_w1, DM, 128, 0, C.Wc1T, 128, scr, r, 4, lane);
    }
    for (int m = gw; m < NT; m += NGW) {
        const f32x4* xr = (const f32x4*)(C.x + (size_t)m * DM) + lane;
        f32x4 v[8]; float s = 0.f;
#pragma unroll
        for (int j = 0; j < 8; ++j) { v[j] = xr[64 * j]; s += (v[j].x * v[j].x + v[j].y * v[j].y) + (v[j].z * v[j].z + v[j].w * v[j].w); }
        const float rstd = 1.f / sqrtf(wave_sum(s) * (1.f / DM) + EPSV);
        v2u* o8 = (v2u*)(C.XN + (size_t)m * DM) + lane;
#pragma unroll
        for (int j = 0; j < 8; ++j) { const f32x4 g = *((const f32x4*)C.norm_g + lane + 64 * j); v2u w; w.x = pk2(v[j].x * rstd * g.x, v[j].y * rstd * g.y); w.y = pk2(v[j].z * rstd * g.z, v[j].w * rstd * g.w); o8[64 * j] = w; }
    }
    const int gt = C.vcu * NTHREADS + tid, NGT = C.G * NTHREADS;
    for (int i = gt; i < NT * PLE / 8; i += NGT) {
        const f32x4 a = *((const f32x4*)C.p + 2 * i), b = *((const f32x4*)C.p + 2 * i + 1);
        v4u w; w.x = pk2(a.x, a.y); w.y = pk2(a.z, a.w); w.z = pk2(b.x, b.y); w.w = pk2(b.z, b.w);
        *((v4u*)C.PB + i) = w;
    }
    for (int i = gt; i < NT * 8; i += NGT) {
        const int t = i >> 3, k = i & 7;
        const float invf[8] = {1.0f, 0.1939227432012558f, 0.03760603070259094f, 0.007292664609849453f, 0.0014142135623842478f, 0.00027424818836152554f, 5.3182957344688475e-05f, 1.0313385246263351e-05f};
        float inv = invf[0];
#pragma unroll
        for (int q = 1; q < 8; ++q) inv = (k == q) ? invf[q] : inv;
        const float ang = (float)C.positions[t] * inv;
        float sn, cs; sincosf(ang, &sn, &cs);
        C.rope[t * 16 + k] = cs; C.rope[t * 16 + 8 + k] = sn;
    }
}

typedef pg8::f32x4 gf4;
struct EpiProj {
    static constexpr bool PERM = true;
    bf16* O; float* gates;
    DI void operator()(const gf4 (&acc)[2][2][4][2], const pg8::Unit& u, int wr, int wc, int fr, int fq) const {
        const int row0 = u.pm * 256 + wr * 64 + fr, col0 = u.pn * 256 + wc * 32 + 8 * fq;
        const bool gl = (u.pn == 34) && (wc == 1) && (fq == 2);
#pragma unroll
        for (int ai = 0; ai < 2; ++ai)
#pragma unroll
            for (int m = 0; m < 4; ++m) { const int row = row0 + ai * 128 + m * 16; bf16* rowp = O + (size_t)row * DINP + col0;
#pragma unroll
                for (int bj = 0; bj < 2; ++bj) { const gf4 v0 = acc[ai][bj][m][0], v1 = acc[ai][bj][m][1];
                    v4u w; w.x = pk2(v0[0], v0[1]); w.y = pk2(v0[2], v0[3]); w.z = pk2(v1[0], v1[1]); w.w = pk2(v1[2], v1[3]);
                    *(v4u*)(rowp + bj * 128) = w; }
                if (gl) { *(gf4*)(gates + (size_t)row * 8) = acc[ai][0][m][0]; *(gf4*)(gates + (size_t)row * 8 + 4) = acc[ai][0][m][1]; } }
    }
};
struct EpiCmp {
    static constexpr bool PERM = true;
    bf16* H;
    DI void operator()(const gf4 (&acc)[2][2][4][2], const pg8::Unit& u, int wr, int wc, int fr, int fq) const {
        const int row0 = u.pm * 256 + wr * 64 + fr, col0 = wc * 32 + 8 * fq;
        const bool isv = u.pm >= 16;
#pragma unroll
        for (int ai = 0; ai < 2; ++ai)
#pragma unroll
            for (int m = 0; m < 4; ++m) { const int row = row0 + ai * 128 + m * 16;
                const gf4 v0 = isv ? acc[ai][1][m][0] : acc[ai][0][m][0], v1 = isv ? acc[ai][1][m][1] : acc[ai][0][m][1];
                v4u w; w.x = pk2(fgelu_tanh(v0[0]), fgelu_tanh(v0[1])); w.y = pk2(fgelu_tanh(v0[2]), fgelu_tanh(v0[3]));
                w.z = pk2(fgelu_tanh(v1[0]), fgelu_tanh(v1[1])); w.w = pk2(fgelu_tanh(v1[2]), fgelu_tanh(v1[3]));
                *(v4u*)(H + (size_t)row * 128 + col0) = w; }
    }
};
struct EpiX1 {
    static constexpr bool PERM = true;
    const float* x; float* out; bf16* xb;
    DI void operator()(const gf4 (&acc)[2][2][4][2], const pg8::Unit& u, int wr, int wc, int fr, int fq) const {
        const int row0 = u.pm * 256 + wr * 64 + fr, col0 = u.pn * 256 + wc * 32 + 8 * fq;
#pragma unroll
        for (int ai = 0; ai < 2; ++ai)
#pragma unroll
            for (int m = 0; m < 4; ++m) { const size_t off = (size_t)(row0 + ai * 128 + m * 16) * DM + col0;
#pragma unroll
                for (int bj = 0; bj < 2; ++bj) { const gf4 a0 = *(const gf4*)(x + off + bj * 128), a1 = *(const gf4*)(x + off + bj * 128 + 4);
                    const gf4 v0 = acc[ai][bj][m][0] + a0, v1 = acc[ai][bj][m][1] + a1;
                    *(gf4*)(out + off + bj * 128) = v0; *(gf4*)(out + off + bj * 128 + 4) = v1;
                    v4u w; w.x = pk2(v0[0], v0[1]); w.y = pk2(v0[2], v0[3]); w.z = pk2(v1[0], v1[1]); w.w = pk2(v1[2], v1[3]);
                    *(v4u*)(xb + off + bj * 128) = w; } }
    }
};
struct EpiPl {
    static constexpr bool PERM = true;
    bf16* PLb; float* ss;
    DI void operator()(const gf4 (&acc)[2][2][4][2], const pg8::Unit& u, int wr, int wc, int fr, int fq) const {
        const int row0 = u.pm * 256 + wr * 64 + fr, col0 = u.pn * 256 + wc * 32 + 8 * fq;
#pragma unroll
        for (int ai = 0; ai < 2; ++ai)
#pragma unroll
            for (int m = 0; m < 4; ++m) { const int row = row0 + ai * 128 + m * 16; const size_t off = (size_t)row * DM + col0; float s = 0.f;
#pragma unroll
                for (int bj = 0; bj < 2; ++bj) { const gf4 v0 = acc[ai][bj][m][0], v1 = acc[ai][bj][m][1];
                    s += (v0[0] * v0[0] + v0[1] * v0[1]) + (v0[2] * v0[2] + v0[3] * v0[3]) + (v1[0] * v1[0] + v1[1] * v1[1]) + (v1[2] * v1[2] + v1[3] * v1[3]);
                    v4u w; w.x = pk2(v0[0], v0[1]); w.y = pk2(v0[2], v0[3]); w.z = pk2(v1[0], v1[1]); w.w = pk2(v1[2], v1[3]);
                    *(v4u*)(PLb + off + bj * 128) = w; }
                s += __shfl_xor(s, 16); s += __shfl_xor(s, 32);
                if (fq == 0) ss[(size_t)row * 32 + u.pn * 4 + wc] = s; }
    }
};
struct EpiGate {
    static constexpr bool PERM = true;
    float* out; const bf16* PLb; const float* plss; const float* pg; float* ss;
    DI void operator()(const gf4 (&acc)[2][2][4][2], const pg8::Unit& u, int wr, int wc, int fr, int fq) const {
        const int row0 = u.pm * 256 + wr * 64 + fr, col0 = u.pn * 256 + wc * 32 + 8 * fq;
#pragma unroll
        for (int ai = 0; ai < 2; ++ai)
#pragma unroll
            for (int m = 0; m < 4; ++m) { const int row = row0 + ai * 128 + m * 16; const size_t off = (size_t)row * DM + col0;
                float ps = 0.f;
#pragma unroll
                for (int k = 0; k < 8; ++k) { const gf4 t = *(const gf4*)(plss + (size_t)row * 32 + 4 * k); ps += (t[0] + t[1]) + (t[2] + t[3]); }
                const float rstd = 1.f / sqrtf(ps * (1.f / DM) + EPSV);
                float s = 0.f;
#pragma unroll
                for (int bj = 0; bj < 2; ++bj) {
                    const gf4 a0 = *(const gf4*)(out + off + bj * 128), a1 = *(const gf4*)(out + off + bj * 128 + 4);
                    const gf4 g0 = *(const gf4*)(pg + col0 + bj * 128), g1 = *(const gf4*)(pg + col0 + bj * 128 + 4);
                    const v4u pw = *(const v4u*)(PLb + off + bj * 128);
                    float pl[8]; unpack8(pw, pl);
                    gf4 v0, v1;
#pragma unroll
                    for (int e = 0; e < 4; ++e) { v0[e] = a0[e] + fsigmoid(acc[ai][bj][m][0][e]) * (pl[e] * rstd * g0[e]); v1[e] = a1[e] + fsigmoid(acc[ai][bj][m][1][e]) * (pl[4 + e] * rstd * g1[e]); }
                    s += (v0[0] * v0[0] + v0[1] * v0[1]) + (v0[2] * v0[2] + v0[3] * v0[3]) + (v1[0] * v1[0] + v1[1] * v1[1]) + (v1[2] * v1[2] + v1[3] * v1[3]);
                    *(gf4*)(out + off + bj * 128) = v0; *(gf4*)(out + off + bj * 128 + 4) = v1; }
                s += __shfl_xor(s, 16); s += __shfl_xor(s, 32);
                if (fq == 0) ss[(size_t)row * 32 + u.pn * 4 + wc] = s; }
    }
};

DI float log_sigmoid(float z) { return fminf(z, 0.f) - log1pf(expf(-fabsf(z))); }
DI void phase2_scan(const Ctx& C, LAS unsigned char* lds, int bh) {
    int tid = threadIdx.x; asm volatile("" : "+v"(tid));
    const int lane = tid & 63, wave = tid >> 6;
    const int b = bh >> 2, h = bh & 3;
    LAS float* red = (LAS float*)lds;
    const float bi = C.b_ig[h], bfg = C.b_fg[h];
    float ig[8], lf[8];
#pragma unroll
    for (int e = 0; e < 8; ++e) { const size_t row = (size_t)b * SEQ + tid * 8 + e; ig[e] = C.gates[row * 8 + h] + bi; lf[e] = log_sigmoid(C.gates[row * 8 + 4 + h] + bfg); }
    float cs[8]; cs[0] = lf[0];
#pragma unroll
    for (int e = 1; e < 8; ++e) cs[e] = cs[e - 1] + lf[e];
    float incl = cs[7];
#pragma unroll
    for (int o = 1; o < 64; o <<= 1) { const float t = __shfl_up(incl, o); if (lane >= o) incl += t; }
    if (lane == 63) red[wave] = incl;
    __syncthreads();
    float woff = 0.f;
#pragma unroll
    for (int w = 0; w < 8; ++w) woff += (w < wave) ? red[w] : 0.f;
    const float excl = woff + incl - cs[7];
    float u[8], cm[8];
#pragma unroll
    for (int e = 0; e < 8; ++e) u[e] = ig[e] - (excl + cs[e]);
    cm[0] = u[0];
#pragma unroll
    for (int e = 1; e < 8; ++e) cm[e] = fmaxf(cm[e - 1], u[e]);
    float mincl = cm[7];
#pragma unroll
    for (int o = 1; o < 64; o <<= 1) { const float t = __shfl_up(mincl, o); if (lane >= o) mincl = fmaxf(mincl, t); }
    float mexcl = __shfl_up(mincl, 1); if (lane == 0) mexcl = 0.f;
    if (lane == 63) red[8 + wave] = mincl;
    __syncthreads();
    float wmax = 0.f;
#pragma unroll
    for (int w = 0; w < 8; ++w) wmax = (w < wave) ? fmaxf(wmax, red[8 + w]) : wmax;
    const float base = fmaxf(fmaxf(mexcl, wmax), 0.f);
#pragma unroll
    for (int e = 0; e < 8; ++e) { const size_t o = (size_t)bh * SEQ + tid * 8 + e; C.u2[o] = u[e] * LOG2E; C.mx2[o] = fmaxf(base, cm[e]) * LOG2E; }
    __syncthreads();
}
DI void phase2(const Ctx& C, LAS unsigned char* lds) {
    int tid = threadIdx.x; asm volatile("" : "+v"(tid));
    const int lane = tid & 63, wave = __builtin_amdgcn_readfirstlane(tid >> 6);
    if (C.vcu < 16) phase2_scan(C, lds, C.vcu);
    if (C.G < 16) { for (int bh = C.vcu + C.G; bh < 16; bh += C.G) phase2_scan(C, lds, bh); }
    const int gw = C.vcu * NWAVES + wave, NGW = C.G * NWAVES;
    for (int it = gw; it < (NT / 32) * 4; it += NGW) {
        const int grp = it >> 2, chunk = it & 3, c0 = chunk * 512 + lane * 8, t0 = grp * 32;
        float w[4][8], bb[8];
#pragma unroll
        for (int j = 0; j < 4; ++j) { const f32x4 a = *(const f32x4*)(C.conv_w + j * 2048 + c0), b2 = *(const f32x4*)(C.conv_w + j * 2048 + c0 + 4);
            w[j][0] = a.x; w[j][1] = a.y; w[j][2] = a.z; w[j][3] = a.w; w[j][4] = b2.x; w[j][5] = b2.y; w[j][6] = b2.z; w[j][7] = b2.w; }
        { const f32x4 a = *(const f32x4*)(C.conv_b + c0), b2 = *(const f32x4*)(C.conv_b + c0 + 4); bb[0] = a.x; bb[1] = a.y; bb[2] = a.z; bb[3] = a.w; bb[4] = b2.x; bb[5] = b2.y; bb[6] = b2.z; bb[7] = b2.w; }
        float a0[8], a1[8], a2[8], a3[8];
        const bool first = (t0 & (SEQ - 1)) == 0;
        if (first) {
#pragma unroll
            for (int e = 0; e < 8; ++e) { a0[e] = 0.f; a1[e] = 0.f; a2[e] = 0.f; }
        } else {
            unpack8(*(const v4u*)(C.PROJ + (size_t)(t0 - 3) * DINP + c0), a0);
            unpack8(*(const v4u*)(C.PROJ + (size_t)(t0 - 2) * DINP + c0), a1);
            unpack8(*(const v4u*)(C.PROJ + (size_t)(t0 - 1) * DINP + c0), a2);
        }
        const bool isk = c0 >= 1024;
        bf16* dst = isk ? (C.KC + (c0 - 1024)) : (C.QC + c0);
        const float osc = isk ? 0.0625f : 1.f;
        for (int tt = 0; tt < 32; ++tt) {
            unpack8(*(const v4u*)(C.PROJ + (size_t)(t0 + tt) * DINP + c0), a3);
            float y[8];
#pragma unroll
            for (int e = 0; e < 8; ++e) { const float v = bb[e] + w[3][e] * a3[e] + w[0][e] * a0[e] + w[1][e] * a1[e] + w[2][e] * a2[e]; y[e] = fsilu(v) * osc; a0[e] = a1[e]; a1[e] = a2[e]; a2[e] = a3[e]; }
            *(v4u*)(dst + (size_t)(t0 + tt) * 1024) = pack8(y);
        }
    }
    const int gt = C.vcu * NTHREADS + tid, NGT = C.G * NTHREADS;
    for (int i = gt; i < NT * 24; i += NGT) {
        const int t = i / 24, hs = i % 24;
        const int col = hs < 16 ? (C_NQ + 64 * hs) : (hs < 20 ? (C_KS + 64 * (hs - 16)) : (C_KW + 64 * (hs - 20)));
        bf16* ptr = C.PROJ + (size_t)t * DINP + col;
        float x1[8], x2[8], y1[8], y2[8];
        unpack8(*(const v4u*)ptr, x1); unpack8(*(const v4u*)(ptr + 8), x2);
        const f32x4 c0 = *(const f32x4*)(C.rope + t * 16), c1 = *(const f32x4*)(C.rope + t * 16 + 4), s0 = *(const f32x4*)(C.rope + t * 16 + 8), s1 = *(const f32x4*)(C.rope + t * 16 + 12);
        const float cs[8] = {c0.x, c0.y, c0.z, c0.w, c1.x, c1.y, c1.z, c1.w}, sn[8] = {s0.x, s0.y, s0.z, s0.w, s1.x, s1.y, s1.z, s1.w};
#pragma unroll
        for (int e = 0; e < 8; ++e) { y1[e] = x1[e] * cs[e] - x2[e] * sn[e]; y2[e] = x2[e] * cs[e] + x1[e] * sn[e]; }
        *(v4u*)ptr = pack8(y1); *(v4u*)(ptr + 8) = pack8(y2);
    }
    for (int i = gt; i < 8192 * 256; i += NGT) {
        const int r = i >> 8, ch = i & 255, j = ch >> 3, dc = ch & 7;
        const int kvsel = r >> 12, bg = (r >> 8) & 15, c = r & 255, b = bg >> 2, g = bg & 3, tok = 16 * c + j;
        float v[8];
        if (tok >= SEQ) {
#pragma unroll
            for (int e = 0; e < 8; ++e) v[e] = 0.f;
        } else {
            const size_t t = (size_t)b * SEQ + tok;
            const bf16* src = C.PROJ + t * DINP + (kvsel ? C_VC : C_KC) + 64 * g;
            unpack8(*(const v4u*)(src + 8 * dc), v);
            if (!kvsel && dc < 2) {
                float o[8]; unpack8(*(const v4u*)(src + 8 * (dc ^ 1)), o);
                const f32x4 c0 = *(const f32x4*)(C.rope + t * 16), c1 = *(const f32x4*)(C.rope + t * 16 + 4), s0 = *(const f32x4*)(C.rope + t * 16 + 8), s1 = *(const f32x4*)(C.rope + t * 16 + 12);
                const float cs[8] = {c0.x, c0.y, c0.z, c0.w, c1.x, c1.y, c1.z, c1.w}, sn[8] = {s0.x, s0.y, s0.z, s0.w, s1.x, s1.y, s1.z, s1.w};
#pragma unroll
                for (int e = 0; e < 8; ++e) v[e] = (dc == 0) ? (v[e] * cs[e] - o[e] * sn[e]) : (v[e] * cs[e] + o[e] * sn[e]);
            }
            const float* pp = (kvsel ? C.pos_v : C.pos_k) + j * 64 + 8 * dc;
            const f32x4 p0 = *(const f32x4*)pp, p1 = *(const f32x4*)(pp + 4);
            v[0] += p0.x; v[1] += p0.y; v[2] += p0.z; v[3] += p0.w; v[4] += p1.x; v[5] += p1.y; v[6] += p1.z; v[7] += p1.w;
        }
        *(v4u*)(C.CA + (size_t)r * 2048 + ch * 8) = pack8(v);
    }
}

DI void phase3b(const Ctx& C, LAS unsigned char* lds) {
    int tid = threadIdx.x; asm volatile("" : "+v"(tid));
    const int lane = tid & 63, wave = __builtin_amdgcn_readfirstlane(tid >> 6);
    LAS float* scr = (LAS float*)(lds + wave * 4096);
    const int gw = C.vcu * NWAVES + wave, NGW = C.G * NWAVES;
    for (int it = gw; it < 1024; it += NGW) {
        const int r0 = it * 8;
        const float* w2 = (r0 >= 4096) ? C.cv_w2 : C.ck_w2;
#pragma unroll
        for (int q = 0; q < 2; ++q) { const int idx = (q * 64 + lane) * 8; float f[8]; unpack8(*(const v4u*)(C.HID + (size_t)r0 * 128 + idx), f);
#pragma unroll
            for (int e = 0; e < 8; ++e) scr[idx + e] = f[e]; }
        __builtin_amdgcn_fence(__ATOMIC_RELEASE, "wavefront"); __builtin_amdgcn_wave_barrier(); __builtin_amdgcn_fence(__ATOMIC_ACQUIRE, "wavefront");
        float acc[8];
#pragma unroll
        for (int rr = 0; rr < 8; ++rr) acc[rr] = 0.f;
        for (int hh = 0; hh < 128; ++hh) { const float w = w2[hh * 64 + lane];
#pragma unroll
            for (int rr = 0; rr < 8; ++rr) acc[rr] += scr[rr * 128 + hh] * w; }
#pragma unroll
        for (int rr = 0; rr < 8; ++rr) C.KVC[(size_t)(r0 + rr) * 64 + lane] = (bf16)(pk2(acc[rr], 0.f) & 0xffffu);
        __builtin_amdgcn_fence(__ATOMIC_RELEASE, "wavefront"); __builtin_amdgcn_wave_barrier(); __builtin_amdgcn_fence(__ATOMIC_ACQUIRE, "wavefront");
    }
}

DI void qk_tile64(const LAS unsigned char* Kt, const bf16x8 (&qr)[4], f32x16& p0, f32x16& p1, int r32, int hi) {
    const LAS unsigned char* kb = Kt + hi * 1024 + r32 * 16;
#pragma unroll
    for (int d0 = 0; d0 < 4; ++d0) {
        const bf16x8 b0 = *(const LAS bf16x8*)(kb + d0 * 2048), b1 = *(const LAS bf16x8*)(kb + d0 * 2048 + 512);
        p0 = MFMA32(b0, qr[d0], p0); p1 = MFMA32(b1, qr[d0], p1);
    }
}
DI s16x4 vtr(const LAS unsigned char* p) { return __builtin_bit_cast(s16x4, __builtin_amdgcn_ds_read_tr16_b64_v4i16((LAS s16x4*)p)); }
DI bf16x8 pack_p(const f32x16& p, int s) {
    v4u w; w.x = pk2(p[8 * s + 0], p[8 * s + 1]); w.y = pk2(p[8 * s + 2], p[8 * s + 3]); w.z = pk2(p[8 * s + 4], p[8 * s + 5]); w.w = pk2(p[8 * s + 6], p[8 * s + 7]);
    return __builtin_bit_cast(bf16x8, w);
}
struct Sm { float m, l; f32x16 o0, o1; };
DI void softmax_pv64(const LAS unsigned char* Vt, f32x16& p0, f32x16& p1, Sm& st, LAS float* wsf, int lane, int r32, int hi) {
    float mx = fmaxf(p0[0], p1[0]);
#pragma unroll
    for (int r = 1; r < 16; ++r) mx = fmaxf(mx, fmaxf(p0[r], p1[r]));
    mx = fmaxf(mx, __shfl_xor(mx, 32));
    const float mn = fmaxf(st.m, mx);
    const float alpha = ex2(st.m - mn);
    st.m = mn;
    float ps = 0.f;
#pragma unroll
    for (int r = 0; r < 16; ++r) { p0[r] = ex2(p0[r] - mn); p1[r] = ex2(p1[r] - mn); ps += p0[r] + p1[r]; }
    st.l = st.l * alpha + ps;
    if (__any(alpha != 1.f)) {
        if (hi == 0) wsf[r32] = alpha;
        __builtin_amdgcn_fence(__ATOMIC_RELEASE, "wavefront"); __builtin_amdgcn_wave_barrier(); __builtin_amdgcn_fence(__ATOMIC_ACQUIRE, "wavefront");
#pragma unroll
        for (int k4 = 0; k4 < 4; ++k4) { const f32x4 a = *(const LAS f32x4*)(wsf + 8 * k4 + 4 * hi);
#pragma unroll
            for (int e = 0; e < 4; ++e) { st.o0[4 * k4 + e] *= a[e]; st.o1[4 * k4 + e] *= a[e]; } }
        __builtin_amdgcn_fence(__ATOMIC_RELEASE, "wavefront"); __builtin_amdgcn_wave_barrier(); __builtin_amdgcn_fence(__ATOMIC_ACQUIRE, "wavefront");
    }
    const bf16x8 pa0 = pack_p(p0, 0), pa1 = pack_p(p0, 1), pa2 = pack_p(p1, 0), pa3 = pack_p(p1, 1);
    const LAS unsigned char* vp = Vt + ((lane >> 4) & 1) * 32 + (lane & 3) * 8 + (4 * hi + ((lane & 15) >> 2)) * 64;
#pragma unroll
    for (int db = 0; db < 2; ++db) {
        f32x16 o = db ? st.o1 : st.o0;
#pragma unroll
        for (int s = 0; s < 4; ++s) {
            const s16x4 lo = vtr(vp + db * 4096 + s * 1024), hh = vtr(vp + db * 4096 + s * 1024 + 512);
            const bf16x8 vf = __builtin_shufflevector(lo, hh, 0, 1, 2, 3, 4, 5, 6, 7);
            o = MFMA32(s == 0 ? pa0 : (s == 1 ? pa1 : (s == 2 ? pa2 : pa3)), vf, o);
        }
        if (db) st.o1 = o; else st.o0 = o;
    }
}
DI void dma_kv64(const bf16* Ksrc, const bf16* Vsrc, size_t pitch, LAS unsigned char* Kd, LAS unsigned char* Vd, int wid, int lane) {
    glds16(Ksrc + (size_t)lane * pitch + wid * 8, Kd + wid * 1024);
    glds16(Vsrc + (size_t)(16 * (wid & 3) + (lane >> 2)) * pitch + (wid >> 2) * 32 + (lane & 3) * 8, Vd + wid * 1024);
}
DI void fold_branch(const Sm& st, float f, f32x16& fin0, f32x16& fin1, LAS float* wsf, int r32, int hi) {
    if (hi == 0) wsf[r32] = f;
    __builtin_amdgcn_fence(__ATOMIC_RELEASE, "wavefront"); __builtin_amdgcn_wave_barrier(); __builtin_amdgcn_fence(__ATOMIC_ACQUIRE, "wavefront");
#pragma unroll
    for (int k4 = 0; k4 < 4; ++k4) { const f32x4 a = *(const LAS f32x4*)(wsf + 8 * k4 + 4 * hi);
#pragma unroll
        for (int e = 0; e < 4; ++e) { fin0[4 * k4 + e] += st.o0[4 * k4 + e] * a[e]; fin1[4 * k4 + e] += st.o1[4 * k4 + e] * a[e]; } }
    __builtin_amdgcn_fence(__ATOMIC_RELEASE, "wavefront"); __builtin_amdgcn_wave_barrier(); __builtin_amdgcn_fence(__ATOMIC_ACQUIRE, "wavefront");
}

DI void nsa_unit(const Ctx& C, LAS unsigned char* lds, int b, int g, int qb) {
    int tid = threadIdx.x; asm volatile("" : "+v"(tid));
    const int lane = tid & 63, wid = __builtin_amdgcn_readfirstlane(tid >> 6), r32 = lane & 31, hi = lane >> 5;
    const int j = wid & 3, th = wid >> 2, head = 4 * g + j;
    const int tl = 32 * th + r32, t = 64 * qb + tl;
    const size_t row0 = (size_t)b * SEQ + 64 * qb;
    LAS unsigned char* Kb = lds;
    LAS unsigned char* Vb = lds + 32768;
    LAS float* impw = (LAS float*)(lds + 65536);
    LAS float* wsf = (LAS float*)(lds + LDS_MISC) + wid * 64;
    LAS unsigned char* selb = lds + LDS_MISC + 2048;
    LAS float* sc = (LAS float*)lds;
    LAS float* stg = (LAS float*)lds;
    const float SC = 0.125f * LOG2E;
    const bf16* prow = C.PROJ + (row0 + tl) * DINP;
    bf16x8 qr[4];
#pragma unroll
    for (int d0 = 0; d0 < 4; ++d0) qr[d0] = *(const bf16x8*)(prow + C_NQ + head * 64 + 16 * d0 + 8 * hi);
    const float g0 = fsigmoid(bf2f(prow[C_NG + head * 3 + 0])), g1 = fsigmoid(bf2f(prow[C_NG + head * 3 + 1])), g2 = fsigmoid(bf2f(prow[C_NG + head * 3 + 2]));
    f32x16 fin0, fin1;
#pragma unroll
    for (int r = 0; r < 16; ++r) { fin0[r] = 0.f; fin1[r] = 0.f; }
    const int bg = b * 4 + g;

    const int nkt = ((4 * qb + 2) >> 6) + 1;
    __syncthreads();
    for (int kt = 0; kt < nkt; ++kt)
        dma_kv64(C.KVC + ((size_t)bg * 256 + 64 * kt) * 64, C.KVC + ((size_t)4096 + bg * 256 + 64 * kt) * 64, 64, Kb + kt * 8192, Vb + kt * 8192, wid, lane);
    for (int idx = lane; idx < 32 * 66; idx += 64) impw[(j * 64 + 32 * th) * 66 + idx] = 0.f;
    VM_WAIT();
    __syncthreads();
    const int climit = (t >= 31) ? ((t - 31) >> 4) : -1;
    Sm st; st.m = NEGV; st.l = 0.f;
#pragma unroll
    for (int r = 0; r < 16; ++r) { st.o0[r] = 0.f; st.o1[r] = 0.f; }
    for (int kt = 0; kt < nkt; ++kt) {
        f32x16 p0, p1;
#pragma unroll
        for (int r = 0; r < 16; ++r) { p0[r] = 0.f; p1[r] = 0.f; }
        qk_tile64(Kb + kt * 8192, qr, p0, p1, r32, hi);
#pragma unroll
        for (int r = 0; r < 16; ++r) { const int c = 64 * kt + crow(r, hi); p0[r] = (c <= climit) ? p0[r] * SC : NEGV; p1[r] = (c + 32 <= climit) ? p1[r] * SC : NEGV; }
        softmax_pv64(Vb + kt * 8192, p0, p1, st, wsf, lane, r32, hi);
    }
    {
        const float l = st.l + __shfl_xor(st.l, 32);
        const float inv_l = (climit >= 0) ? 1.f / l : 0.f;
        fold_branch(st, g0 * inv_l, fin0, fin1, wsf, r32, hi);
        LAS float* myimp = impw + (j * 64 + tl) * 66;
        for (int kt = 0; kt < nkt; ++kt) {
            f32x16 p0, p1;
#pragma unroll
            for (int r = 0; r < 16; ++r) { p0[r] = 0.f; p1[r] = 0.f; }
            qk_tile64(Kb + kt * 8192, qr, p0, p1, r32, hi);
#pragma unroll
            for (int r = 0; r < 16; ++r) { const int c = 64 * kt + crow(r, hi); p0[r] = (c <= climit) ? ex2(p0[r] * SC - st.m) * inv_l : 0.f; p1[r] = (c + 32 <= climit) ? ex2(p1[r] * SC - st.m) * inv_l : 0.f; }
#pragma unroll
            for (int hf = 0; hf < 2; ++hf)
#pragma unroll
                for (int k4 = 0; k4 < 4; ++k4) {
                    const int n = 16 * kt + 8 * hf + 2 * k4 + hi;
                    const float a0 = hf ? p1[4 * k4] : p0[4 * k4], a1 = hf ? p1[4 * k4 + 1] : p0[4 * k4 + 1], a2 = hf ? p1[4 * k4 + 2] : p0[4 * k4 + 2], a3 = hf ? p1[4 * k4 + 3] : p0[4 * k4 + 3];
                    myimp[n] += (a0 + a1) + (a2 + 0.5f * a3);
                    __builtin_amdgcn_fence(__ATOMIC_RELEASE, "wavefront"); __builtin_amdgcn_wave_barrier(); __builtin_amdgcn_fence(__ATOMIC_ACQUIRE, "wavefront");
                    myimp[n + 1] += 0.5f * a3;
                    __builtin_amdgcn_fence(__ATOMIC_RELEASE, "wavefront"); __builtin_amdgcn_wave_barrier(); __builtin_amdgcn_fence(__ATOMIC_ACQUIRE, "wavefront");
                }
        }
    }
    __syncthreads();
    {
        const int tok = tid & 63, part = tid >> 6;
        float cand[8];
#pragma unroll
        for (int e = 0; e < 8; ++e) { const int n = part * 8 + e;
            const float imp = ((impw[(0 * 64 + tok) * 66 + n] + impw[(1 * 64 + tok) * 66 + n]) + impw[(2 * 64 + tok) * 66 + n]) + impw[(3 * 64 + tok) * 66 + n];
            const bool forced = (n == 0) || (n == qb) || (n == qb - 1);
            cand[e] = (n <= qb) ? (imp + (forced ? 1000.f : 0.f)) : NEGV; }
        __syncthreads();
#pragma unroll
        for (int e = 0; e < 8; ++e) sc[tok * 68 + part * 8 + e] = cand[e];
        __syncthreads();
        int cnt[8];
#pragma unroll
        for (int e = 0; e < 8; ++e) cnt[e] = 0;
        for (int n2 = 0; n2 <= qb; ++n2) { const float v = sc[tok * 68 + n2];
#pragma unroll
            for (int e = 0; e < 8; ++e) { const int n = part * 8 + e; cnt[e] += ((v > cand[e]) || (v == cand[e] && n2 < n)) ? 1 : 0; } }
        unsigned byte = 0;
#pragma unroll
        for (int e = 0; e < 8; ++e) { const int n = part * 8 + e; if (n <= qb && cnt[e] < 16) byte |= (1u << e); }
        selb[tok * 8 + part] = (unsigned char)byte;
        __syncthreads();
    }
    unsigned long long mysel, un;
    { const v2u w = *(const LAS v2u*)(selb + tl * 8); mysel = ((unsigned long long)w.y << 32) | w.x;
      const v2u a = *(const LAS v2u*)(selb + lane * 8); unsigned lo = a.x, hh = a.y;
#pragma unroll
      for (int o = 1; o < 64; o <<= 1) { lo |= __shfl_xor(lo, o); hh |= __shfl_xor(hh, o); }
      un = ((unsigned long long)__builtin_amdgcn_readfirstlane(hh) << 32) | (unsigned)__builtin_amdgcn_readfirstlane(lo); }

    {
        const bf16* Kg = C.PROJ + (size_t)b * SEQ * DINP + C_KS + 64 * g;
        const bf16* Vg = C.PROJ + (size_t)b * SEQ * DINP + C_VS + 64 * g;
        st.m = NEGV; st.l = 0.f;
#pragma unroll
        for (int r = 0; r < 16; ++r) { st.o0[r] = 0.f; st.o1[r] = 0.f; }
        unsigned long long um = un; int idx = 0;
        { const int n = __builtin_ctzll(um); dma_kv64(Kg + (size_t)64 * n * DINP, Vg + (size_t)64 * n * DINP, DINP, Kb, Vb, wid, lane); }
        while (um) {
            const int n = __builtin_ctzll(um); um &= um - 1;
            VM_WAIT(); __syncthreads();
            if (um) { const int n2 = __builtin_ctzll(um); const int bo = ((idx + 1) & 1) * 8192; dma_kv64(Kg + (size_t)64 * n2 * DINP, Vg + (size_t)64 * n2 * DINP, DINP, Kb + bo, Vb + bo, wid, lane); }
            const bool seln = (mysel >> n) & 1ull;
            if (__any(seln)) {
                const int bo = (idx & 1) * 8192;
                f32x16 p0, p1;
#pragma unroll
                for (int r = 0; r < 16; ++r) { p0[r] = 0.f; p1[r] = 0.f; }
                qk_tile64(Kb + bo, qr, p0, p1, r32, hi);
                const int lim = (n == qb) ? tl : 64;
#pragma unroll
                for (int r = 0; r < 16; ++r) { const int kv = crow(r, hi); p0[r] = (seln && kv <= lim) ? p0[r] * SC : NEGV; p1[r] = (seln && kv + 32 <= lim) ? p1[r] * SC : NEGV; }
                softmax_pv64(Vb + bo, p0, p1, st, wsf, lane, r32, hi);
            }
            ++idx;
        }
        const float l = st.l + __shfl_xor(st.l, 32);
        fold_branch(st, g1 / l, fin0, fin1, wsf, r32, hi);
    }
    __syncthreads();
    {
        const bf16* Kg = C.PROJ + (size_t)b * SEQ * DINP + C_KW + 64 * g;
        const bf16* Vg = C.PROJ + (size_t)b * SEQ * DINP + C_VW + 64 * g;
        st.m = NEGV; st.l = 0.f;
#pragma unroll
        for (int r = 0; r < 16; ++r) { st.o0[r] = 0.f; st.o1[r] = 0.f; }
        const int n0 = qb >= 8 ? qb - 8 : 0;
        dma_kv64(Kg + (size_t)64 * n0 * DINP, Vg + (size_t)64 * n0 * DINP, DINP, Kb, Vb, wid, lane);
        for (int n = n0, idx = 0; n <= qb; ++n, ++idx) {
            VM_WAIT(); __syncthreads();
            if (n < qb) { const int bo = ((idx + 1) & 1) * 8192; dma_kv64(Kg + (size_t)64 * (n + 1) * DINP, Vg + (size_t)64 * (n + 1) * DINP, DINP, Kb + bo, Vb + bo, wid, lane); }
            const int bo = (idx & 1) * 8192;
            f32x16 p0, p1;
#pragma unroll
            for (int r = 0; r < 16; ++r) { p0[r] = 0.f; p1[r] = 0.f; }
            qk_tile64(Kb + bo, qr, p0, p1, r32, hi);
            const int hi_lim = (n == qb) ? tl : 64;
            const int lo_lim = (n == qb - 8) ? tl : -1;
#pragma unroll
            for (int r = 0; r < 16; ++r) { const int kv = crow(r, hi); p0[r] = (kv <= hi_lim && kv > lo_lim) ? p0[r] * SC : NEGV; p1[r] = (kv + 32 <= hi_lim && kv + 32 > lo_lim) ? p1[r] * SC : NEGV; }
            softmax_pv64(Vb + bo, p0, p1, st, wsf, lane, r32, hi);
        }
        const float l = st.l + __shfl_xor(st.l, 32);
        fold_branch(st, g2 / l, fin0, fin1, wsf, r32, hi);
    }
    __syncthreads();
#pragma unroll
    for (int r = 0; r < 16; ++r) { const int tok = 32 * th + crow(r, hi); stg[tok * STG_PITCH + j * 64 + r32] = fin0[r]; stg[tok * STG_PITCH + j * 64 + 32 + r32] = fin1[r]; }
    __syncthreads();
    {
        const int tok = tid >> 3, seg = tid & 7;
        const bf16* nz = C.PROJ + (row0 + tok) * DINP + C_NZ + g * 256 + seg * 32;
        bf16* dst = C.MIX + (row0 + tok) * DM + 1024 + g * 256 + seg * 32;
#pragma unroll
        for (int q = 0; q < 4; ++q) {
            float z[8], o[8]; unpack8(*(const v4u*)(nz + 8 * q), z);
            const f32x4 a = *(const LAS f32x4*)(stg + tok * STG_PITCH + seg * 32 + 8 * q), c = *(const LAS f32x4*)(stg + tok * STG_PITCH + seg * 32 + 8 * q + 4);
            o[0] = a.x * fsilu(z[0]); o[1] = a.y * fsilu(z[1]); o[2] = a.z * fsilu(z[2]); o[3] = a.w * fsilu(z[3]);
            o[4] = c.x * fsilu(z[4]); o[5] = c.y * fsilu(z[5]); o[6] = c.z * fsilu(z[6]); o[7] = c.w * fsilu(z[7]);
            *(v4u*)(dst + 8 * q) = pack8(o);
        }
    }
    __syncthreads();
}

DI void mlstm_unit(const Ctx& C, LAS unsigned char* lds, int b, int h, int iq) {
    int tid = threadIdx.x; asm volatile("" : "+v"(tid));
    const int lane = tid & 63, wid = __builtin_amdgcn_readfirstlane(tid >> 6), r32 = lane & 31, hi = lane >> 5;
    const int rg = wid & 3, dvh = wid >> 2, bh = b * 4 + h;
    const int ql = 32 * rg + r32, qabs = 128 * iq + ql;
    const size_t rowb = (size_t)b * SEQ;
    LAS float* wsf = (LAS float*)(lds + LDS_MISC) + wid * 64;
    LAS float* stg = (LAS float*)lds;
    bf16x8 qf[16];
    { const bf16* qp = C.QC + (rowb + qabs) * 1024 + h * 256 + 8 * hi;
#pragma unroll
      for (int ks = 0; ks < 16; ++ks) qf[ks] = *(const bf16x8*)(qp + 16 * ks); }
    const float mx2 = C.mx2[(size_t)bh * SEQ + qabs];
    const float* u2p = C.u2 + (size_t)bh * SEQ;
    f32x16 o[4];
#pragma unroll
    for (int d = 0; d < 4; ++d)
#pragma unroll
        for (int r = 0; r < 16; ++r) o[d][r] = 0.f;
    float den = 0.f;
    const int ntile = 2 * (iq + 1);
    const bf16* Kg = C.KC + rowb * 1024 + h * 256;
    const bf16* Vg = C.PROJ + rowb * DINP + C_MV + h * 256;
#define ML_DMA(tt, buf) do { LAS unsigned char* Kd_ = lds + (buf) * 65536; LAS unsigned char* Vd_ = Kd_ + 32768; \
        _Pragma("unroll") for (int c4 = 0; c4 < 4; ++c4) { const int c_ = wid + 8 * c4; \
            glds16(Kg + (size_t)(64 * (tt) + lane) * 1024 + c_ * 8, Kd_ + c_ * 1024); \
            glds16(Vg + (size_t)(64 * (tt) + 16 * (c_ & 3) + (lane >> 2)) * DINP + (c_ >> 2) * 32 + (lane & 3) * 8, Vd_ + c_ * 1024); } } while (0)
    __syncthreads();
    ML_DMA(0, 0);
    for (int tt = 0; tt < ntile; ++tt) {
        VM_WAIT(); __syncthreads();
        if (tt + 1 < ntile) ML_DMA(tt + 1, (tt + 1) & 1);
        const LAS unsigned char* Kt = lds + (tt & 1) * 65536; const LAS unsigned char* Vt = Kt + 32768;
        const int kv0 = 64 * tt - 128 * iq;
        if (kv0 > 32 * rg + 31) continue;
        f32x16 p0, p1;
#pragma unroll
        for (int r = 0; r < 16; ++r) { p0[r] = 0.f; p1[r] = 0.f; }
        { const LAS unsigned char* kb = Kt + hi * 1024 + r32 * 16;
#pragma unroll
          for (int ks = 0; ks < 16; ++ks) { const bf16x8 b0 = *(const LAS bf16x8*)(kb + ks * 2048), b1 = *(const LAS bf16x8*)(kb + ks * 2048 + 512);
              p0 = MFMA32(b0, qf[ks], p0); p1 = MFMA32(b1, qf[ks], p1); } }
        const int lim = ql - kv0;
        float ps = 0.f;
#pragma unroll
        for (int k4 = 0; k4 < 4; ++k4) {
            const f32x4 ua = *(const f32x4*)(u2p + 64 * tt + 8 * k4 + 4 * hi), ub = *(const f32x4*)(u2p + 64 * tt + 32 + 8 * k4 + 4 * hi);
#pragma unroll
            for (int e = 0; e < 4; ++e) { const int r = 4 * k4 + e, kv = 8 * k4 + 4 * hi + e;
                const float wa = (kv <= lim) ? ex2(ua[e] - mx2) * p0[r] : 0.f, wb = (kv + 32 <= lim) ? ex2(ub[e] - mx2) * p1[r] : 0.f;
                p0[r] = wa; p1[r] = wb; ps += wa + wb; }
        }
        den += ps;
        const bf16x8 pa0 = pack_p(p0, 0), pa1 = pack_p(p0, 1), pa2 = pack_p(p1, 0), pa3 = pack_p(p1, 1);
        const LAS unsigned char* vp = Vt + (4 * dvh) * 4096 + ((lane >> 4) & 1) * 32 + (lane & 3) * 8 + (4 * hi + ((lane & 15) >> 2)) * 64;
#pragma unroll
        for (int db = 0; db < 4; ++db) {
#pragma unroll
            for (int s = 0; s < 4; ++s) {
                const s16x4 lo = vtr(vp + db * 4096 + s * 1024), hh = vtr(vp + db * 4096 + s * 1024 + 512);
                const bf16x8 vf = __builtin_shufflevector(lo, hh, 0, 1, 2, 3, 4, 5, 6, 7);
                o[db] = MFMA32(s == 0 ? pa0 : (s == 1 ? pa1 : (s == 2 ? pa2 : pa3)), vf, o[db]);
            }
        }
    }
#undef ML_DMA
    den += __shfl_xor(den, 32);
    const float f = 1.f / fmaxf(fabsf(den), 1.f);
    if (hi == 0) wsf[r32] = f;
    __builtin_amdgcn_fence(__ATOMIC_RELEASE, "wavefront"); __builtin_amdgcn_wave_barrier(); __builtin_amdgcn_fence(__ATOMIC_ACQUIRE, "wavefront");
    float fr[16];
#pragma unroll
    for (int k4 = 0; k4 < 4; ++k4) { const f32x4 a = *(const LAS f32x4*)(wsf + 8 * k4 + 4 * hi); fr[4 * k4] = a.x; fr[4 * k4 + 1] = a.y; fr[4 * k4 + 2] = a.z; fr[4 * k4 + 3] = a.w; }
    __syncthreads();
#pragma unroll
    for (int db = 0; db < 4; ++db)
#pragma unroll
        for (int r = 0; r < 16; ++r) stg[(32 * rg + crow(r, hi)) * STG_PITCH + 128 * dvh + 32 * db + r32] = o[db][r] * fr[r];
    __syncthreads();
    {
        const int row = tid >> 2, seg = tid & 3;
        const LAS float* sp = stg + row * STG_PITCH + seg * 64;
        float s1 = 0.f;
#pragma unroll
        for (int q = 0; q < 16; ++q) { const f32x4 a = *(const LAS f32x4*)(sp + 4 * q); s1 += (a.x + a.y) + (a.z + a.w); }
        s1 += __shfl_xor(s1, 1); s1 += __shfl_xor(s1, 2);
        const float mu = s1 * (1.f / 256.f);
        float s2 = 0.f;
#pragma unroll
        for (int q = 0; q < 16; ++q) { const f32x4 a = *(const LAS f32x4*)(sp + 4 * q); const float d0 = a.x - mu, d1 = a.y - mu, d2 = a.z - mu, d3 = a.w - mu; s2 += (d0 * d0 + d1 * d1) + (d2 * d2 + d3 * d3); }
        s2 += __shfl_xor(s2, 1); s2 += __shfl_xor(s2, 2);
        const float rstd = 1.f / sqrtf(s2 * (1.f / 256.f) + EPSV);
        const size_t grow = rowb + 128 * iq + row;
        const bf16* mo = C.PROJ + grow * DINP + C_MO + h * 256 + seg * 64;
        const bf16* mz = C.PROJ + grow * DINP + C_MZ + h * 256 + seg * 64;
        const float* gn = C.m_norm_g + h * 256 + seg * 64;
        bf16* dst = C.MIX + grow * DM + h * 256 + seg * 64;
#pragma unroll
        for (int q = 0; q < 8; ++q) {
            float vo[8], vz[8], y[8]; unpack8(*(const v4u*)(mo + 8 * q), vo); unpack8(*(const v4u*)(mz + 8 * q), vz);
            const f32x4 a = *(const LAS f32x4*)(sp + 8 * q), c = *(const LAS f32x4*)(sp + 8 * q + 4);
            const f32x4 ga = *(const f32x4*)(gn + 8 * q), gc = *(const f32x4*)(gn + 8 * q + 4);
            const float hv[8] = {a.x, a.y, a.z, a.w, c.x, c.y, c.z, c.w}, gg[8] = {ga.x, ga.y, ga.z, ga.w, gc.x, gc.y, gc.z, gc.w};
#pragma unroll
            for (int e = 0; e < 8; ++e) y[e] = (hv[e] - mu) * rstd * gg[e] * fsigmoid(vo[e]) * fsilu(vz[e]);
            *(v4u*)(dst + 8 * q) = pack8(y);
        }
    }
    __syncthreads();
}

DI void phase7(const Ctx& C) {
    int tid = threadIdx.x; asm volatile("" : "+v"(tid));
    const int lane = tid & 63, wave = __builtin_amdgcn_readfirstlane(tid >> 6);
    const int gw = C.vcu * NWAVES + wave, NGW = C.G * NWAVES;
    for (int m = gw; m < NT; m += NGW) {
        float ps = (lane < 32) ? C.x2ss[(size_t)m * 32 + lane] : 0.f;
        ps = wave_sum(ps);
        const float rstd = 1.f / sqrtf(ps * (1.f / DM) + EPSV);
        f32x4* xr = (f32x4*)(C.out + (size_t)m * DM) + lane;
#pragma unroll
        for (int j = 0; j < 8; ++j) { const f32x4 v = xr[64 * j]; const f32x4 g = *((const f32x4*)C.final_g + lane + 64 * j);
            f32x4 o; o.x = v.x * rstd * g.x; o.y = v.y * rstd * g.y; o.z = v.z * rstd * g.z; o.w = v.w * rstd * g.w; xr[64 * j] = o; }
    }
}

struct Args { const void* in[21]; float* out; unsigned char* ws; };
__global__ void __launch_bounds__(NTHREADS, 2) mega_fwd(Args a) {
    extern __shared__ __attribute__((aligned(16))) unsigned char lds_raw[];
    LAS unsigned char* lds = (LAS unsigned char*)lds_raw;
    cg::grid_group grid = cg::this_grid();
    Ctx C;
    C.x = (const float*)a.in[0]; C.p = (const float*)a.in[1]; C.positions = (const int*)a.in[2]; C.norm_g = (const float*)a.in[3]; C.w_in = (const float*)a.in[4];
    C.conv_w = (const float*)a.in[5]; C.conv_b = (const float*)a.in[6]; C.b_ig = (const float*)a.in[7]; C.b_fg = (const float*)a.in[8]; C.m_norm_g = (const float*)a.in[9];
    C.pos_k = (const float*)a.in[10]; C.pos_v = (const float*)a.in[11]; C.ck_w1 = (const float*)a.in[12]; C.ck_w2 = (const float*)a.in[13]; C.cv_w1 = (const float*)a.in[14]; C.cv_w2 = (const float*)a.in[15];
    C.w_out = (const float*)a.in[16]; C.gate_w = (const float*)a.in[17]; C.ple_w = (const float*)a.in[18]; C.ple_g = (const float*)a.in[19]; C.final_g = (const float*)a.in[20];
    C.out = a.out;
    unsigned char* ws = a.ws;
    C.gates = (float*)(ws + WS_GATES); C.rope = (float*)(ws + WS_ROPE); C.u2 = (float*)(ws + WS_U2); C.mx2 = (float*)(ws + WS_MX2); C.plss = (float*)(ws + WS_PLSS); C.x2ss = (float*)(ws + WS_X2SS);
    C.WoutT = (bf16*)(ws + WS_WOUT); C.WgateT = (bf16*)(ws + WS_WGATE); C.WpleT = (bf16*)(ws + WS_WPLE); C.Wc1T = (bf16*)(ws + WS_WC1); C.HID = (bf16*)(ws + WS_HID); C.KVC = (bf16*)(ws + WS_KVC);
    C.PB = (bf16*)(ws + WS_PB); C.WinT = (bf16*)(ws + WS_WIN); C.CA = (bf16*)(ws + WS_WIN); C.XN = (bf16*)(ws + WS_XN); C.QC = (bf16*)(ws + WS_XN); C.KC = (bf16*)(ws + WS_XN + 32 * MiB);
    C.PROJ = (bf16*)(ws + WS_PROJ); C.PL = (bf16*)(ws + WS_PROJ); C.X1B = (bf16*)(ws + WS_PROJ + 64 * MiB); C.MIX = (bf16*)(ws + WS_MIX);
    C.G = gridDim.x; { const int bx = blockIdx.x; C.vcu = (C.G % 8 == 0) ? (bx % 8) * (C.G / 8) + bx / 8 : bx; }

#ifndef PHMASK
#define PHMASK 0xffff
#endif
#if PHMASK & 1
    phase0(C, lds);
#endif
    grid.sync();
#if PHMASK & 2
    { pg8::Gemm g{C.XN, C.WinT, NT, DINP, DM}; pg8::StaticOrder S; S.init(NT, DINP, C.G, (int)blockIdx.x);
      EpiProj E{C.PROJ, C.gates};
      pg8::gemm_phase<EpiProj, pg8::StaticOrder, true, true>(lds, g, S, E); }
#endif
    grid.sync();
#if PHMASK & 4
    phase2(C, lds);
#endif
    grid.sync();
#if PHMASK & 8
    { pg8::Gemm g{C.CA, C.Wc1T, 8192, 256, DM}; pg8::StaticOrder S; S.init(8192, 256, C.G, (int)blockIdx.x);
      EpiCmp E{C.HID};
      pg8::gemm_phase<EpiCmp, pg8::StaticOrder, true, true>(lds, g, S, E); }
#endif
    grid.sync();
#if PHMASK & 16
    phase3b(C, lds);
#endif
    grid.sync();
    for (int v = C.vcu; v < 256; v += C.G) {
        const int bg = v >> 4, s = v & 15, b = bg >> 2, gh = bg & 3;
#if PHMASK & 32
        for (int k = 0; k < 2; ++k) mlstm_unit(C, lds, b, gh, k == 0 ? 31 - s : s);
#endif
#if PHMASK & 64
        for (int k = 0; k < 4; ++k) nsa_unit(C, lds, b, gh, k == 0 ? 63 - s : (k == 1 ? 32 + s : (k == 2 ? 31 - s : s)));
#endif
    }
    grid.sync();
#if PHMASK & 128
    { pg8::Gemm g{C.MIX, C.WoutT, NT, DM, DM}; pg8::StaticOrder S; S.init(NT, DM, C.G, (int)blockIdx.x);
      EpiX1 E{C.x, C.out, C.X1B};
      pg8::gemm_phase<EpiX1, pg8::StaticOrder, true, true>(lds, g, S, E); }
#endif
#if PHMASK & 256
    { pg8::Gemm g{C.PB, C.WpleT, NT, DM, PLE}; pg8::StaticOrder S; S.init(NT, DM, C.G, (int)blockIdx.x);
      EpiPl E{C.PL, C.plss};
      pg8::gemm_phase<EpiPl, pg8::StaticOrder, true, true>(lds, g, S, E); }
#endif
    grid.sync();
#if PHMASK & 512
    { pg8::Gemm g{C.X1B, C.WgateT, NT, DM, DM}; pg8::StaticOrder S; S.init(NT, DM, C.G, (int)blockIdx.x);
      EpiGate E{C.out, C.PL, C.plss, C.ple_g, C.x2ss};
      pg8::gemm_phase<EpiGate, pg8::StaticOrder, true, true>(lds, g, S, E); }
#endif
    grid.sync();
#if PHMASK & 1024
    phase7(C);
#endif
}

extern "C" void kernel_launch(void* const* d_in, const int* in_sizes, int n_in, void* d_out, int out_size, void* d_ws, size_t ws_size, hipStream_t stream) {
    static int grid = 0;
    if (grid == 0) {
        if (n_in != 21 || in_sizes[0] != NT * DM || out_size != NT * DM || ws_size < WS_END) {
            fprintf(stderr, "kernel_launch: unexpected problem (n_in %d, in0 %d, out %d, ws %zu); nothing launched\n", n_in, n_in > 0 ? in_sizes[0] : -1, out_size, ws_size); grid = -1; return; }
        int dev = 0, cus = 0, per_cu = 0;
        if (hipGetDevice(&dev) != hipSuccess || hipDeviceGetAttribute(&cus, hipDeviceAttributeMultiprocessorCount, dev) != hipSuccess) { grid = -1; return; }
        if (hipFuncSetAttribute((const void*)mega_fwd, hipFuncAttributeMaxDynamicSharedMemorySize, LDS_BYTES) != hipSuccess) { fprintf(stderr, "kernel_launch: hipFuncSetAttribute failed\n"); grid = -1; return; }
        if (hipOccupancyMaxActiveBlocksPerMultiprocessor(&per_cu, (const void*)mega_fwd, NTHREADS, LDS_BYTES) != hipSuccess || per_cu < 1) {
            fprintf(stderr, "kernel_launch: occupancy query says %d blocks/CU; nothing launched\n", per_cu); grid = -1; return; }
        grid = cus * 1;
        if (grid > 256) grid = 256;
    }
    if (grid < 0) return;
    Args a{};
    for (int i = 0; i < 21; ++i) a.in[i] = d_in[i];
    a.out = (float*)d_out; a.ws = (unsigned char*)d_ws;
    void* args[] = {&a};
    hipError_t e = hipLaunchCooperativeKernel((const void*)mega_fwd, dim3(grid), dim3(NTHREADS), args, LDS_BYTES, stream);
    if (e != hipSuccess) fprintf(stderr, "cooperative launch failed: %s (grid %d)\n", hipGetErrorString(e), grid);
}
```

```cpp
#include <hip/hip_runtime.h>
#include <hip/hip_cooperative_groups.h>
#include <cstdio>
#include <cstdint>
namespace cg = cooperative_groups;

namespace pg8 {
#define PG8_LAS __attribute__((address_space(3)))
typedef unsigned short bf16_t;
typedef short bf16x8 __attribute__((ext_vector_type(8)));
typedef float f32x4 __attribute__((ext_vector_type(4)));
typedef unsigned u32x4 __attribute__((ext_vector_type(4)));
constexpr int BM = 256, BK = 64, HALF = 128, HTB = HALF * BK * 2, STAGE_BYTES = 8 * HTB, NXCD = 8, WGM = 4;

__host__ __device__ __forceinline__ int lds_byte(int r, int c) { const int st = (r >> 4) * 2 + (c >> 5), rr = r & 15, cc = c & 31, ob = rr * 64 + cc * 2; return st * 1024 + (ob ^ (((ob >> 9) & 1) << 5)); }
__host__ __device__ __forceinline__ void stage_rc(int b, int& R, int& C) { const int st = b / 1024, sb = b % 1024, swz = sb ^ (((sb >> 9) & 1) << 5); R = (st >> 1) * 16 + swz / 64; C = (st & 1) * 32 + (swz % 64) / 2; }
__host__ __device__ __forceinline__ int perm32(int rho) { const int n = rho >> 4, i = rho & 15; return 8 * (i >> 2) + 4 * n + (i & 3); }

struct Unit { int pm, pn, ks; };
struct Gemm { const bf16_t* A; const bf16_t* Bt; int M, N, K, ld, lda; };

struct SplitKOrder {
    int nM, nwg, G, c;
    __host__ __device__ void init(int M, int nsplit, int G_, int c_) { nM = M / BM; nwg = nM * nsplit; G = G_; c = c_; }
    __host__ __device__ bool next(int i, Unit& u) const { const long L = (long)i * G + c; if (L >= nwg) return false; u.pm = (int)(L % nM); u.pn = 0; u.ks = (int)(L / nM); return true; }
    __device__ __forceinline__ size_t aoff(const Unit& u, const Gemm& g) const { return (size_t)u.pm * BM * (size_t)g.lda * 2 + (size_t)u.ks * g.K * 2; }
    __device__ __forceinline__ void a_ready(const Unit&) const {}
    __device__ __forceinline__ void done(const Unit&) const {}
    template <class A> __device__ __forceinline__ void preload(A&, int) const {}
};
struct StaticOrder {
    int nM, nN, nwg, G, c, wgm, i0;
    __host__ __device__ void init(int M, int N, int G_, int c_, int wgm_ = WGM, int i0_ = 0) { nM = M / BM; nN = N / BM; nwg = nM * nN; G = G_; c = c_; wgm = wgm_; i0 = i0_; }
    __host__ __device__ __forceinline__ bool next(int i, Unit& u) const {
        const long L = (long)(i + i0) * G + c; if (L >= nwg) return false;
        int wgid = (int)L; { const int q = nwg / NXCD, r = nwg % NXCD, xcd = wgid % NXCD, off = wgid / NXCD; wgid = (xcd < r ? xcd * (q + 1) : r * (q + 1) + (xcd - r) * q) + off; }
        const int nig = wgm * nN, gid = wgid / nig, fm = gid * wgm, gsz = (nM - fm) < wgm ? (nM - fm) : wgm;
        u.pm = fm + ((wgid % nig) % gsz); u.pn = (wgid % nig) / gsz; u.ks = 0; return true;
    }
    __device__ __forceinline__ size_t aoff(const Unit& u, const Gemm& g) const { return (size_t)u.pm * BM * (size_t)g.lda * 2; }
    __device__ __forceinline__ void a_ready(const Unit&) const {}
    __device__ __forceinline__ void done(const Unit&) const {}
    template <class A> __device__ __forceinline__ void preload(A&, int) const {}
};

template <class Epi, class Sched, bool ALIGN_EPI = false, bool SP2 = false>
__device__ __forceinline__ void gemm_phase(PG8_LAS unsigned char* lds, const Gemm g, const Sched& S, const Epi& E, int tid_in) {
    int tid = tid_in; asm volatile("" : "+v"(tid));
    const int wid = __builtin_amdgcn_readfirstlane(tid >> 6), lane = tid & 63, wr = wid >> 2, wc = wid & 3, fr = lane & 15, fq = lane >> 4;
    const int K = g.K, nt = K / BK, LD = g.ld;
    unsigned voffA[2], voffB[2];
#pragma unroll
    for (int i = 0; i < 2; ++i) { int R, C; stage_rc(tid * 16 + i * 8192, R, C); const int Rb = Epi::PERM ? ((R & ~31) + perm32(R & 31)) : R;
        voffA[i] = (unsigned)(R * g.lda + C) * 2u; voffB[i] = (unsigned)(Rb * LD + C) * 2u; }
    const size_t kstep = (size_t)(BK * 2);
    const size_t hstep = (size_t)HALF * LD * 2, hstepA = (size_t)HALF * g.lda * 2;
    const size_t tstep = 2 * hstep;
    const unsigned ldsw = (unsigned)wid * 1024u;
    const int aoff = lds_byte(wr * 64 + fr, fq * 8), boff = lds_byte(wc * 32 + fr, fq * 8);
#define PG8_SA(b, h) (((b) * 2 + (h)) * HTB)
#define PG8_SB(b, h) ((4 + (b) * 2 + (h)) * HTB)
#define PG8_STAGE(bufoff, gbase, voff) do { _Pragma("unroll") for (int _i = 0; _i < 2; ++_i) \
        __builtin_amdgcn_global_load_lds((const unsigned*)((const char*)(gbase) + (voff)[_i]), (PG8_LAS unsigned*)(lds + (bufoff) + ldsw + _i * 8192), 16, 0, 0); } while (0)
#define PG8_LDA(dst, b, h) do { _Pragma("unroll") for (int m = 0; m < 4; ++m) _Pragma("unroll") for (int k = 0; k < 2; ++k) dst[m][k] = *(const PG8_LAS bf16x8*)(lds + PG8_SA(b, h) + aoff + m * 2048 + k * 1024); } while (0)
#define PG8_LDB(dst, b, h) do { _Pragma("unroll") for (int n = 0; n < 2; ++n) _Pragma("unroll") for (int k = 0; k < 2; ++k) dst[n][k] = *(const PG8_LAS bf16x8*)(lds + PG8_SB(b, h) + boff + n * 2048 + k * 1024); } while (0)
#define PG8_MMA(ai, bj, At, Bt) do { __builtin_amdgcn_s_setprio(1); _Pragma("unroll") for (int m = 0; m < 4; ++m) _Pragma("unroll") for (int n = 0; n < 2; ++n) _Pragma("unroll") for (int k = 0; k < 2; ++k) \
        acc[ai][bj][m][n] = __builtin_amdgcn_mfma_f32_16x16x32_bf16(Bt[n][k], At[m][k], acc[ai][bj][m][n], 0, 0, 0); __builtin_amdgcn_s_setprio(0); } while (0)
#define PG8_WAIT_V(n) asm volatile("s_waitcnt vmcnt(" #n ")" ::: "memory")
#define PG8_WAIT_L(n) asm volatile("s_waitcnt lgkmcnt(" #n ")" ::: "memory")
#define PG8_BAR __builtin_amdgcn_s_barrier()
#define PG8_SCHED __builtin_amdgcn_sched_barrier(0)
    Unit cur, nxt; int ui = 0;
    if (!S.next(0, cur)) return;
    f32x4 acc[2][2][4][2];
#pragma unroll
    for (int a = 0; a < 2; ++a)
#pragma unroll
        for (int b = 0; b < 2; ++b)
#pragma unroll
            for (int m = 0; m < 4; ++m)
#pragma unroll
                for (int n = 0; n < 2; ++n) acc[a][b][m][n] = (f32x4){0.f, 0.f, 0.f, 0.f};
    S.preload(acc, tid);
    bf16x8 At[4][2], B0[2][2], B1[2][2];
    const char* cA = (const char*)g.A + S.aoff(cur, g); const char* cB = (const char*)g.Bt + (size_t)cur.pn * tstep + (size_t)cur.ks * K * 2;
    S.a_ready(cur);
    if constexpr (SP2) {
        PG8_STAGE(PG8_SB(0, 0), cB, voffB); PG8_STAGE(PG8_SB(0, 1), cB + hstep, voffB); PG8_STAGE(PG8_SA(0, 0), cA, voffA); PG8_STAGE(PG8_SA(0, 1), cA + hstepA, voffA);
        if (wr == 1) PG8_BAR;
        PG8_WAIT_V(2); PG8_BAR;
        PG8_STAGE(PG8_SB(1, 0), cB + kstep, voffB); PG8_STAGE(PG8_SA(1, 0), cA + kstep, voffA); PG8_STAGE(PG8_SB(1, 1), cB + hstep + kstep, voffB);
        PG8_WAIT_V(6); PG8_BAR;
    } else {
        PG8_STAGE(PG8_SB(0, 0), cB, voffB); PG8_STAGE(PG8_SA(0, 0), cA, voffA); PG8_STAGE(PG8_SB(0, 1), cB + hstep, voffB); PG8_STAGE(PG8_SA(0, 1), cA + hstepA, voffA);
        if (wr == 1) PG8_BAR;
        PG8_WAIT_V(4); PG8_BAR;
        PG8_STAGE(PG8_SB(1, 0), cB + kstep, voffB); PG8_STAGE(PG8_SA(1, 0), cA + kstep, voffA); PG8_STAGE(PG8_SB(1, 1), cB + hstep + kstep, voffB);
        PG8_WAIT_V(6); PG8_BAR;
    }
    for (;;) {
        const bool has_next = S.next(ui + 1, nxt);
        const char* nA = has_next ? (const char*)g.A + S.aoff(nxt, g) : cA; const char* nB = has_next ? (const char*)g.Bt + (size_t)nxt.pn * tstep + (size_t)nxt.ks * K * 2 : cB;
        for (int t = 0; t < nt; t += 2) {
            const bool last = (t == nt - 2);
            const char* a1 = cA + (size_t)(t + 1) * kstep;
            const char* a2 = last ? nA : cA + (size_t)(t + 2) * kstep; const char* b2 = last ? nB : cB + (size_t)(t + 2) * kstep;
            const char* a3 = a2 + kstep; const char* b3 = b2 + kstep;
            if (last && has_next) S.a_ready(nxt);
            if constexpr (SP2) {
            PG8_LDB(B0, 0, 0); PG8_LDB(B1, 0, 1); PG8_SCHED; PG8_LDA(At, 0, 0); PG8_STAGE(PG8_SA(1, 1), a1 + hstepA, voffA);
            PG8_WAIT_V(8); PG8_WAIT_L(0); PG8_BAR; PG8_MMA(0, 0, At, B0); PG8_MMA(0, 1, At, B1); PG8_BAR; PG8_SCHED;
            PG8_LDA(At, 0, 1); PG8_STAGE(PG8_SB(0, 0), b2, voffB); PG8_STAGE(PG8_SB(0, 1), b2 + hstep, voffB); PG8_STAGE(PG8_SA(0, 0), a2, voffA);
            PG8_WAIT_V(8); PG8_WAIT_L(0); PG8_BAR; PG8_MMA(1, 0, At, B0); PG8_MMA(1, 1, At, B1); PG8_BAR; PG8_SCHED;
            PG8_LDB(B0, 1, 0); PG8_LDB(B1, 1, 1); PG8_SCHED; PG8_LDA(At, 1, 0); PG8_STAGE(PG8_SA(0, 1), a2 + hstepA, voffA);
            PG8_WAIT_V(8); PG8_WAIT_L(0); PG8_BAR; PG8_MMA(0, 0, At, B0); PG8_MMA(0, 1, At, B1); PG8_BAR; PG8_SCHED;
            PG8_LDA(At, 1, 1); PG8_STAGE(PG8_SB(1, 0), b3, voffB); PG8_STAGE(PG8_SB(1, 1), b3 + hstep, voffB); PG8_STAGE(PG8_SA(1, 0), a3, voffA);
            PG8_WAIT_V(8); PG8_WAIT_L(0); PG8_BAR; PG8_MMA(1, 0, At, B0); PG8_MMA(1, 1, At, B1); PG8_BAR; PG8_SCHED;
            } else {
            PG8_LDB(B0, 0, 0); PG8_SCHED; PG8_LDA(At, 0, 0); PG8_STAGE(PG8_SA(1, 1), a1 + hstepA, voffA);
            PG8_WAIT_L(8); PG8_BAR; PG8_WAIT_L(0); PG8_MMA(0, 0, At, B0); PG8_BAR; PG8_SCHED;
            PG8_LDB(B1, 0, 1); PG8_STAGE(PG8_SB(0, 0), b2, voffB);
            PG8_BAR; PG8_WAIT_L(0); PG8_MMA(0, 1, At, B1); PG8_BAR;
            PG8_LDA(At, 0, 1); PG8_STAGE(PG8_SA(0, 0), a2, voffA);
            PG8_BAR; PG8_WAIT_L(0); PG8_MMA(1, 0, At, B0); PG8_BAR; PG8_SCHED;
            PG8_STAGE(PG8_SB(0, 1), b2 + hstep, voffB);
            PG8_WAIT_V(6); PG8_BAR; PG8_MMA(1, 1, At, B1); PG8_BAR;
            PG8_LDB(B0, 1, 0); PG8_SCHED; PG8_LDA(At, 1, 0); PG8_STAGE(PG8_SA(0, 1), a2 + hstepA, voffA);
            PG8_WAIT_L(8); PG8_BAR; PG8_WAIT_L(0); PG8_MMA(0, 0, At, B0); PG8_BAR; PG8_SCHED;
            PG8_LDB(B1, 1, 1); PG8_STAGE(PG8_SB(1, 0), b3, voffB);
            PG8_BAR; PG8_WAIT_L(0); PG8_MMA(0, 1, At, B1); PG8_BAR;
            PG8_LDA(At, 1, 1); PG8_STAGE(PG8_SA(1, 0), a3, voffA);
            PG8_BAR; PG8_WAIT_L(0); PG8_MMA(1, 0, At, B0); PG8_BAR; PG8_SCHED;
            PG8_STAGE(PG8_SB(1, 1), b3 + hstep, voffB);
            PG8_WAIT_V(6); PG8_BAR; PG8_MMA(1, 1, At, B1); PG8_BAR;
            }
        }
        if constexpr (ALIGN_EPI) { if (wr == 0) PG8_BAR; }
        E(acc, cur, wr, wc, fr, fq);
        if (!has_next) break;
#pragma unroll
        for (int a = 0; a < 2; ++a)
#pragma unroll
            for (int b = 0; b < 2; ++b)
#pragma unroll
                for (int m = 0; m < 4; ++m)
#pragma unroll
                    for (int n = 0; n < 2; ++n) acc[a][b][m][n] = (f32x4){0.f, 0.f, 0.f, 0.f};
        cur = nxt; cA = nA; cB = nB; ++ui;
        if constexpr (ALIGN_EPI) { if (wr == 1) PG8_BAR; }
    }
    PG8_WAIT_V(0);
    if constexpr (!ALIGN_EPI) { if (wr == 0) PG8_BAR; }
    PG8_BAR;
#undef PG8_SA
#undef PG8_SB
#undef PG8_STAGE
#undef PG8_LDA
#undef PG8_LDB
#undef PG8_MMA
#undef PG8_WAIT_V
#undef PG8_WAIT_L
#undef PG8_BAR
#undef PG8_SCHED
}
}

constexpr int NB = 4, SEQ = 4096, DM = 2048, NT = NB * SEQ, PLE = 256;
constexpr int MH = 4, MDH = 256;
constexpr int NHD = 64, NH = 16, NKV = 4;
constexpr int DIN = 8760, DINP = 8960;
constexpr int C_MQ = 0, C_MK = 1024, C_MV = 2048, C_MO = 3072, C_MZ = 4096, C_NQ = 5120, C_KC = 6144, C_VC = 6400, C_KS = 6656, C_VS = 6912,
              C_KW = 7168, C_VW = 7424, C_NZ = 7680, C_NG = 8704, C_GATE = 8752;
constexpr size_t PE = 524288;
constexpr size_t PO_MQK = 0, PO_MV = 64 * PE, PO_MG = 96 * PE, PO_NQ = 160 * PE, PO_KV6 = 192 * PE, PO_NZ = 240 * PE, PO_NG = 272 * PE;
constexpr size_t KVSZ = (size_t)4 * 4 * 4096 * 64;
constexpr float EPSV = 1e-6f, NEGV = -1e30f, LOG2E = 1.4426950408889634f;
constexpr int NWAVES = 8, NTHREADS = 512;
constexpr int LDS_BYTES = 147456;
constexpr int LDS_MISC = 135168;
constexpr int STG_PITCH = 260;

constexpr size_t MiB = 1u << 20;
constexpr size_t WS_GATES = 1 * MiB;
constexpr size_t WS_ROPE  = 2 * MiB;
constexpr size_t WS_U2    = 3 * MiB;
constexpr size_t WS_MX2   = 3 * MiB + 512 * 1024;
constexpr size_t WS_PLSS  = 32768;
constexpr size_t WS_X2SS  = 6 * MiB;
constexpr size_t WS_WOUT  = 8 * MiB;
constexpr size_t WS_WGATE = 16 * MiB;
constexpr size_t WS_WPLE  = 24 * MiB;
constexpr size_t WS_WC1   = 25 * MiB;
constexpr size_t WS_HID   = 26 * MiB;
constexpr size_t WS_KVC   = 30 * MiB;
constexpr size_t WS_PB    = 32 * MiB;
constexpr size_t WS_WIN   = 40 * MiB;
constexpr size_t WS_XN    = 76 * MiB;
constexpr size_t WS_PROJ  = 140 * MiB;
constexpr size_t WS_MIX   = 420 * MiB;
constexpr size_t WS_DN    = 484 * MiB;
constexpr size_t WS_NS    = 484 * MiB + 256 * 1024;
constexpr size_t WS_END   = 485 * MiB;

#define LAS __attribute__((address_space(3)))
#define DI __device__ __forceinline__
typedef unsigned short bf16;
typedef unsigned v4u __attribute__((ext_vector_type(4)));
typedef unsigned v2u __attribute__((ext_vector_type(2)));
typedef float f32x4 __attribute__((ext_vector_type(4)));
typedef float f32x16 __attribute__((ext_vector_type(16)));
typedef short bf16x8 __attribute__((ext_vector_type(8)));
typedef short s16x4 __attribute__((ext_vector_type(4)));
typedef float f32x2_t __attribute__((ext_vector_type(2)));
typedef __bf16 bf16x2_t __attribute__((ext_vector_type(2)));

DI unsigned pk2(float lo, float hi) { f32x2_t v = {lo, hi}; bf16x2_t b = __builtin_convertvector(v, bf16x2_t); return __builtin_bit_cast(unsigned, b); }
DI float bflo(unsigned w) { return __uint_as_float(w << 16); }
DI float bfhi(unsigned w) { return __uint_as_float(w & 0xffff0000u); }
DI float bf2f(bf16 h) { return __uint_as_float((unsigned)h << 16); }
DI float ex2(float x) { return __builtin_amdgcn_exp2f(x); }
DI float fsigmoid(float x) { return __builtin_amdgcn_rcpf(1.f + ex2(-LOG2E * x)); }
DI float fsilu(float x) { return x * fsigmoid(x); }
DI float fgelu_tanh(float x) { const float z = 0.7978845608028654f * (x + 0.044715f * x * x * x); return x * fsigmoid(2.f * z); }
DI float swap32_max(float m) { const auto rr = __builtin_amdgcn_permlane32_swap(__float_as_uint(m), __float_as_uint(m), false, false); return fmaxf(__uint_as_float(rr[0]), __uint_as_float(rr[1])); }
DI int crow(int r, int h) { return (r & 3) + 8 * (r >> 2) + 4 * h; }
DI void unpack8(v4u w, float (&f)[8]) { f[0] = bflo(w.x); f[1] = bfhi(w.x); f[2] = bflo(w.y); f[3] = bfhi(w.y); f[4] = bflo(w.z); f[5] = bfhi(w.z); f[6] = bflo(w.w); f[7] = bfhi(w.w); }
DI v4u pack8(const float (&f)[8]) { v4u w; w.x = pk2(f[0], f[1]); w.y = pk2(f[2], f[3]); w.z = pk2(f[4], f[5]); w.w = pk2(f[6], f[7]); return w; }
DI float wave_sum(float v) {
#pragma unroll
    for (int o = 1; o < 64; o <<= 1) v += __shfl_xor(v, o);
    return v;
}
DI void glds16(const void* gsrc, LAS unsigned char* dst_wave_uniform) {
    __builtin_amdgcn_global_load_lds((const unsigned*)gsrc, (LAS unsigned*)dst_wave_uniform, 16, 0, 0);
}
DI void glds16a(const void* gsrc, unsigned lds_dst) { unsigned keep;
    asm volatile("s_mov_b32 %0, m0\n\ts_mov_b32 m0, %2\n\ts_nop 0\n\tglobal_load_lds_dwordx4 %1, off\n\ts_mov_b32 m0, %0" : "=&s"(keep) : "v"(gsrc), "s"(lds_dst) : "memory"); }
template <int IMM> DI void glds16s(const void* sbase, unsigned voff, unsigned lds_dst) { unsigned keep;
    asm volatile("s_mov_b32 %0, m0\n\ts_mov_b32 m0, %3\n\ts_nop 0\n\tglobal_load_lds_dwordx4 %1, %2 offset:%c4\n\ts_mov_b32 m0, %0" : "=&s"(keep) : "v"(voff), "s"(sbase), "s"(lds_dst), "i"(IMM) : "memory"); }
DI unsigned lds_u32(const LAS void* p) { return (unsigned)(size_t)p; }
#define WAITBAR(N) asm volatile("s_waitcnt vmcnt(" #N ") lgkmcnt(0)\n\ts_barrier" ::: "memory")
#define LBAR() asm volatile("s_waitcnt lgkmcnt(0)\n\ts_barrier" ::: "memory")
#define VM_WAIT() asm volatile("s_waitcnt vmcnt(0)" ::: "memory")
#define MFMA32(a, b, c) __builtin_amdgcn_mfma_f32_32x32x16_bf16((a), (b), (c), 0, 0, 0)


#define XB_TMO      128
#define XB_XCNT(j)  (256  + 64 * (j))
#define XB_XSUB(j)  (1280 + 64 * (j))
#define XB_XGEN(j)  (2304 + 64 * (j))
#define XB_TOP      3328
#define XB_TOPGEN   3392
#define XCD_BAR_WORDS 3456
#define XB_SPIN_CAP (1u << 20)
DI unsigned xb_ld(unsigned* p)              { return __hip_atomic_load(p, __ATOMIC_RELAXED, __HIP_MEMORY_SCOPE_AGENT); }
DI unsigned xb_add(unsigned* p, unsigned v) { return __hip_atomic_fetch_add(p, v, __ATOMIC_RELAXED, __HIP_MEMORY_SCOPE_AGENT); }
DI unsigned xb_xcc_id() { return (unsigned)__builtin_amdgcn_s_getreg((3 << 11) | 20) & 0xFu; }
#define XB_SPIN(cond, bar) do { unsigned _sp = 0; while (cond) { \
    if ((++_sp & 255u) == 0u) { if (xb_ld(&(bar)[XB_TMO])) break; if (_sp > XB_SPIN_CAP) { atomicAdd(&(bar)[XB_TMO], 1u); break; } } } } while (0)
struct XcdBarrier { unsigned* bar; unsigned x; volatile LAS unsigned* st; };
DI XcdBarrier xcd_barrier_post(unsigned* bar, volatile LAS unsigned* st, bool leader) {
    XcdBarrier b; b.bar = bar; b.x = xb_xcc_id(); b.st = st;
    if (leader) (void)xb_add(&bar[XB_XCNT(b.x)], 1u);
    return b;
}
DI void xcd_barrier_complete(unsigned* bar, unsigned x, unsigned& nloc, unsigned& nx) {
    const unsigned G = gridDim.x * gridDim.y * gridDim.z;
    unsigned sum, cnt, mine, sp = 0u;
    for (;;) {
        sum = 0u; cnt = 0u; mine = 0u;
#pragma unroll
        for (unsigned j = 0; j < 16; ++j) { const unsigned c = xb_ld(&bar[XB_XCNT(j)]); sum += c; cnt += (c > 0u) ? 1u : 0u; mine = (j == x) ? c : mine; }
        if (sum == G) break;
        __builtin_amdgcn_s_sleep(1);
        if ((++sp & 255u) == 0u) { if (xb_ld(&bar[XB_TMO])) break; if (sp > XB_SPIN_CAP) { atomicAdd(&bar[XB_TMO], 1u); break; } }
    }
    nloc = mine > 0u ? mine : 1u; nx = cnt > 0u ? cnt : 1u;
}
DI void xcd_barrier_local(const XcdBarrier& b, bool leader) {
    asm volatile("s_waitcnt vmcnt(0)" ::: "memory");
    __syncthreads();
    if (leader) {
        unsigned* bar = b.bar;
        __builtin_amdgcn_s_waitcnt(0);
        unsigned nloc = b.st[0], nx = b.st[1];
        if (nloc == 0u) { xcd_barrier_complete(bar, b.x, nloc, nx); b.st[0] = nloc; b.st[1] = nx; }
        const unsigned old = xb_add(&bar[XB_XSUB(b.x)], 1u);
        const unsigned gen = old / nloc;
        if (old + 1u == (gen + 1u) * nloc) {
            __builtin_amdgcn_fence(__ATOMIC_RELEASE, "agent");
            asm volatile("s_waitcnt vmcnt(0)" ::: "memory");
            __builtin_amdgcn_fence(__ATOMIC_ACQUIRE, "agent");
            xb_add(&bar[XB_XGEN(b.x)], 1u);
            asm volatile("s_waitcnt vmcnt(0)" ::: "memory");
        } else {
            XB_SPIN(xb_ld(&bar[XB_XGEN(b.x)]) == gen, bar);
            __builtin_amdgcn_fence(__ATOMIC_ACQUIRE, "agent");
            asm volatile("s_waitcnt vmcnt(0)" ::: "memory");
        }
    }
    __syncthreads();
}
DI void xcd_barrier(const XcdBarrier& b, bool leader) {
    asm volatile("s_waitcnt vmcnt(0)" ::: "memory");
    __syncthreads();
    if (leader) {
        unsigned* bar = b.bar;
        __builtin_amdgcn_s_waitcnt(0);
        unsigned nloc = b.st[0], nx = b.st[1];
        if (nloc == 0u) { xcd_barrier_complete(bar, b.x, nloc, nx); b.st[0] = nloc; b.st[1] = nx; }
        const unsigned old = xb_add(&bar[XB_XSUB(b.x)], 1u);
        const unsigned gen = old / nloc;
        if (old + 1u == (gen + 1u) * nloc) {
            __builtin_amdgcn_fence(__ATOMIC_RELEASE, "agent");
            asm volatile("s_waitcnt vmcnt(0)" ::: "memory");
            const unsigned og = xb_add(&bar[XB_TOP], 1u);
            const unsigned tg = og / nx;
            if (og + 1u == (tg + 1u) * nx) xb_add(&bar[XB_TOPGEN], 1u);
            else XB_SPIN(xb_ld(&bar[XB_TOPGEN]) == tg, bar);
            __builtin_amdgcn_fence(__ATOMIC_ACQUIRE, "agent");
            xb_add(&bar[XB_XGEN(b.x)], 1u);
            asm volatile("s_waitcnt vmcnt(0)" ::: "memory");
        } else {
            XB_SPIN(xb_ld(&bar[XB_XGEN(b.x)]) == gen, bar);
            __builtin_amdgcn_fence(__ATOMIC_ACQUIRE, "agent");
            asm volatile("s_waitcnt vmcnt(0)" ::: "memory");
        }
    }
    __syncthreads();
}

struct Ctx {
    const float *x, *p; const int* positions; const float *norm_g, *w_in, *conv_w, *conv_b, *b_ig, *b_fg, *m_norm_g, *pos_k, *pos_v, *ck_w1, *ck_w2, *cv_w1, *cv_w2,
                *w_out, *gate_w, *ple_w, *ple_g, *final_g;
    float* out; unsigned char* ws;
    int vcu, G, wbase;
    DI int tid() const { return wbase + (int)__builtin_amdgcn_mbcnt_hi(~0u, __builtin_amdgcn_mbcnt_lo(~0u, 0u)); }
    DI float* gates() const { return (float*)(ws + WS_GATES); }
    DI float* rope() const { return (float*)(ws + WS_ROPE); }
    DI float* u2() const { return (float*)(ws + WS_U2); }
    DI float* mx2() const { return (float*)(ws + WS_MX2); }
    DI float* plss() const { return (float*)(ws + WS_PLSS); }
    DI float* x2ss() const { return (float*)(ws + WS_X2SS); }
    DI float* DN() const { return (float*)(ws + WS_DN); }
    DI float* NS() const { return (float*)(ws + WS_NS); }
    DI bf16* SB() const { return (bf16*)(ws + WS_WIN); }
    DI bf16* WoutT() const { return (bf16*)(ws + WS_WOUT); }
    DI bf16* WgateT() const { return (bf16*)(ws + WS_WGATE); }
    DI bf16* WpleT() const { return (bf16*)(ws + WS_WPLE); }
    DI bf16* Wc1T() const { return (bf16*)(ws + WS_WC1); }
    DI bf16* HID() const { return (bf16*)(ws + WS_HID); }
    DI bf16* KVC() const { return (bf16*)(ws + WS_KVC); }
    DI bf16* PB() const { return (bf16*)(ws + WS_PB); }
    DI bf16* WinT() const { return (bf16*)(ws + WS_WIN); }
    DI bf16* CA() const { return (bf16*)(ws + WS_WIN); }
    DI bf16* XN() const { return (bf16*)(ws + WS_XN); }
    DI bf16* QC() const { return (bf16*)(ws + WS_XN); }
    DI bf16* KC() const { return (bf16*)(ws + WS_XN + 32 * MiB); }
    DI bf16* PROJ() const { return (bf16*)(ws + WS_PROJ); }
    DI bf16* PL() const { return (bf16*)(ws + WS_PROJ); }
    DI bf16* X1B() const { return (bf16*)(ws + WS_PROJ + 64 * MiB); }
    DI bf16* MIX() const { return (bf16*)(ws + WS_MIX); }
    DI bf16* X2B() const { return (bf16*)(ws + WS_XN); }
    DI float* HIDP() const { return (float*)((unsigned char*)out + 32 * MiB); }
    DI float* posb() const { return (float*)(ws + WS_KVC + 1024 * 1024); }
};

DI int map_in(int np) { if (np >= 3072 && np < 5120) { const int k = (np - 3072) >> 8, ct = np & 255; return ct < 128 ? 3072 + 128 * k + ct : 4096 + 128 * k + (ct - 128); }
    return np < 5120 ? np : (np < 7680 ? np + 8 : (np < 8704 ? np + 56 : (np < 8752 ? np - 1016 : (np < 8760 ? np - 3632 : -1)))); }
DI void transpose_item(const float* W, int K, int N, int mode, bf16* WT, int row_off, LAS float* scr, int item, int nblk, int lane) {
    const int kb = item / nblk, nb = item % nblk, k0 = 64 * kb, n0 = 32 * nb;
    const int np = n0 + 4 * (lane & 7);
    const int src = mode ? map_in(np) : np;
    f32x4 v[8];
#pragma unroll
    for (int i = 0; i < 8; ++i) { const int kk = (lane >> 3) + 8 * i; v[i] = (src >= 0) ? __builtin_nontemporal_load((const f32x4*)(W + (size_t)(k0 + kk) * N + src)) : (f32x4){0.f, 0.f, 0.f, 0.f}; }
#pragma unroll
    for (int i = 0; i < 8; ++i) { const int kk = (lane >> 3) + 8 * i; LAS float* d = scr + kk * 33 + 4 * (lane & 7); d[0] = v[i].x; d[1] = v[i].y; d[2] = v[i].z; d[3] = v[i].w; }
    __builtin_amdgcn_fence(__ATOMIC_RELEASE, "wavefront"); __builtin_amdgcn_wave_barrier(); __builtin_amdgcn_fence(__ATOMIC_ACQUIRE, "wavefront");
    const int c = lane & 7;
#pragma unroll
    for (int j = 0; j < 4; ++j) { const int n = (lane >> 3) + 8 * j; const LAS float* s = scr + (8 * c) * 33 + n;
        v4u o; o.x = pk2(s[0 * 33], s[1 * 33]); o.y = pk2(s[2 * 33], s[3 * 33]); o.z = pk2(s[4 * 33], s[5 * 33]); o.w = pk2(s[6 * 33], s[7 * 33]);
        *(v4u*)(WT + (size_t)(row_off + n0 + n) * K + k0 + 8 * c) = o; }
    __builtin_amdgcn_fence(__ATOMIC_RELEASE, "wavefront"); __builtin_amdgcn_wave_barrier(); __builtin_amdgcn_fence(__ATOMIC_ACQUIRE, "wavefront");
}
DI void phase0(const Ctx& C, LAS unsigned char* lds) {
    int tid = C.tid(); asm volatile("" : "+v"(tid));
    const int lane = tid & 63, wave = __builtin_amdgcn_readfirstlane(tid >> 6);
    LAS float* scr = (LAS float*)(lds + wave * 16384);
    const int gw = C.vcu * NWAVES + wave, NGW = C.G * NWAVES;
    constexpr int I_IN = 32 * 280;
    for (int it = gw; it < I_IN; it += NGW) transpose_item(C.w_in, DM, DIN, 1, C.WinT(), 0, scr, it, 280, lane);
    for (int m = gw; m < NT; m += NGW) {
        const f32x4* xr = (const f32x4*)(C.x + (size_t)m * DM);
        f32x4 v[8]; float s = 0.f;
#pragma unroll
        for (int j = 0; j < 4; ++j) { v[2 * j] = __builtin_nontemporal_load(xr + 2 * (lane + 64 * j)); v[2 * j + 1] = __builtin_nontemporal_load(xr + 2 * (lane + 64 * j) + 1); }
#pragma unroll
        for (int j = 0; j < 8; ++j) s += (v[j].x * v[j].x + v[j].y * v[j].y) + (v[j].z * v[j].z + v[j].w * v[j].w);
        const float rstd = 1.f / sqrtf(wave_sum(s) * (1.f / DM) + EPSV);
        v4u* o16 = (v4u*)(C.XN() + (size_t)m * DM);
#pragma unroll
        for (int j = 0; j < 4; ++j) { const f32x4 g0 = *((const f32x4*)C.norm_g + 2 * (lane + 64 * j)), g1 = *((const f32x4*)C.norm_g + 2 * (lane + 64 * j) + 1);
            const f32x4 a = v[2 * j], b2 = v[2 * j + 1];
            v4u w; w.x = pk2(a.x * rstd * g0.x, a.y * rstd * g0.y); w.y = pk2(a.z * rstd * g0.z, a.w * rstd * g0.w); w.z = pk2(b2.x * rstd * g1.x, b2.y * rstd * g1.y); w.w = pk2(b2.z * rstd * g1.z, b2.w * rstd * g1.w);
            o16[lane + 64 * j] = w; }
    }
    const int gt = C.vcu * NTHREADS + tid, NGT = C.G * NTHREADS;
    for (int i = gt; i < NT * 8; i += NGT) {
        const int t = i >> 3, k = i & 7;
        const float invf[8] = {1.0f, 0.1939227432012558f, 0.03760603070259094f, 0.007292664609849453f, 0.0014142135623842478f, 0.00027424818836152554f, 5.3182957344688475e-05f, 1.0313385246263351e-05f};
        float inv = invf[0];
#pragma unroll
        for (int q = 1; q < 8; ++q) inv = (k == q) ? invf[q] : inv;
        const float ang = (float)C.positions[t] * inv;
        float sn, cs; sincosf(ang, &sn, &cs);
        C.rope()[t * 16 + k] = cs; C.rope()[t * 16 + 8 + k] = sn;
    }
}

DI void late_weights(const Ctx& C, LAS unsigned char* lds, int wg, int nwg, int part = 0) {
    int tid = C.tid(); asm volatile("" : "+v"(tid));
    const int lane = tid & 63, wave = __builtin_amdgcn_readfirstlane(tid >> 6);
    LAS float* scr = (LAS float*)(lds + wave * 16384);
    const int gw = wg * NWAVES + wave, NGW = nwg * NWAVES;
    constexpr int I_OUT = 32 * 64, I_GATE = 32 * 64, I_PLE = 4 * 64, I_C1 = 32 * 4;
    constexpr int NITEMS = I_OUT + I_GATE + I_PLE + 2 * I_C1;
    __syncthreads();
    if (part != 2)
    for (int it = gw; it < NITEMS; it += NGW) {
        int r = it;
        if (r < I_OUT) { transpose_item(C.w_out, DM, DM, 0, C.WoutT(), 0, scr, r, 64, lane); continue; } r -= I_OUT;
        if (r < I_GATE) { transpose_item(C.gate_w, DM, DM, 0, C.WgateT(), 0, scr, r, 64, lane); continue; } r -= I_GATE;
        if (r < I_PLE) { transpose_item(C.ple_w, PLE, DM, 0, C.WpleT(), 0, scr, r, 64, lane); continue; } r -= I_PLE;
        if (r < I_C1) { transpose_item(C.ck_w1, DM, 128, 0, C.Wc1T(), 0, scr, r, 4, lane); continue; } r -= I_C1;
        transpose_item(C.cv_w1, DM, 128, 0, C.Wc1T(), 128, scr, r, 4, lane);
    }
    if (part != 1)
    for (int i = wg * NTHREADS + tid; i < NT * PLE / 8; i += nwg * NTHREADS) {
        const f32x4 a = *((const f32x4*)C.p + 2 * i), b = *((const f32x4*)C.p + 2 * i + 1);
        v4u w; w.x = pk2(a.x, a.y); w.y = pk2(a.z, a.w); w.z = pk2(b.x, b.y); w.w = pk2(b.z, b.w);
        *((v4u*)C.PB() + i) = w;
    }
    __syncthreads();
}

typedef pg8::f32x4 gf4;
struct CmpOrder {
    int G, c;
    DI void init(int G_, int c_) { G = G_; c = c_; }
    DI bool next(int i, pg8::Unit& u) const {
        if (G == 256) { if (i) return false; const int g8 = c & 7, li = c >> 3; u.pm = ((li >> 1) & 1) * 16 + 2 * g8 + (li & 1); u.pn = 0; u.ks = li >> 2; return true; }
        const int L = i * G + c; if (L >= 256) return false; u.pm = L & 31; u.pn = 0; u.ks = L >> 5; return true; }
    DI void a_ready(const pg8::Unit&) const {}
    DI void done(const pg8::Unit&) const {}
    template <class A> DI void preload(A&, int) const {}
    DI size_t aoff(const pg8::Unit& u, const pg8::Gemm& g) const { return ((size_t)(u.pm >> 4) * KVSZ + (size_t)(u.pm & 15) * SEQ * 64) * 2 + (size_t)u.ks * g.K * 2; }
};
DI bf16* proj_dst(bf16* P, int pn, int r, int ct) {
    const int b = r >> 12, s = r & (SEQ - 1);
    if (pn < 8) return P + PO_MQK + (size_t)r * 2048 + pn * 256 + ct;
    if (pn < 12) return P + PO_MV + ((size_t)(b * 4 + (pn - 8)) * SEQ + s) * 256 + ct;
    if (pn < 20) return nullptr;
    if (pn < 24) return P + PO_NQ + ((size_t)(b * 16 + (pn - 20) * 4 + (ct >> 6)) * SEQ + s) * 64 + (ct & 63);
    if (pn < 30) return P + PO_KV6 + (size_t)(pn - 24) * KVSZ + ((size_t)(b * 4 + (ct >> 6)) * SEQ + s) * 64 + (ct & 63);
    if (pn < 34) return P + PO_NZ + ((size_t)(b * 16 + (pn - 30) * 4 + (ct >> 6)) * SEQ + s) * 64 + (ct & 63);
    return ct < 64 ? P + PO_NG + (size_t)r * 64 + ct : nullptr;
}
struct EpiProj {
    static constexpr bool PERM = true;
    bf16* O; float* gates; const float* rope;
    DI void operator()(const gf4 (&acc)[2][2][4][2], const pg8::Unit& u, int wr, int wc, int fr, int fq) const {
        const int row0 = u.pm * 256 + wr * 64 + fr, ct0 = wc * 32 + 8 * fq;
        const bool gl = (u.pn == 34) && (wc == 1) && (fq == 2);
        const bool ropew = ((u.pn >= 20 && u.pn <= 24) || u.pn == 26 || u.pn == 28) && ((wc & 1) == 0);
        const float sgn = (fq == 0) ? -1.f : 1.f;
#pragma unroll
        for (int ai = 0; ai < 2; ++ai)
#pragma unroll
            for (int m = 0; m < 4; ++m) { const int row = row0 + ai * 128 + m * 16;
                gf4 c0, c1, s0, s1;
                if (ropew) { c0 = *(const gf4*)(rope + (size_t)row * 16); c1 = *(const gf4*)(rope + (size_t)row * 16 + 4); s0 = *(const gf4*)(rope + (size_t)row * 16 + 8); s1 = *(const gf4*)(rope + (size_t)row * 16 + 12); }
#pragma unroll
                for (int bj = 0; bj < 2; ++bj) { gf4 v0 = acc[ai][bj][m][0], v1 = acc[ai][bj][m][1];
                    if (ropew) {
                        gf4 p0, p1;
#pragma unroll
                        for (int e = 0; e < 4; ++e) { p0[e] = __shfl_xor(v0[e], 16); p1[e] = __shfl_xor(v1[e], 16); }
                        if (fq < 2) {
#pragma unroll
                            for (int e = 0; e < 4; ++e) { v0[e] = v0[e] * c0[e] + sgn * p0[e] * s0[e]; v1[e] = v1[e] * c1[e] + sgn * p1[e] * s1[e]; }
                        }
                    }
                    if (u.pn >= 12 && u.pn < 20) {
                        if (bj == 1) { const gf4 o0 = acc[ai][0][m][0], o1 = acc[ai][0][m][1]; float gg[8];
#pragma unroll
                            for (int e = 0; e < 4; ++e) { gg[e] = v0[e] * __builtin_amdgcn_rcpf((1.f + ex2(-LOG2E * o0[e])) * (1.f + ex2(-LOG2E * v0[e]))); gg[4 + e] = v1[e] * __builtin_amdgcn_rcpf((1.f + ex2(-LOG2E * o1[e])) * (1.f + ex2(-LOG2E * v1[e]))); }
                            const int k = u.pn - 12, b_ = row >> 12, s_ = row & (SEQ - 1);
                            __builtin_nontemporal_store(pack8(gg), (v4u*)(O + PO_MG + ((size_t)(b_ * 4 + (k >> 1)) * SEQ + s_) * 256 + (k & 1) * 128 + ct0)); }
                    } else {
                    if (u.pn >= 30 && u.pn < 34) {
#pragma unroll
                        for (int e = 0; e < 4; ++e) { v0[e] = fsilu(v0[e]); v1[e] = fsilu(v1[e]); }
                    } else if (u.pn == 34) {
#pragma unroll
                        for (int e = 0; e < 4; ++e) { v0[e] = fsigmoid(v0[e]); v1[e] = fsigmoid(v1[e]); }
                    }
                    v4u w; w.x = pk2(v0[0], v0[1]); w.y = pk2(v0[2], v0[3]); w.z = pk2(v1[0], v1[1]); w.w = pk2(v1[2], v1[3]);
                    bf16* dst = proj_dst(O, u.pn, row, ct0 + bj * 128);
                    if (dst) __builtin_nontemporal_store(w, (v4u*)dst); }
                    }
                if (gl) { *(gf4*)(gates + (size_t)row * 8) = acc[ai][0][m][0]; *(gf4*)(gates + (size_t)row * 8 + 4) = acc[ai][0][m][1]; } }
    }
};
struct EpiCmpPart {
    static constexpr bool PERM = true;
    float* HP;
    DI void operator()(const gf4 (&acc)[2][2][4][2], const pg8::Unit& u, int wr, int wc, int fr, int fq) const {
        const int row0 = u.pm * 256 + wr * 64 + fr, col0 = wc * 32 + 8 * fq;
        const bool isv = u.pm >= 16;
        float* base = HP + (size_t)u.ks * 8192 * 128;
#pragma unroll
        for (int ai = 0; ai < 2; ++ai)
#pragma unroll
            for (int m = 0; m < 4; ++m) { const int row = row0 + ai * 128 + m * 16;
                const gf4 v0 = isv ? acc[ai][1][m][0] : acc[ai][0][m][0], v1 = isv ? acc[ai][1][m][1] : acc[ai][0][m][1];
                *(gf4*)(base + (size_t)row * 128 + col0) = v0; *(gf4*)(base + (size_t)row * 128 + col0 + 4) = v1; }
    }
};
struct EpiX1 {
    static constexpr bool PERM = true;
    const float* x; bf16* xb;
    DI void operator()(const gf4 (&acc)[2][2][4][2], const pg8::Unit& u, int wr, int wc, int fr, int fq) const {
        const int row0 = u.pm * 256 + wr * 64 + fr, col0 = u.pn * 256 + wc * 32 + 8 * fq;
        gf4 nx[4];
        { const size_t off = (size_t)row0 * DM + col0; nx[0] = __builtin_nontemporal_load((const gf4*)(x + off)); nx[1] = __builtin_nontemporal_load((const gf4*)(x + off + 4)); nx[2] = __builtin_nontemporal_load((const gf4*)(x + off + 128)); nx[3] = __builtin_nontemporal_load((const gf4*)(x + off + 132)); }
#pragma unroll
        for (int r8 = 0; r8 < 8; ++r8) { const int ai = r8 >> 2, m = r8 & 3; const size_t off = (size_t)(row0 + ai * 128 + m * 16) * DM + col0;
            const gf4 cx0 = nx[0], cx1 = nx[1], cx2 = nx[2], cx3 = nx[3];
            if (r8 < 7) { const int ai2 = (r8 + 1) >> 2, m2 = (r8 + 1) & 3; const size_t o2 = (size_t)(row0 + ai2 * 128 + m2 * 16) * DM + col0;
                nx[0] = __builtin_nontemporal_load((const gf4*)(x + o2)); nx[1] = __builtin_nontemporal_load((const gf4*)(x + o2 + 4)); nx[2] = __builtin_nontemporal_load((const gf4*)(x + o2 + 128)); nx[3] = __builtin_nontemporal_load((const gf4*)(x + o2 + 132)); }
            { const gf4 v0 = acc[ai][0][m][0] + cx0, v1 = acc[ai][0][m][1] + cx1; v4u w; w.x = pk2(v0[0], v0[1]); w.y = pk2(v0[2], v0[3]); w.z = pk2(v1[0], v1[1]); w.w = pk2(v1[2], v1[3]); *(v4u*)(xb + off) = w; }
            { const gf4 v0 = acc[ai][1][m][0] + cx2, v1 = acc[ai][1][m][1] + cx3; v4u w; w.x = pk2(v0[0], v0[1]); w.y = pk2(v0[2], v0[3]); w.z = pk2(v1[0], v1[1]); w.w = pk2(v1[2], v1[3]); *(v4u*)(xb + off + 128) = w; }
        }
    }
};
struct EpiPl {
    static constexpr bool PERM = true;
    bf16* PLb; float* ss;
    DI void operator()(const gf4 (&acc)[2][2][4][2], const pg8::Unit& u, int wr, int wc, int fr, int fq) const {
        const int row0 = u.pm * 256 + wr * 64 + fr, col0 = u.pn * 256 + wc * 32 + 8 * fq;
#pragma unroll
        for (int ai = 0; ai < 2; ++ai)
#pragma unroll
            for (int m = 0; m < 4; ++m) { const int row = row0 + ai * 128 + m * 16; const size_t off = (size_t)row * DM + col0; float s = 0.f;
#pragma unroll
                for (int bj = 0; bj < 2; ++bj) { const gf4 v0 = acc[ai][bj][m][0], v1 = acc[ai][bj][m][1];
                    s += (v0[0] * v0[0] + v0[1] * v0[1]) + (v0[2] * v0[2] + v0[3] * v0[3]) + (v1[0] * v1[0] + v1[1] * v1[1]) + (v1[2] * v1[2] + v1[3] * v1[3]);
                    v4u w; w.x = pk2(v0[0], v0[1]); w.y = pk2(v0[2], v0[3]); w.z = pk2(v1[0], v1[1]); w.w = pk2(v1[2], v1[3]);
                    __builtin_nontemporal_store(w, (v4u*)(PLb + off + bj * 128)); }
                s += __shfl_xor(s, 16); s += __shfl_xor(s, 32);
                if (fq == 0) atomicAdd(ss + row, s); }
    }
};
struct OneUnit {
    int pm, pn;
    __device__ bool next(int i, pg8::Unit& u) const { if (i) return false; u.pm = pm; u.pn = pn; u.ks = 0; return true; }
    DI void a_ready(const pg8::Unit&) const {}
    DI void done(const pg8::Unit&) const {}
    template <class A> DI void preload(A&, int) const {}
    DI size_t aoff(const pg8::Unit& u, const pg8::Gemm& g) const { return (size_t)u.pm * 256 * (size_t)g.lda * 2; }
};
struct P1Order {
    pg8::StaticOrder S; int i0, l8;
    DI void init(int bx, int i0_) { S.init(NT, DINP, 256, bx); i0 = i0_; const int x = bx & 7, k = bx >> 3;
        l8 = (x & 1) ? (k < 24 ? 2048 + 8 * k + x : 2048 + 8 * (k - 8) + x - 1) : (k < 16 ? 2048 + 8 * k + x : -1); }
    DI bool next(int i, pg8::Unit& u) const { const int r = i + i0; if (r > 8 || (r == 8 && l8 < 0)) return false;
        pg8::StaticOrder T = S; T.i0 = 0; if (r == 8) { T.c = l8 - 2048; } return T.next(r, u); }
    DI void a_ready(const pg8::Unit&) const {}
    DI void done(const pg8::Unit&) const {}
    template <class A> DI void preload(A&, int) const {}
    DI size_t aoff(const pg8::Unit& u, const pg8::Gemm& g) const { return (size_t)u.pm * 256 * (size_t)g.lda * 2; }
};
struct P5Order {
    pg8::StaticOrder S;
    DI void init(int M, int N, int G_, int c_) { S.init(M, N, G_, c_); }
    DI bool next(int i, pg8::Unit& u) const {
        if (S.G == 256) { if (i > 1) return false; const int x = S.c & 7, li = S.c >> 3; u.pm = 32 * i + 4 * x + (li & 3); u.pn = li >> 2; u.ks = 0; return true; }
        return S.next(i, u); }
    DI void a_ready(const pg8::Unit&) const {}
    DI void done(const pg8::Unit&) const {}
    template <class A> DI void preload(A&, int) const {}
    DI size_t aoff(const pg8::Unit& u, const pg8::Gemm& g) const { return (size_t)u.pm * 256 * (size_t)g.lda * 2; }
};
struct HalfUnit {
    int pm, pn, ks; const float* part;
    __device__ bool next(int i, pg8::Unit& u) const { if (i) return false; u.pm = pm; u.pn = pn; u.ks = ks; return true; }
    DI void a_ready(const pg8::Unit&) const {}
    DI void done(const pg8::Unit&) const {}
    DI void preload(gf4 (&acc)[2][2][4][2], int tid) const {
        if (part == nullptr) return;
#pragma unroll
        for (int i = 0; i < 32; ++i) acc[i >> 4][(i >> 3) & 1][(i >> 1) & 3][i & 1] = __builtin_nontemporal_load((const gf4*)part + i * NTHREADS + tid);
    }
    DI size_t aoff(const pg8::Unit& u, const pg8::Gemm& g) const { return (size_t)u.pm * 256 * (size_t)g.lda * 2 + (size_t)u.ks * g.K * 2; }
};
struct EpiPartSave {
    static constexpr bool PERM = true;
    float* part;
    DI void operator()(const gf4 (&acc)[2][2][4][2], const pg8::Unit&, int wr, int wc, int fr, int fq) const {
        const int tid = (wr * 4 + wc) * 64 + fq * 16 + fr;
#pragma unroll
        for (int i = 0; i < 32; ++i) __builtin_nontemporal_store(acc[i >> 4][(i >> 3) & 1][(i >> 1) & 3][i & 1], (gf4*)part + i * NTHREADS + tid);
    }
};
struct EpiGateNorm {
    static constexpr bool PERM = true;
    float* out; const bf16* x1b; const bf16* PLb; const float* plss; const float* pg; const float* fg; unsigned* slots; unsigned* cnt; LAS unsigned char* lds;
    DI void operator()(gf4 (&acc)[2][2][4][2], const pg8::Unit& u, int wr, int wc, int fr, int fq) const {
        LAS float* P = (LAS float*)(lds + 131072);
        LAS float* S = (LAS float*)(lds + 135168);
        const int tid = (wr * 4 + wc) * 64 + fr + 16 * fq;
        const int row0 = u.pm * 256 + wr * 64 + fr, col0 = u.pn * 256 + wc * 32 + 8 * fq;
        gf4 g0[2], g1[2];
#pragma unroll
        for (int bj = 0; bj < 2; ++bj) { g0[bj] = *(const gf4*)(pg + col0 + bj * 128); g1[bj] = *(const gf4*)(pg + col0 + bj * 128 + 4); }
        v4u nxa[2], npl[2]; float nps;
        { const size_t off = (size_t)row0 * DM + col0; nxa[0] = *(const v4u*)(x1b + off); nxa[1] = *(const v4u*)(x1b + off + 128); npl[0] = *(const v4u*)(PLb + off); npl[1] = *(const v4u*)(PLb + off + 128); nps = plss[row0]; }
#pragma unroll
        for (int r8 = 0; r8 < 8; ++r8) { const int ai = r8 >> 2, m = r8 & 3;
            const v4u cxa0 = nxa[0], cxa1 = nxa[1], cpl0 = npl[0], cpl1 = npl[1]; const float ps = nps;
            if (r8 < 7) { const int ai2 = (r8 + 1) >> 2, m2 = (r8 + 1) & 3; const int row2 = row0 + ai2 * 128 + m2 * 16; const size_t o2 = (size_t)row2 * DM + col0;
                nxa[0] = *(const v4u*)(x1b + o2); nxa[1] = *(const v4u*)(x1b + o2 + 128); npl[0] = *(const v4u*)(PLb + o2); npl[1] = *(const v4u*)(PLb + o2 + 128); nps = plss[row2]; }
            const float rstd = 1.f / sqrtf(ps * (1.f / DM) + EPSV);
            float s = 0.f;
#pragma unroll
            for (int bj = 0; bj < 2; ++bj) {
                float xa[8]; unpack8(bj ? cxa1 : cxa0, xa);
                float pl[8]; unpack8(bj ? cpl1 : cpl0, pl);
                gf4 v0, v1;
#pragma unroll
                for (int e = 0; e < 4; ++e) { v0[e] = xa[e] + fsigmoid(acc[ai][bj][m][0][e]) * (pl[e] * rstd * g0[bj][e]); v1[e] = xa[4 + e] + fsigmoid(acc[ai][bj][m][1][e]) * (pl[4 + e] * rstd * g1[bj][e]); }
                s += (v0[0] * v0[0] + v0[1] * v0[1]) + (v0[2] * v0[2] + v0[3] * v0[3]) + (v1[0] * v1[0] + v1[1] * v1[1]) + (v1[2] * v1[2] + v1[3] * v1[3]);
                acc[ai][bj][m][0] = v0; acc[ai][bj][m][1] = v1; }
            s += __shfl_xor(s, 16); s += __shfl_xor(s, 32);
            if (fq == 0) P[(ai * 128 + wr * 64 + m * 16 + fr) * 4 + wc] = s; }
        __syncthreads();
        if (tid < 256) { const f32x4 p4 = *(const LAS f32x4*)(P + tid * 4); const float t = (p4.x + p4.y) + (p4.z + p4.w);
            __hip_atomic_store(slots + ((size_t)(u.pm * 256 + tid)) * 8 + u.pn, __float_as_uint(t), __ATOMIC_RELAXED, __HIP_MEMORY_SCOPE_AGENT); }
        asm volatile("s_waitcnt vmcnt(0)" ::: "memory");
        __syncthreads();
        if (tid == 0) {
            unsigned* c = cnt + 64 * u.pm;
            __hip_atomic_fetch_add(c, 1u, __ATOMIC_RELAXED, __HIP_MEMORY_SCOPE_AGENT);
            unsigned sp = 0;
            while (__hip_atomic_load(c, __ATOMIC_RELAXED, __HIP_MEMORY_SCOPE_AGENT) < 8u) { if (++sp > (1u << 24)) break; }
            __builtin_amdgcn_fence(__ATOMIC_ACQUIRE, "agent");
            asm volatile("s_waitcnt vmcnt(0)" ::: "memory");
        }
        __syncthreads();
        if (tid < 256) { float t = 0.f;
#pragma unroll
            for (int k = 0; k < 8; ++k) t += __uint_as_float(__hip_atomic_load(slots + ((size_t)(u.pm * 256 + tid)) * 8 + k, __ATOMIC_RELAXED, __HIP_MEMORY_SCOPE_AGENT));
            S[tid] = 1.f / sqrtf(t * (1.f / DM) + EPSV); }
        __syncthreads();
#pragma unroll
        for (int bj = 0; bj < 2; ++bj) { g0[bj] = *(const gf4*)(fg + col0 + bj * 128); g1[bj] = *(const gf4*)(fg + col0 + bj * 128 + 4); }
#pragma unroll
        for (int ai = 0; ai < 2; ++ai)
#pragma unroll
            for (int m = 0; m < 4; ++m) { const int rl = ai * 128 + wr * 64 + m * 16 + fr; const size_t off = (size_t)(u.pm * 256 + rl) * DM + col0; const float rs = S[rl];
#pragma unroll
                for (int bj = 0; bj < 2; ++bj) { gf4 o0, o1;
#pragma unroll
                    for (int e = 0; e < 4; ++e) { o0[e] = acc[ai][bj][m][0][e] * rs * g0[bj][e]; o1[e] = acc[ai][bj][m][1][e] * rs * g1[bj][e]; }
                    __builtin_nontemporal_store(o0, (gf4*)(out + off + bj * 128)); __builtin_nontemporal_store(o1, (gf4*)(out + off + bj * 128 + 4)); } }
        __syncthreads();
    }
};

DI float log_sigmoid(float z) { return fminf(z, 0.f) - 0.6931471805599453f * __builtin_amdgcn_logf(1.f + ex2(-LOG2E * fabsf(z))); }
DI void phase2_scan(const Ctx& C, LAS unsigned char* lds, int bh) {
    int tid = C.tid(); asm volatile("" : "+v"(tid));
    const int lane = tid & 63, wave = tid >> 6;
    const int b = bh >> 2, h = bh & 3;
    LAS float* red = (LAS float*)lds;
    const float bi = C.b_ig[h], bfg = C.b_fg[h];
    float ig[8], lf[8];
#pragma unroll
    for (int e = 0; e < 8; ++e) { const size_t row = (size_t)b * SEQ + tid * 8 + e; ig[e] = C.gates()[row * 8 + h] + bi; lf[e] = log_sigmoid(C.gates()[row * 8 + 4 + h] + bfg); }
    float cs[8]; cs[0] = lf[0];
#pragma unroll
    for (int e = 1; e < 8; ++e) cs[e] = cs[e - 1] + lf[e];
    float incl = cs[7];
#pragma unroll
    for (int o = 1; o < 64; o <<= 1) { const float t = __shfl_up(incl, o); if (lane >= o) incl += t; }
    if (lane == 63) red[wave] = incl;
    __syncthreads();
    float woff = 0.f;
#pragma unroll
    for (int w = 0; w < 8; ++w) woff += (w < wave) ? red[w] : 0.f;
    const float excl = woff + incl - cs[7];
    float u[8], cm[8];
#pragma unroll
    for (int e = 0; e < 8; ++e) u[e] = ig[e] - (excl + cs[e]);
    cm[0] = u[0];
#pragma unroll
    for (int e = 1; e < 8; ++e) cm[e] = fmaxf(cm[e - 1], u[e]);
    float mincl = cm[7];
#pragma unroll
    for (int o = 1; o < 64; o <<= 1) { const float t = __shfl_up(mincl, o); if (lane >= o) mincl = fmaxf(mincl, t); }
    float mexcl = __shfl_up(mincl, 1); if (lane == 0) mexcl = 0.f;
    if (lane == 63) red[8 + wave] = mincl;
    __syncthreads();
    float wmax = 0.f;
#pragma unroll
    for (int w = 0; w < 8; ++w) wmax = (w < wave) ? fmaxf(wmax, red[8 + w]) : wmax;
    const float base = fmaxf(fmaxf(mexcl, wmax), 0.f);
#pragma unroll
    for (int e = 0; e < 8; ++e) { const size_t o = (size_t)bh * SEQ + tid * 8 + e; C.u2()[o] = u[e] * LOG2E; C.mx2()[o] = fmaxf(base, cm[e]) * LOG2E; }
    __syncthreads();
}
DI void phase2(const Ctx& C, LAS unsigned char* lds) {
    int tid = C.tid(); asm volatile("" : "+v"(tid));
    const int lane = tid & 63, wave = __builtin_amdgcn_readfirstlane(tid >> 6);
    if (C.G == 256) { if ((C.vcu & 31) < 2) phase2_scan(C, lds, (C.vcu >> 5) * 2 + (C.vcu & 31)); }
    else if (C.vcu < 16) phase2_scan(C, lds, C.vcu);
    if (C.G < 16) { for (int bh = C.vcu + C.G; bh < 16; bh += C.G) phase2_scan(C, lds, bh); }
    const int gw = C.vcu * NWAVES + wave, NGW = C.G * NWAVES;
    const int grpl = (C.vcu >> 6) * 256 + (C.vcu & 31) * NWAVES + wave;
    const int itA = grpl * 4 + ((C.vcu >> 5) & 1), itB = itA + 2;
    for (int it0 = gw; it0 < (NT / 16) * 4; it0 += 2 * NGW) {
        v4u raw[2][19];
#pragma unroll
        for (int z = 0; z < 2; ++z) { const int it = (C.G == 256) ? (z ? itB : itA) : it0 + z * NGW; const int grp = it >> 2, chunk = it & 3, c0 = chunk * 512 + lane * 8, t0 = grp * 16; const bool first = (t0 & (SEQ - 1)) == 0;
#pragma unroll
            for (int q = 0; q < 19; ++q) { const int tr = t0 - 3 + q; raw[z][q] = ((q < 3 && first) || it >= (NT / 16) * 4) ? (v4u){0u, 0u, 0u, 0u} : __builtin_nontemporal_load((const v4u*)(C.PROJ() + PO_MQK + (size_t)tr * 2048 + c0)); } }
#pragma unroll
        for (int z = 0; z < 2; ++z) { const int it = (C.G == 256) ? (z ? itB : itA) : it0 + z * NGW; if (it >= (NT / 16) * 4) break;
            const int grp = it >> 2, chunk = it & 3, c0 = chunk * 512 + lane * 8, t0 = grp * 16;
            float w[4][8], bb[8];
#pragma unroll
            for (int j = 0; j < 4; ++j) { const f32x4 a = *(const f32x4*)(C.conv_w + j * 2048 + c0), b2 = *(const f32x4*)(C.conv_w + j * 2048 + c0 + 4);
                w[j][0] = a.x; w[j][1] = a.y; w[j][2] = a.z; w[j][3] = a.w; w[j][4] = b2.x; w[j][5] = b2.y; w[j][6] = b2.z; w[j][7] = b2.w; }
            { const f32x4 a = *(const f32x4*)(C.conv_b + c0), b2 = *(const f32x4*)(C.conv_b + c0 + 4); bb[0] = a.x; bb[1] = a.y; bb[2] = a.z; bb[3] = a.w; bb[4] = b2.x; bb[5] = b2.y; bb[6] = b2.z; bb[7] = b2.w; }
            const bool isk = c0 >= 1024;
            const int ch = c0 & 1023;
            bf16* dst = (isk ? C.KC() : C.QC()) + ((size_t)((t0 >> 12) * 4 + (ch >> 8)) * SEQ + (t0 & (SEQ - 1))) * 256 + (ch & 255);
            const float osc = isk ? 0.0625f : 1.f;
            float a0[8], a1[8], a2[8], a3[8];
            unpack8(raw[z][0], a0); unpack8(raw[z][1], a1); unpack8(raw[z][2], a2);
#pragma unroll
            for (int tt = 0; tt < 16; ++tt) {
                unpack8(raw[z][3 + tt], a3);
                float y[8];
#pragma unroll
                for (int e = 0; e < 8; ++e) { const float v = bb[e] + w[3][e] * a3[e] + w[0][e] * a0[e] + w[1][e] * a1[e] + w[2][e] * a2[e]; y[e] = fsilu(v) * osc; a0[e] = a1[e]; a1[e] = a2[e]; a2[e] = a3[e]; }
                *(v4u*)(dst + (size_t)tt * 256) = pack8(y);
            }
        }
    }
    const int pgrp = (C.G == 256) ? (C.vcu >> 5) : 0;
    for (int it = (C.G == 256) ? (C.vcu & 31) * NWAVES + wave : gw; it < 256; it += NGW) {
        const float* ps = (it >> 7) ? C.pos_v : C.pos_k; const bf16* wr = C.Wc1T() + (size_t)it * 2048;
        float a = 0.f;
#pragma unroll
        for (int i = 0; i < 4; ++i) { const int k = 8 * (lane + 64 * i); float wv[8]; unpack8(*(const v4u*)(wr + k), wv);
            const f32x4 p0 = *(const f32x4*)(ps + k), p1 = *(const f32x4*)(ps + k + 4);
            a += ((p0.x * wv[0] + p0.y * wv[1]) + (p0.z * wv[2] + p0.w * wv[3])) + ((p1.x * wv[4] + p1.y * wv[5]) + (p1.z * wv[6] + p1.w * wv[7])); }
        a = wave_sum(a);
        if (lane == 0) C.posb()[pgrp * 256 + it] = a; }
}

DI void phase3b(const Ctx& C, LAS unsigned char* lds) {
    int tid = C.tid(); asm volatile("" : "+v"(tid));
    const int lane = tid & 63, wave = __builtin_amdgcn_readfirstlane(tid >> 6);
    LAS float* w2s = (LAS float*)lds;
    LAS float* scr = (LAS float*)(lds + 65536 + wave * 2048);
    __syncthreads();
    for (int i = tid; i < 2 * 128 * 64 / 4; i += NTHREADS) { const f32x4 v = (i < 2048) ? *((const f32x4*)C.ck_w2 + i) : *((const f32x4*)C.cv_w2 + (i - 2048)); *((LAS f32x4*)w2s + i) = v; }
    __syncthreads();
    const int gw = C.vcu * NWAVES + wave, NGW = C.G * NWAVES;
    for (int it = gw; it < 2048; it += NGW) {
        int r0 = it * 4;
        if (C.G == 256) { const int g8 = C.vcu >> 5, jj = (C.vcu & 31) * NWAVES + wave, t4 = jj >> 6; r0 = (((t4 >> 1) * 16 + 2 * g8 + (t4 & 1)) << 8) + (jj & 63) * 4; }
        const LAS float* w2 = w2s + ((r0 >= 4096) ? 128 * 64 : 0);
        { const int idx = lane * 8; const float* hp = C.HIDP() + (size_t)r0 * 128 + idx;
          f32x4 a = {0.f, 0.f, 0.f, 0.f}, b2 = {0.f, 0.f, 0.f, 0.f};
#pragma unroll
          for (int ks = 0; ks < 8; ++ks) { a += *(const f32x4*)(hp + (size_t)ks * 8192 * 128); b2 += *(const f32x4*)(hp + (size_t)ks * 8192 * 128 + 4); }
          const float* pb = C.posb() + ((C.G == 256) ? (C.vcu >> 5) * 256 : 0) + ((r0 >= 4096) ? 128 : 0) + (idx & 127);
          const f32x4 q0 = *(const f32x4*)pb, q1 = *(const f32x4*)(pb + 4);
          const float f[8] = {a.x + q0.x, a.y + q0.y, a.z + q0.z, a.w + q0.w, b2.x + q1.x, b2.y + q1.y, b2.z + q1.z, b2.w + q1.w};
#pragma unroll
          for (int e = 0; e < 8; ++e) scr[idx + e] = fgelu_tanh(f[e]); }
        __builtin_amdgcn_fence(__ATOMIC_RELEASE, "wavefront"); __builtin_amdgcn_wave_barrier(); __builtin_amdgcn_fence(__ATOMIC_ACQUIRE, "wavefront");
        float acc[4] = {0.f, 0.f, 0.f, 0.f};
#pragma unroll 8
        for (int hh = 0; hh < 128; ++hh) { const float w = w2[hh * 64 + lane];
#pragma unroll
            for (int rr = 0; rr < 4; ++rr) acc[rr] += scr[rr * 128 + hh] * w; }
#pragma unroll
        for (int rr = 0; rr < 4; ++rr) C.KVC()[(size_t)(r0 + rr) * 64 + lane] = (((r0 + rr) & 255) == 255) ? (bf16)0 : (bf16)(pk2(acc[rr], 0.f) & 0xffffu);
        __builtin_amdgcn_fence(__ATOMIC_RELEASE, "wavefront"); __builtin_amdgcn_wave_barrier(); __builtin_amdgcn_fence(__ATOMIC_ACQUIRE, "wavefront");
    }
    __syncthreads();
}

DI void qk_tile64(const LAS unsigned char* Kt, const bf16x8 (&qr)[4], f32x16& p0, f32x16& p1, int r32, int hi) {
    const LAS unsigned char* kb = Kt + hi * 1024 + r32 * 16;
    bf16x8 kf[8];
#pragma unroll
    for (int d0 = 0; d0 < 4; ++d0) { kf[2 * d0] = *(const LAS bf16x8*)(kb + d0 * 2048); kf[2 * d0 + 1] = *(const LAS bf16x8*)(kb + d0 * 2048 + 512); }
    __builtin_amdgcn_sched_barrier(0);
#pragma unroll
    for (int d0 = 0; d0 < 4; ++d0) { p0 = MFMA32(kf[2 * d0], qr[d0], p0); p1 = MFMA32(kf[2 * d0 + 1], qr[d0], p1); }
}
DI s16x4 vtr(const LAS unsigned char* p) { return __builtin_bit_cast(s16x4, __builtin_amdgcn_ds_read_tr16_b64_v4i16((LAS s16x4*)p)); }
DI bf16x8 pack_p(const f32x16& p, int s) {
    v4u w; w.x = pk2(p[8 * s + 0], p[8 * s + 1]); w.y = pk2(p[8 * s + 2], p[8 * s + 3]); w.z = pk2(p[8 * s + 4], p[8 * s + 5]); w.w = pk2(p[8 * s + 6], p[8 * s + 7]);
    return __builtin_bit_cast(bf16x8, w);
}
typedef float f32x2v __attribute__((ext_vector_type(2)));
struct Sm { float m, l; f32x16 o0, o1; };
DI void softmax_pv64_fast(const LAS unsigned char* Vt, f32x16& p0, f32x16& p1, Sm& st, LAS float* wsf, int lane, int r32, int hi, bool en, float SC) {
    const LAS unsigned char* vp = Vt + ((lane >> 4) & 1) * 32 + (lane & 3) * 8 + (4 * hi + ((lane & 15) >> 2)) * 64;
    bf16x8 vfr[8];
#pragma unroll
    for (int db = 0; db < 2; ++db)
#pragma unroll
        for (int s = 0; s < 4; ++s) { const s16x4 lo = vtr(vp + db * 4096 + s * 1024), hh = vtr(vp + db * 4096 + s * 1024 + 512); vfr[4 * db + s] = __builtin_shufflevector(lo, hh, 0, 1, 2, 3, 4, 5, 6, 7); }
    __builtin_amdgcn_sched_barrier(0);
    const bool fresh = st.m < -1.0e29f;
    const float refo = fresh ? 0.f : st.m;
    const float scl = en ? SC : 0.f, offo = en ? -refo : NEGV;
    const f32x2v scl2 = {scl, scl}, offo2 = {offo, offo};
    f32x2v a2[8], c2[8];
#pragma unroll
    for (int q = 0; q < 8; ++q) { a2[q] = (f32x2v){p0[2 * q], p0[2 * q + 1]} * scl2 + offo2; c2[q] = (f32x2v){p1[2 * q], p1[2 * q + 1]} * scl2 + offo2; }
    float mx = fmaxf(fmaxf(a2[0].x, a2[0].y), fmaxf(c2[0].x, c2[0].y));
#pragma unroll
    for (int q = 1; q < 8; ++q) { mx = fmaxf(fmaxf(mx, a2[q].x), a2[q].y); mx = fmaxf(fmaxf(mx, c2[q].x), c2[q].y); }
    mx = swap32_max(mx);
    const bool move = (fresh || mx > 8.f) && (mx > -1.0e29f);
    const float delta = move ? mx : 0.f;
    const float alpha = (move && !fresh) ? ex2(-delta) : 1.f;
    st.m = move ? refo + delta : st.m;
    if (__any(delta != 0.f)) {
        const f32x2v d2 = {delta, delta};
#pragma unroll
        for (int q = 0; q < 8; ++q) { a2[q] -= d2; c2[q] -= d2; }
    }
    f32x2v ps2 = {0.f, 0.f};
#pragma unroll
    for (int q = 0; q < 8; ++q) {
        f32x2v ea, ec; ea.x = ex2(a2[q].x); ea.y = ex2(a2[q].y); ec.x = ex2(c2[q].x); ec.y = ex2(c2[q].y);
        p0[2 * q] = ea.x; p0[2 * q + 1] = ea.y; p1[2 * q] = ec.x; p1[2 * q + 1] = ec.y;
        ps2 += ea; ps2 += ec;
    }
    const float ps = ps2.x + ps2.y;
    st.l = st.l * alpha + ps;
    if (__any(alpha != 1.f)) {
        if (hi == 0) wsf[r32] = alpha;
        __builtin_amdgcn_fence(__ATOMIC_RELEASE, "wavefront"); __builtin_amdgcn_wave_barrier(); __builtin_amdgcn_fence(__ATOMIC_ACQUIRE, "wavefront");
#pragma unroll
        for (int k4 = 0; k4 < 4; ++k4) { const f32x4 a = *(const LAS f32x4*)(wsf + 8 * k4 + 4 * hi);
#pragma unroll
            for (int e = 0; e < 4; ++e) { st.o0[4 * k4 + e] *= a[e]; st.o1[4 * k4 + e] *= a[e]; } }
        __builtin_amdgcn_fence(__ATOMIC_RELEASE, "wavefront"); __builtin_amdgcn_wave_barrier(); __builtin_amdgcn_fence(__ATOMIC_ACQUIRE, "wavefront");
    }
    const bf16x8 pa0 = pack_p(p0, 0), pa1 = pack_p(p0, 1), pa2 = pack_p(p1, 0), pa3 = pack_p(p1, 1);
    __builtin_amdgcn_sched_barrier(0);
#pragma unroll
    for (int db = 0; db < 2; ++db) {
        f32x16 o = db ? st.o1 : st.o0;
#pragma unroll
        for (int s = 0; s < 4; ++s) o = MFMA32(s == 0 ? pa0 : (s == 1 ? pa1 : (s == 2 ? pa2 : pa3)), vfr[4 * db + s], o);
        if (db) st.o1 = o; else st.o0 = o;
    }
}
DI void dma_kv64(const bf16* Ksrc, const bf16* Vsrc, unsigned pitch, LAS unsigned char* Kd, LAS unsigned char* Vd, int wid, int lane) {
    glds16s<0>(Ksrc + wid * 8, (unsigned)lane * pitch * 2u, (unsigned)__builtin_amdgcn_readfirstlane(lds_u32(Kd) + wid * 1024));
    glds16s<0>(Vsrc + (size_t)(16 * (wid & 3)) * pitch + (wid >> 2) * 32, ((unsigned)(lane >> 2) * pitch + (lane & 3) * 8) * 2u, (unsigned)__builtin_amdgcn_readfirstlane(lds_u32(Vd) + wid * 1024));
}
DI void ring_wait(int r) { if (r >= 2) WAITBAR(4); else if (r == 1) WAITBAR(2); else WAITBAR(0); }
DI void fold_branch(const Sm& st, float f, f32x16& fin0, f32x16& fin1, LAS float* wsf, int r32, int hi) {
    if (hi == 0) wsf[r32] = f;
    __builtin_amdgcn_fence(__ATOMIC_RELEASE, "wavefront"); __builtin_amdgcn_wave_barrier(); __builtin_amdgcn_fence(__ATOMIC_ACQUIRE, "wavefront");
#pragma unroll
    for (int k4 = 0; k4 < 4; ++k4) { const f32x4 a = *(const LAS f32x4*)(wsf + 8 * k4 + 4 * hi);
#pragma unroll
        for (int e = 0; e < 4; ++e) { fin0[4 * k4 + e] += st.o0[4 * k4 + e] * a[e]; fin1[4 * k4 + e] += st.o1[4 * k4 + e] * a[e]; } }
    __builtin_amdgcn_fence(__ATOMIC_RELEASE, "wavefront"); __builtin_amdgcn_wave_barrier(); __builtin_amdgcn_fence(__ATOMIC_ACQUIRE, "wavefront");
}

DI void nsa_unit(const Ctx& C, LAS unsigned char* lds, int b, int g, int qb, int nqb, bf16x8 (&qpre)[4], bool havepre) {
    int tid = C.tid(); asm volatile("" : "+v"(tid));
    const int lane = tid & 63, wid = __builtin_amdgcn_readfirstlane(tid >> 6), r32 = lane & 31, hi = lane >> 5;
    const int j = wid & 3, th = wid >> 2, head = 4 * g + j;
    const int tl = 32 * th + r32, t = 64 * qb + tl;
    const size_t row0 = (size_t)b * SEQ + 64 * qb;
    LAS unsigned char* Kb = lds;
    LAS unsigned char* Vb = lds + 32768;
    LAS float* impw = (LAS float*)(lds + 65536);
    LAS float* wsf = (LAS float*)(lds + LDS_MISC) + wid * 64;
    LAS unsigned char* selb = lds + LDS_MISC + 2048;
    LAS float* sc = (LAS float*)(lds + 65536);
    LAS float* stg;
    const float SC = 0.125f * LOG2E;
    bf16x8 qr[4];
    if (havepre) {
#pragma unroll
        for (int d0 = 0; d0 < 4; ++d0) qr[d0] = qpre[d0];
    } else { const bf16* qp = C.PROJ() + PO_NQ + ((size_t)(b * 16 + head) * SEQ + t) * 64 + 8 * hi;
#pragma unroll
      for (int d0 = 0; d0 < 4; ++d0) qr[d0] = *(const bf16x8*)(qp + 16 * d0); }
    const bf16* ngp = C.PROJ() + PO_NG + (row0 + tl) * 64 + head * 3;
    const float g0 = bf2f(ngp[0]), g1 = bf2f(ngp[1]), g2 = bf2f(ngp[2]);
    f32x16 fin0, fin1;
#pragma unroll
    for (int r = 0; r < 16; ++r) { fin0[r] = 0.f; fin1[r] = 0.f; }
    const int bg = b * 4 + g;

    const int nkt = ((4 * qb + 2) >> 6) + 1;
    if (!havepre) {
        LBAR();
        for (int kt = 0; kt < nkt; ++kt)
            dma_kv64(C.KVC() + ((size_t)bg * 256 + 64 * kt) * 64, C.KVC() + ((size_t)4096 + bg * 256 + 64 * kt) * 64, 64, Kb + kt * 8192, Vb + kt * 8192, wid, lane);
    }
    for (int idx = lane; idx < 32 * 66; idx += 64) impw[(j * 64 + 32 * th) * 66 + idx] = 0.f;
    WAITBAR(0);
    const int climit = (t >= 31) ? ((t - 31) >> 4) : -1;
    Sm st; st.m = NEGV; st.l = 0.f;
#pragma unroll
    for (int r = 0; r < 16; ++r) { st.o0[r] = 0.f; st.o1[r] = 0.f; }
    LAS float* fwv = (LAS float*)(lds + 139392);
    LAS float* spv = (LAS float*)(lds + 139392 + 4096);
    const bool need_imp = qb >= 16;
    LAS float* myimp = impw + (j * 64 + tl) * 66;
    for (int kt = 0; kt < nkt; ++kt) {
        f32x16 p0, p1;
#pragma unroll
        for (int r = 0; r < 16; ++r) { p0[r] = 0.f; p1[r] = 0.f; }
        qk_tile64(Kb + kt * 8192, qr, p0, p1, r32, hi);
#pragma unroll
        for (int r = 0; r < 16; ++r) { const int c = 64 * kt + crow(r, hi); p0[r] = (c <= climit) ? p0[r] : NEGV; p1[r] = (c + 32 <= climit) ? p1[r] : NEGV; }
        softmax_pv64_fast(Vb + kt * 8192, p0, p1, st, wsf, lane, r32, hi, climit >= 64 * kt, SC);
        if (need_imp) {
            if (hi == 0) fwv[(j * 64 + tl) * 4 + kt] = st.m;
            float mainv[8], nxtv[8], cur[8];
#pragma unroll
            for (int hf = 0; hf < 2; ++hf)
#pragma unroll
                for (int k4 = 0; k4 < 4; ++k4) {
                    const float a0 = hf ? p1[4 * k4] : p0[4 * k4], a1 = hf ? p1[4 * k4 + 1] : p0[4 * k4 + 1], a2 = hf ? p1[4 * k4 + 2] : p0[4 * k4 + 2], a3 = hf ? p1[4 * k4 + 3] : p0[4 * k4 + 3];
                    mainv[4 * hf + k4] = (a0 + a1) + (a2 + 0.5f * a3); nxtv[4 * hf + k4] = 0.5f * a3; }
#pragma unroll
            for (int q = 0; q < 8; ++q) cur[q] = myimp[16 * kt + 8 * (q >> 2) + 2 * (q & 3) + hi];
#pragma unroll
            for (int q = 0; q < 8; ++q) myimp[16 * kt + 8 * (q >> 2) + 2 * (q & 3) + hi] = cur[q] + mainv[q];
            __builtin_amdgcn_fence(__ATOMIC_RELEASE, "wavefront"); __builtin_amdgcn_wave_barrier(); __builtin_amdgcn_fence(__ATOMIC_ACQUIRE, "wavefront");
#pragma unroll
            for (int q = 0; q < 8; ++q) cur[q] = (q == 7 && hi == 1) ? 0.f : myimp[16 * kt + 8 * (q >> 2) + 2 * (q & 3) + hi + 1];
#pragma unroll
            for (int q = 0; q < 8; ++q) { if (q == 7 && hi == 1) { if (kt < 3) spv[(j * 64 + tl) * 3 + kt] = nxtv[7]; } else myimp[16 * kt + 8 * (q >> 2) + 2 * (q & 3) + hi + 1] = cur[q] + nxtv[q]; }
            __builtin_amdgcn_fence(__ATOMIC_RELEASE, "wavefront"); __builtin_amdgcn_wave_barrier(); __builtin_amdgcn_fence(__ATOMIC_ACQUIRE, "wavefront");
        }
    }
    {
        const float l = st.l + __shfl_xor(st.l, 32);
        const float inv_l = (climit >= 0) ? 1.f / l : 0.f;
#pragma unroll
        for (int r = 0; r < 16; ++r) { fin0[r] = 0.f; fin1[r] = 0.f; }
        fold_branch(st, g0 * inv_l, fin0, fin1, wsf, r32, hi);
        if (need_imp && hi == 0) {
            for (int kt = 0; kt < nkt; ++kt) { const float mr = fwv[(j * 64 + tl) * 4 + kt]; fwv[(j * 64 + tl) * 4 + kt] = ex2(mr - st.m) * inv_l; }
        }
    }
    LBAR();
    dma_kv64(C.PROJ() + PO_KV6 + 2 * KVSZ + (size_t)(b * 4 + g) * SEQ * 64, C.PROJ() + PO_KV6 + 3 * KVSZ + (size_t)(b * 4 + g) * SEQ * 64, 64, Kb, Vb, wid, lane);
    {
        const int tok = tid & 63, part = tid >> 6;
        float cand[8];
        {
            float imp[8];
#pragma unroll
            for (int e = 0; e < 8; ++e) imp[e] = 0.f;
            const int kt = part >> 1;
            if (need_imp && kt < nkt) {
#pragma unroll
                for (int jj = 0; jj < 4; ++jj) {
                    const float f = fwv[(jj * 64 + tok) * 4 + kt];
                    const LAS f32x2_t* ip = (const LAS f32x2_t*)(impw + (jj * 64 + tok) * 66 + part * 8);
#pragma unroll
                    for (int q = 0; q < 4; ++q) { const f32x2_t v = ip[q]; imp[2 * q] += v.x * f; imp[2 * q + 1] += v.y * f; }
                    if ((part & 1) == 0 && part >= 2) imp[0] += spv[(jj * 64 + tok) * 3 + kt - 1] * fwv[(jj * 64 + tok) * 4 + kt - 1];
                }
            }
#pragma unroll
            for (int e = 0; e < 8; ++e) { const int n = part * 8 + e;
                const bool forced = (n == 0) || (n == qb) || (n == qb - 1);
                cand[e] = (n <= qb) ? (imp[e] + (forced ? 1000.f : 0.f)) : NEGV; }
        }
        LBAR();
#pragma unroll
        for (int e = 0; e < 8; e += 4) *(LAS f32x4*)(sc + tok * 68 + part * 8 + e) = (f32x4){cand[e], cand[e + 1], cand[e + 2], cand[e + 3]};
        LBAR();
        if (qb < 16) {
            unsigned byte = 0;
#pragma unroll
            for (int e = 0; e < 8; ++e) { const int n = part * 8 + e; if (n <= qb) byte |= (1u << e); }
            selb[tok * 8 + part] = (unsigned char)byte;
        } else {
            unsigned key[8], srt[8], pr[8];
#pragma unroll
            for (int i = 0; i < 8; ++i) { const float c = sc[(wid * 8 + i) * 68 + lane]; key[i] = (lane <= qb) ? ((__float_as_uint(c) & ~63u) | (unsigned)(63 - lane)) : 0u; srt[i] = key[i]; }
#pragma unroll
            for (int k = 2; k <= 64; k <<= 1)
#pragma unroll
                for (int jx = k >> 1; jx > 0; jx >>= 1) {
                    const bool keepmax = (((lane & jx) == 0) == ((lane & k) == 0));
#pragma unroll
                    for (int i = 0; i < 8; ++i) pr[i] = (unsigned)__shfl_xor((int)srt[i], jx);
                    __builtin_amdgcn_sched_barrier(0);
#pragma unroll
                    for (int i = 0; i < 8; ++i) { const unsigned hi_ = srt[i] > pr[i] ? srt[i] : pr[i], lo_ = srt[i] > pr[i] ? pr[i] : srt[i]; srt[i] = keepmax ? hi_ : lo_; }
                    __builtin_amdgcn_sched_barrier(0);
                }
#pragma unroll
            for (int i = 0; i < 8; ++i) { const unsigned T = (unsigned)__builtin_amdgcn_readlane((int)srt[i], 15);
                const unsigned long long m = __ballot((lane <= qb) && (key[i] >= T));
                if (lane == 0) { v2u w; w.x = (unsigned)m; w.y = (unsigned)(m >> 32); *(LAS v2u*)(selb + (wid * 8 + i) * 8) = w; } }
        }
        LBAR();
    }
    unsigned long long mysel, un;
    { const v2u w = *(const LAS v2u*)(selb + tl * 8); mysel = ((unsigned long long)w.y << 32) | w.x;
      const v2u a = *(const LAS v2u*)(selb + lane * 8); unsigned lo = a.x, hh = a.y;
#pragma unroll
      for (int o = 1; o < 64; o <<= 1) { lo |= __shfl_xor(lo, o); hh |= __shfl_xor(hh, o); }
      un = ((unsigned long long)__builtin_amdgcn_readfirstlane(hh) << 32) | (unsigned)__builtin_amdgcn_readfirstlane(lo); }
    LAS float* accF = (LAS float*)(lds + 65536);
#pragma unroll
    for (int r = 0; r < 16; ++r) { const int tok = 32 * th + crow(r, hi); accF[tok * STG_PITCH + j * 64 + r32] = fin0[r]; accF[tok * STG_PITCH + j * 64 + 32 + r32] = fin1[r]; }
#define NSA_FOLD(F) do { const float f_ = (F); if (hi == 0) wsf[r32] = f_; \
        __builtin_amdgcn_fence(__ATOMIC_RELEASE, "wavefront"); __builtin_amdgcn_wave_barrier(); __builtin_amdgcn_fence(__ATOMIC_ACQUIRE, "wavefront"); \
        _Pragma("unroll") for (int k4 = 0; k4 < 4; ++k4) { const f32x4 a_ = *(const LAS f32x4*)(wsf + 8 * k4 + 4 * hi); \
            _Pragma("unroll") for (int e = 0; e < 4; ++e) { const int tok_ = 32 * th + 8 * k4 + 4 * hi + e; \
                accF[tok_ * STG_PITCH + j * 64 + r32] += st.o0[4 * k4 + e] * a_[e]; accF[tok_ * STG_PITCH + j * 64 + 32 + r32] += st.o1[4 * k4 + e] * a_[e]; } } \
        __builtin_amdgcn_fence(__ATOMIC_RELEASE, "wavefront"); __builtin_amdgcn_wave_barrier(); __builtin_amdgcn_fence(__ATOMIC_ACQUIRE, "wavefront"); } while (0)
#define NSA_QK(bo) f32x16 p0, p1; _Pragma("unroll") for (int r = 0; r < 16; ++r) { p0[r] = 0.f; p1[r] = 0.f; } qk_tile64(Kb + (bo), qr, p0, p1, r32, hi)

    {
        const bf16* Kg = C.PROJ() + PO_KV6 + 2 * KVSZ + (size_t)(b * 4 + g) * SEQ * 64;
        const bf16* Vg = C.PROJ() + PO_KV6 + 3 * KVSZ + (size_t)(b * 4 + g) * SEQ * 64;
        st.m = NEGV; st.l = 0.f;
#pragma unroll
        for (int r = 0; r < 16; ++r) { st.o0[r] = 0.f; st.o1[r] = 0.f; }
        unsigned long long um = un, ui = un; const int ntile = __builtin_popcountll(un);
        ui &= ui - 1;
#pragma unroll
        for (int q = 1; q < 3; ++q) if (q < ntile) { const int n = __builtin_ctzll(ui); ui &= ui - 1; dma_kv64(Kg + (size_t)4096 * n, Vg + (size_t)4096 * n, 64, Kb + q * 8192, Vb + q * 8192, wid, lane); }
        for (int i = 0; i < ntile - 1; ++i) {
            const int n = __builtin_ctzll(um); um &= um - 1;
            ring_wait(ntile - 1 - i);
            if (i + 3 < ntile) { const int n2 = __builtin_ctzll(ui); ui &= ui - 1; const int bo2 = ((i + 3) & 3) * 8192; dma_kv64(Kg + (size_t)4096 * n2, Vg + (size_t)4096 * n2, 64, Kb + bo2, Vb + bo2, wid, lane); }
            const bool seln = (mysel >> n) & 1ull;
            if (__any(seln)) { const int bo = (i & 3) * 8192; NSA_QK(bo); softmax_pv64_fast(Vb + bo, p0, p1, st, wsf, lane, r32, hi, seln, SC); }
        }
        {
            const int i = ntile - 1;
            ring_wait(0);
            const int bo = (i & 3) * 8192; NSA_QK(bo);
#pragma unroll
            for (int r = 0; r < 16; ++r) { const int kv = crow(r, hi); p0[r] = (kv <= tl) ? p0[r] : -3.0e38f; p1[r] = (kv + 32 <= tl) ? p1[r] : -3.0e38f; }
            softmax_pv64_fast(Vb + bo, p0, p1, st, wsf, lane, r32, hi, true, SC);
        }
        const float l = st.l + __shfl_xor(st.l, 32);
        NSA_FOLD(g1 / l);
    }
    WAITBAR(0);
    v4u nzv[4];
    { const bf16* nz = C.PROJ() + PO_NZ + ((size_t)(b * 16 + 4 * g + ((tid & 7) >> 1)) * SEQ + 64 * qb + (tid >> 3)) * 64 + (tid & 1) * 32;
#pragma unroll
      for (int q = 0; q < 4; ++q) nzv[q] = *(const v4u*)(nz + 8 * ((q + ((tid & 7) >> 1)) & 3)); }
    {
        const bf16* Kg = C.PROJ() + PO_KV6 + 4 * KVSZ + (size_t)(b * 4 + g) * SEQ * 64;
        const bf16* Vg = C.PROJ() + PO_KV6 + 5 * KVSZ + (size_t)(b * 4 + g) * SEQ * 64;
        st.m = NEGV; st.l = 0.f;
#pragma unroll
        for (int r = 0; r < 16; ++r) { st.o0[r] = 0.f; st.o1[r] = 0.f; }
        const int n0 = qb >= 8 ? qb - 8 : 0; const int ntile = qb - n0 + 1;
#pragma unroll
        for (int q = 0; q < 3; ++q) if (q < ntile) dma_kv64(Kg + (size_t)4096 * (n0 + q), Vg + (size_t)4096 * (n0 + q), 64, Kb + q * 8192, Vb + q * 8192, wid, lane);
        int i = 0;
        if (qb >= 8) {
            ring_wait(ntile - 1);
            if (3 < ntile) dma_kv64(Kg + (size_t)4096 * (n0 + 3), Vg + (size_t)4096 * (n0 + 3), 64, Kb + 3 * 8192, Vb + 3 * 8192, wid, lane);
            NSA_QK(0);
#pragma unroll
            for (int r = 0; r < 16; ++r) { const int kv = crow(r, hi); p0[r] = (kv > tl) ? p0[r] : -3.0e38f; p1[r] = (kv + 32 > tl) ? p1[r] : -3.0e38f; }
            softmax_pv64_fast(Vb, p0, p1, st, wsf, lane, r32, hi, true, SC);
            i = 1;
        }
        for (; i < ntile - 1; ++i) {
            ring_wait(ntile - 1 - i);
            if (i + 3 < ntile) { const int bo2 = ((i + 3) & 3) * 8192; dma_kv64(Kg + (size_t)4096 * (n0 + i + 3), Vg + (size_t)4096 * (n0 + i + 3), 64, Kb + bo2, Vb + bo2, wid, lane); }
            const int bo = (i & 3) * 8192; NSA_QK(bo);
            softmax_pv64_fast(Vb + bo, p0, p1, st, wsf, lane, r32, hi, true, SC);
        }
        {
            ring_wait(0);
            const int bo = ((ntile - 1) & 3) * 8192; NSA_QK(bo);
#pragma unroll
            for (int r = 0; r < 16; ++r) { const int kv = crow(r, hi); p0[r] = (kv <= tl) ? p0[r] : -3.0e38f; p1[r] = (kv + 32 <= tl) ? p1[r] : -3.0e38f; }
            softmax_pv64_fast(Vb + bo, p0, p1, st, wsf, lane, r32, hi, true, SC);
        }
        const float l = st.l + __shfl_xor(st.l, 32);
        NSA_FOLD(g2 / l);
    }
#undef NSA_FOLD
#undef NSA_QK
    LBAR();
#pragma unroll
    for (int q = 0; q < 4; ++q) asm volatile("" :: "v"(nzv[q]));
    if (nqb >= 0) {
        const int nkt2 = ((4 * nqb + 2) >> 6) + 1;
        for (int kt = 0; kt < nkt2; ++kt)
            dma_kv64(C.KVC() + ((size_t)bg * 256 + 64 * kt) * 64, C.KVC() + ((size_t)4096 + bg * 256 + 64 * kt) * 64, 64, Kb + kt * 8192, Vb + kt * 8192, wid, lane);
        const bf16* qp = C.PROJ() + PO_NQ + ((size_t)(b * 16 + head) * SEQ + 64 * nqb + tl) * 64 + 8 * hi;
#pragma unroll
        for (int d0 = 0; d0 < 4; ++d0) qpre[d0] = *(const bf16x8*)(qp + 16 * d0);
    }
    stg = accF;
    {
        const int tok = tid >> 3, seg = tid & 7;
        bf16* dst = C.MIX() + (row0 + tok) * DM + 1024 + g * 256 + seg * 32;
#pragma unroll
        for (int q = 0; q < 4; ++q) { const int qq = (q + (seg >> 1)) & 3;
            float z[8], o[8]; unpack8(nzv[q], z);
            const f32x4 a = *(const LAS f32x4*)(stg + tok * STG_PITCH + seg * 32 + 8 * qq), c = *(const LAS f32x4*)(stg + tok * STG_PITCH + seg * 32 + 8 * qq + 4);
            o[0] = a.x * z[0]; o[1] = a.y * z[1]; o[2] = a.z * z[2]; o[3] = a.w * z[3];
            o[4] = c.x * z[4]; o[5] = c.y * z[5]; o[6] = c.z * z[6]; o[7] = c.w * z[7];
            *(v4u*)(dst + 8 * qq) = pack8(o);
        }
    }
    LBAR();
}

DI void mlstm_delta_unit(const Ctx& C, LAS unsigned char* lds, int bh, int c) {
    int tid = C.tid(); asm volatile("" : "+v"(tid));
    const int lane = tid & 63, wid = __builtin_amdgcn_readfirstlane(tid >> 6), r32 = lane & 31, hi = lane >> 5;
    const int dkw = wid & 3, dvw = wid >> 2, b = bh >> 2, h = bh & 3;
    const size_t rowb = (size_t)b * SEQ + 256 * c;
    const float mend2 = C.mx2()[(size_t)bh * SEQ + 256 * c + 255];
    const float* u2p = C.u2() + (size_t)bh * SEQ + 256 * c;
    const bf16* Kg = C.KC() + ((size_t)bh * SEQ + 256 * c) * 256;
    const bf16* Vg = C.PROJ() + PO_MV + ((size_t)bh * SEQ + 256 * c) * 256;
    LAS float* u2l = (LAS float*)(lds + LDS_MISC + 2048);
    f32x16 acc[2][4];
#pragma unroll
    for (int a = 0; a < 2; ++a)
#pragma unroll
        for (int d = 0; d < 4; ++d)
#pragma unroll
            for (int r = 0; r < 16; ++r) acc[a][d][r] = 0.f;
    float nacc[2] = {0.f, 0.f};
    const unsigned voK_ = ((unsigned)(lane >> 2) * 256u + (lane & 3) * 8u) * 2u, voV_ = voK_;
#define MD_DMA(st, buf) do { const unsigned Kd_ = (unsigned)__builtin_amdgcn_readfirstlane(lds_u32(lds) + (buf) * 65536u + wid * 1024u), Vd_ = Kd_ + 32768u; \
        const bf16* kb_ = Kg + (size_t)(64 * (st) + 16 * (wid & 3)) * 256 + (wid >> 2) * 32; const bf16* vb_ = Vg + (size_t)(64 * (st) + 16 * (wid & 3)) * 256 + (wid >> 2) * 32; \
        glds16s<0>(kb_, voK_, Kd_); glds16s<0>(kb_ + 64, voK_, Kd_ + 8192u); glds16s<0>(kb_ + 128, voK_, Kd_ + 16384u); glds16s<0>(kb_ + 192, voK_, Kd_ + 24576u); \
        glds16s<0>(vb_, voV_, Vd_); glds16s<0>(vb_ + 64, voV_, Vd_ + 8192u); glds16s<0>(vb_ + 128, voV_, Vd_ + 16384u); glds16s<0>(vb_ + 192, voV_, Vd_ + 24576u); \
        if (wid == 0) glds16s<0>(u2p + 64 * (st), (unsigned)lane * 16u, (unsigned)__builtin_amdgcn_readfirstlane(lds_u32(u2l) + (buf) * 1024u)); } while (0)
    WAITBAR(0);
    MD_DMA(0, 0);
    const int vpn = ((lane >> 4) & 1) * 32 + (lane & 3) * 8 + (8 * hi + ((lane & 15) >> 2)) * 64;
    for (int st = 0; st < 4; ++st) {
        WAITBAR(0);
        if (st + 1 < 4) MD_DMA(st + 1, (st + 1) & 1);
        const LAS unsigned char* Kt = lds + (st & 1) * 65536; const LAS unsigned char* Vt = Kt + 32768;
        const LAS float* u2t = u2l + (st & 1) * 256;
#pragma unroll
        for (int ss = 0; ss < 4; ++ss) {
            const f32x4 ua = *(const LAS f32x4*)(u2t + 16 * ss + 8 * hi), ub = *(const LAS f32x4*)(u2t + 16 * ss + 8 * hi + 4);
            float w[8];
#pragma unroll
            for (int e = 0; e < 4; ++e) { w[e] = ex2(ua[e] - mend2); w[4 + e] = ex2(ub[e] - mend2); }
            bf16x8 af[2];
#pragma unroll
            for (int db = 0; db < 2; ++db) {
                const s16x4 lo = vtr(Kt + (2 * dkw + db) * 4096 + ss * 1024 + vpn), h4 = vtr(Kt + (2 * dkw + db) * 4096 + ss * 1024 + vpn + 256);
                float f[8];
#pragma unroll
                for (int e = 0; e < 4; ++e) { f[e] = bf2f((bf16)lo[e]) * w[e]; f[4 + e] = bf2f((bf16)h4[e]) * w[4 + e]; }
                nacc[db] += ((f[0] + f[1]) + (f[2] + f[3])) + ((f[4] + f[5]) + (f[6] + f[7]));
                af[db] = __builtin_bit_cast(bf16x8, pack8(f));
            }
#pragma unroll
            for (int dbv = 0; dbv < 4; ++dbv) {
                const s16x4 lo = vtr(Vt + (4 * dvw + dbv) * 4096 + ss * 1024 + vpn), h4 = vtr(Vt + (4 * dvw + dbv) * 4096 + ss * 1024 + vpn + 256);
                const bf16x8 vf = __builtin_shufflevector(lo, h4, 0, 1, 2, 3, 4, 5, 6, 7);
                acc[0][dbv] = MFMA32(vf, af[0], acc[0][dbv]); acc[1][dbv] = MFMA32(vf, af[1], acc[1][dbv]);
            }
            asm volatile("" ::: "memory");
        }
    }
#undef MD_DMA
    bf16* dsp = (bf16*)C.out + ((size_t)(bh * 16 + c) << 16);
#pragma unroll
    for (int db = 0; db < 2; ++db)
#pragma unroll
        for (int dbv = 0; dbv < 4; ++dbv)
#pragma unroll
            for (int p2 = 0; p2 < 2; ++p2) {
                unsigned a0 = pk2(acc[db][dbv][8 * p2], acc[db][dbv][8 * p2 + 1]), a1 = pk2(acc[db][dbv][8 * p2 + 2], acc[db][dbv][8 * p2 + 3]);
                unsigned b0 = pk2(acc[db][dbv][8 * p2 + 4], acc[db][dbv][8 * p2 + 5]), b1 = pk2(acc[db][dbv][8 * p2 + 6], acc[db][dbv][8 * p2 + 7]);
                { const auto r0 = __builtin_amdgcn_permlane32_swap(a0, b0, false, false); a0 = r0[0]; b0 = r0[1]; const auto r1 = __builtin_amdgcn_permlane32_swap(a1, b1, false, false); a1 = r1[0]; b1 = r1[1]; }
                v4u w; w.x = a0; w.y = a1; w.z = b0; w.w = b1;
                *(v4u*)(dsp + (size_t)(32 * (2 * dkw + db) + r32) * 256 + 32 * (4 * dvw + dbv) + 16 * p2 + 8 * hi) = w; }
#pragma unroll
    for (int db = 0; db < 2; ++db) { const float n = nacc[db] + __shfl_xor(nacc[db], 32); if (dvw == 0 && hi == 0) C.DN()[(size_t)(bh * 16 + c) * 256 + 32 * (2 * dkw + db) + r32] = n; }
    WAITBAR(0);
}
DI void mlstm_scan(const Ctx& C) {
    int tid = C.tid(); asm volatile("" : "+v"(tid));
    const int gt = C.vcu * NTHREADS + tid, NGT = C.G * NTHREADS;
    for (int it = 0; ; ++it) {
        bool isn; int bh; size_t off;
        if (C.G == 256) {
            if (it == 0) { isn = false; bh = gt >> 13; off = (size_t)(gt & 8191) * 8; }
            else if (it == 1 && tid < 2) { isn = true; bh = C.vcu >> 4; off = (size_t)((C.vcu & 15) * 2 + tid) * 8; }
            else break;
        } else { const int e8 = gt + it * NGT; if (e8 >= 16 * 8192 + 512) break;
            isn = e8 >= 16 * 8192; bh = isn ? ((e8 - 16 * 8192) >> 5) : (e8 >> 13); off = isn ? (size_t)((e8 - 16 * 8192) & 31) * 8 : (size_t)(e8 & 8191) * 8; }
        f32x4 ld[15][2];
        if (isn) { const float* src = C.DN() + (size_t)bh * 16 * 256 + off;
#pragma unroll
            for (int c = 0; c < 15; ++c) { ld[c][0] = *(const f32x4*)(src + c * 256); ld[c][1] = *(const f32x4*)(src + c * 256 + 4); } }
        else { const bf16* src = (const bf16*)C.out + ((size_t)bh * 16 << 16) + off;
#pragma unroll
            for (int c = 0; c < 15; ++c) { float f[8]; unpack8(*(const v4u*)(src + (size_t)c * 65536), f); ld[c][0] = (f32x4){f[0], f[1], f[2], f[3]}; ld[c][1] = (f32x4){f[4], f[5], f[6], f[7]}; } }
        float mr[16]; mr[0] = 0.f;
#pragma unroll
        for (int c = 1; c < 16; ++c) mr[c] = C.mx2()[(size_t)bh * SEQ + 256 * c - 1];
        f32x4 s0 = {0.f, 0.f, 0.f, 0.f}, s1 = {0.f, 0.f, 0.f, 0.f};
#pragma unroll
        for (int c = 0; c < 15; ++c) {
            const float d = ex2(mr[c] - mr[c + 1]);
            s0 = s0 * d + ld[c][0]; s1 = s1 * d + ld[c][1];
            if (isn) { float* dst = C.NS() + (size_t)(bh * 16 + c + 1) * 256 + off; *(f32x4*)dst = s0; *(f32x4*)(dst + 4) = s1; }
            else { v4u w; w.x = pk2(s0[0], s0[1]); w.y = pk2(s0[2], s0[3]); w.z = pk2(s1[0], s1[1]); w.w = pk2(s1[2], s1[3]);
                   *(v4u*)(C.SB() + ((size_t)(bh * 16 + c + 1) << 16) + off) = w; }
        }
    }
}
DI void mlstm_out_unit(const Ctx& C, LAS unsigned char* lds, int b, int h, int iq) {
    int tid = C.tid(); asm volatile("" : "+v"(tid));
    const int lane = tid & 63, wid = __builtin_amdgcn_readfirstlane(tid >> 6), r32 = lane & 31, hi = lane >> 5;
    const int rg = wid & 3, dvh = wid >> 2, bh = b * 4 + h, c = iq >> 1;
    const int ql = 32 * rg + r32, qabs = 128 * iq + ql;
    const size_t rowb = (size_t)b * SEQ;
    LAS float* wsf = (LAS float*)(lds + LDS_MISC) + wid * 64;
    LAS float* u2l = (LAS float*)(lds + LDS_MISC + 2048);
    LAS float* nl = (LAS float*)(lds + LDS_MISC + 5120);
    LAS float* stg = (LAS float*)lds;
    const float* u2p = C.u2() + (size_t)bh * SEQ;
    f32x16 o[4];
#pragma unroll
    for (int d = 0; d < 4; ++d)
#pragma unroll
        for (int r = 0; r < 16; ++r) o[d][r] = 0.f;
    float den = 0.f, den_i = 0.f;
    const int nintra = 2 * (iq & 1) + 2, tt0 = 4 * c;
    const bf16* Kg = C.KC() + (size_t)bh * SEQ * 256;
    const bf16* Vg = C.PROJ() + PO_MV + (size_t)bh * SEQ * 256;
    const bf16* Sg = C.SB() + ((size_t)(bh * 16 + c) << 16);
    const float* ng = C.NS() + (size_t)(bh * 16 + c) * 256;
    const unsigned voK_ = (unsigned)lane * 512u, voS_ = ((unsigned)(lane >> 2) * 256u + (lane & 3) * 8u) * 2u, voV_ = voS_;
#define ML_K(tt, R) do { const unsigned Kd_ = (unsigned)__builtin_amdgcn_readfirstlane(lds_u32(lds) + (R) * 32768u + wid * 1024u); const bf16* kb_ = Kg + (size_t)(64 * (tt)) * 256 + wid * 8; \
        glds16s<0>(kb_, voK_, Kd_); glds16s<0>(kb_ + 64, voK_, Kd_ + 8192u); glds16s<0>(kb_ + 128, voK_, Kd_ + 16384u); glds16s<0>(kb_ + 192, voK_, Kd_ + 24576u); } while (0)
#define ML_V(tt, R) do { const unsigned Vd_ = (unsigned)__builtin_amdgcn_readfirstlane(lds_u32(lds) + (R) * 32768u + wid * 1024u); const bf16* vb_ = Vg + (size_t)(64 * (tt) + 16 * (wid & 3)) * 256 + (wid >> 2) * 32; \
        glds16s<0>(vb_, voV_, Vd_); glds16s<0>(vb_ + 64, voV_, Vd_ + 8192u); glds16s<0>(vb_ + 128, voV_, Vd_ + 16384u); glds16s<0>(vb_ + 192, voV_, Vd_ + 24576u); } while (0)
#define ML_S(sl, R) do { const unsigned Vd_ = (unsigned)__builtin_amdgcn_readfirstlane(lds_u32(lds) + (R) * 32768u + wid * 1024u); const bf16* sb_ = Sg + (size_t)(64 * (sl) + 16 * (wid & 3)) * 256 + (wid >> 2) * 32; \
        glds16s<0>(sb_, voS_, Vd_); glds16s<0>(sb_ + 64, voS_, Vd_ + 8192u); glds16s<0>(sb_ + 128, voS_, Vd_ + 16384u); glds16s<0>(sb_ + 192, voS_, Vd_ + 24576u); } while (0)
    LAS float* gnl = (LAS float*)(lds + LDS_MISC + 6144);
    if (wid == 0) glds16s<0>(u2p + 256 * c, (unsigned)lane * 16u, (unsigned)__builtin_amdgcn_readfirstlane(lds_u32(u2l)));
    if (wid == 2) glds16s<0>(C.m_norm_g + h * 256, (unsigned)lane * 16u, (unsigned)__builtin_amdgcn_readfirstlane(lds_u32(gnl)));
    if (c >= 1) {
        if (wid == 1) glds16s<0>(ng, (unsigned)lane * 16u, (unsigned)__builtin_amdgcn_readfirstlane(lds_u32(nl)));
        ML_S(0, 0); ML_S(1, 1); ML_S(2, 2); ML_S(3, 3);
    } else {
        ML_K(tt0, 0); ML_V(tt0, 1); ML_K(tt0 + 1, 2);
    }
    bf16x8 qf[16];
    { const bf16* qp = C.QC() + ((size_t)bh * SEQ + qabs) * 256 + 8 * hi;
#pragma unroll
      for (int ks = 0; ks < 16; ++ks) qf[ks] = *(const bf16x8*)(qp + 16 * ks); }
    const float mx2 = C.mx2()[(size_t)bh * SEQ + qabs];
    const float mref2 = (c >= 1) ? C.mx2()[(size_t)bh * SEQ + 256 * c - 1] : 0.f;
#define ML_USEQ() do { _Pragma("unroll") for (int ks = 0; ks < 16; ++ks) asm volatile("" :: "v"(qf[ks])); asm volatile("" :: "v"(mx2), "v"(mref2)); } while (0)
    if (c >= 1) {
        const int vpn = ((lane >> 4) & 1) * 32 + (lane & 3) * 8 + (8 * hi + ((lane & 15) >> 2)) * 64;
#pragma unroll
        for (int k = 0; k < 4; ++k) {
            if (k == 0) { WAITBAR(12); ML_USEQ(); } else WAITBAR(8);
            if (k == 1) ML_K(tt0, 0); else if (k == 2) ML_V(tt0, 1); else if (k == 3) ML_K(tt0 + 1, 2);
            const LAS unsigned char* Vt = lds + k * 32768 + (4 * dvh) * 4096 + vpn;
#pragma unroll
            for (int s = 0; s < 4; ++s)
#pragma unroll
                for (int db = 0; db < 4; ++db) {
                    const s16x4 lo = vtr(Vt + db * 4096 + s * 1024), h4 = vtr(Vt + db * 4096 + s * 1024 + 256);
                    const bf16x8 sf = __builtin_shufflevector(lo, h4, 0, 1, 2, 3, 4, 5, 6, 7);
                    o[db] = MFMA32(qf[4 * k + s], sf, o[db]);
                    if (db == 3) asm volatile("" ::: "memory");
                }
        }
        float dq = 0.f;
#pragma unroll
        for (int ks = 0; ks < 16; ++ks) { float qv[8]; unpack8(__builtin_bit_cast(v4u, qf[ks]), qv);
            const f32x4 na = *(const LAS f32x4*)(nl + 16 * ks + 8 * hi), nb = *(const LAS f32x4*)(nl + 16 * ks + 8 * hi + 4);
            dq += ((qv[0] * na[0] + qv[1] * na[1]) + (qv[2] * na[2] + qv[3] * na[3])) + ((qv[4] * nb[0] + qv[5] * nb[1]) + (qv[6] * nb[2] + qv[7] * nb[3])); }
        dq += __shfl_xor(dq, 32);
        const float fq = ex2(mref2 - mx2);
        den_i = fq * dq;
        if (hi == 0) wsf[r32] = fq;
        __builtin_amdgcn_fence(__ATOMIC_RELEASE, "wavefront"); __builtin_amdgcn_wave_barrier(); __builtin_amdgcn_fence(__ATOMIC_ACQUIRE, "wavefront");
#pragma unroll
        for (int k4 = 0; k4 < 4; ++k4) { const f32x4 a = *(const LAS f32x4*)(wsf + 8 * k4 + 4 * hi);
#pragma unroll
            for (int e = 0; e < 4; ++e)
#pragma unroll
                for (int db = 0; db < 4; ++db) o[db][4 * k4 + e] *= a[e]; }
        __builtin_amdgcn_fence(__ATOMIC_RELEASE, "wavefront"); __builtin_amdgcn_wave_barrier(); __builtin_amdgcn_fence(__ATOMIC_ACQUIRE, "wavefront");
    }
    for (int i = 0; i < nintra; ++i) {
        const int tt = tt0 + i;
        if (i == 0) { WAITBAR(4); if (c == 0) ML_USEQ(); ML_V(tt0 + 1, 3); }
        else { WAITBAR(0); if (i + 1 < nintra) { ML_K(tt + 1, 2 * ((i + 1) & 1)); ML_V(tt + 1, 2 * ((i + 1) & 1) + 1); } }
        const LAS unsigned char* Kt = lds + (i & 1) * 65536; const LAS unsigned char* Vt = Kt + 32768;
        const LAS float* u2t = u2l + 64 * i;
        const int kv0 = 64 * tt - 128 * iq;
        if (kv0 > 32 * rg + 31) continue;
        const int lim = ql - kv0;
        const LAS unsigned char* vp = Vt + (4 * dvh) * 4096 + ((lane >> 4) & 1) * 32 + (lane & 3) * 8 + (4 * hi + ((lane & 15) >> 2)) * 64;
#pragma unroll
        for (int hf = 0; hf < 2; ++hf) {
            f32x16 p;
#pragma unroll
            for (int r = 0; r < 16; ++r) p[r] = 0.f;
            { const LAS unsigned char* kb = Kt + hi * 1024 + r32 * 16 + hf * 512;
#pragma unroll
              for (int ks = 0; ks < 16; ++ks) { const bf16x8 b0 = *(const LAS bf16x8*)(kb + ks * 2048); p = MFMA32(b0, qf[ks], p); } }
            float ps = 0.f;
#pragma unroll
            for (int k4 = 0; k4 < 4; ++k4) {
                const f32x4 ua = *(const LAS f32x4*)(u2t + 32 * hf + 8 * k4 + 4 * hi);
#pragma unroll
                for (int e = 0; e < 4; ++e) { const int r = 4 * k4 + e, kv = 32 * hf + 8 * k4 + 4 * hi + e;
                    const float wa = (kv <= lim) ? ex2(ua[e] - mx2) * p[r] : 0.f; p[r] = wa; ps += wa; }
            }
            den += ps;
            const bf16x8 pa0 = pack_p(p, 0), pa1 = pack_p(p, 1);
#pragma unroll
            for (int db = 0; db < 4; ++db) {
#pragma unroll
                for (int s = 0; s < 2; ++s) {
                    const s16x4 lo = vtr(vp + db * 4096 + (2 * hf + s) * 1024), hh = vtr(vp + db * 4096 + (2 * hf + s) * 1024 + 512);
                    const bf16x8 vf = __builtin_shufflevector(lo, hh, 0, 1, 2, 3, 4, 5, 6, 7);
                    o[db] = MFMA32(s == 0 ? pa0 : pa1, vf, o[db]);
                }
            }
        }
    }
#undef ML_K
#undef ML_V
#undef ML_S
#undef ML_USEQ
    const int erow = tid >> 2, eseg = tid & 3;
    const size_t grow = rowb + 128 * iq + erow;
    v4u mgv[8];
    { const bf16* mg = C.PROJ() + PO_MG + ((size_t)bh * SEQ + 128 * iq + erow) * 256 + eseg * 64;
#pragma unroll
      for (int q = 0; q < 8; ++q) mgv[q] = *(const v4u*)(mg + 8 * ((q + 2 * eseg) & 7)); }
    const LAS float* gn = gnl + eseg * 64;
    den += __shfl_xor(den, 32);
    den += den_i;
    const float f = 1.f / fmaxf(fabsf(den), 1.f);
    if (hi == 0) wsf[r32] = f;
    __builtin_amdgcn_fence(__ATOMIC_RELEASE, "wavefront"); __builtin_amdgcn_wave_barrier(); __builtin_amdgcn_fence(__ATOMIC_ACQUIRE, "wavefront");
    float fr[16];
#pragma unroll
    for (int k4 = 0; k4 < 4; ++k4) { const f32x4 a = *(const LAS f32x4*)(wsf + 8 * k4 + 4 * hi); fr[4 * k4] = a.x; fr[4 * k4 + 1] = a.y; fr[4 * k4 + 2] = a.z; fr[4 * k4 + 3] = a.w; }
    LBAR();
#pragma unroll
    for (int db = 0; db < 4; ++db)
#pragma unroll
        for (int r = 0; r < 16; ++r) stg[(32 * rg + crow(r, hi)) * STG_PITCH + 128 * dvh + 32 * db + r32] = o[db][r] * fr[r];
    LBAR();
    {
        const LAS float* sp = stg + erow * STG_PITCH + eseg * 64;
        f32x4 hvv[16];
#pragma unroll
        for (int q = 0; q < 16; ++q) hvv[q] = *(const LAS f32x4*)(sp + 4 * ((q + 4 * eseg) & 15));
        float s1 = 0.f;
#pragma unroll
        for (int q = 0; q < 16; ++q) s1 += (hvv[q].x + hvv[q].y) + (hvv[q].z + hvv[q].w);
        s1 += __shfl_xor(s1, 1); s1 += __shfl_xor(s1, 2);
        const float mu = s1 * (1.f / 256.f);
        float s2 = 0.f;
#pragma unroll
        for (int q = 0; q < 16; ++q) { const float d0 = hvv[q].x - mu, d1 = hvv[q].y - mu, d2 = hvv[q].z - mu, d3 = hvv[q].w - mu; s2 += (d0 * d0 + d1 * d1) + (d2 * d2 + d3 * d3); }
        s2 += __shfl_xor(s2, 1); s2 += __shfl_xor(s2, 2);
        const float rstd = 1.f / sqrtf(s2 * (1.f / 256.f) + EPSV);
        bf16* dst = C.MIX() + grow * DM + h * 256 + eseg * 64;
#pragma unroll
        for (int q = 0; q < 8; ++q) { const int qq = (q + 2 * eseg) & 7;
            float vg[8], y[8]; unpack8(mgv[q], vg);
            const f32x4 a = hvv[2 * q], cc = hvv[2 * q + 1];
            const f32x4 ga = *(const LAS f32x4*)(gn + 8 * qq), gc = *(const LAS f32x4*)(gn + 8 * qq + 4);
            const float hv[8] = {a.x, a.y, a.z, a.w, cc.x, cc.y, cc.z, cc.w}, gg[8] = {ga.x, ga.y, ga.z, ga.w, gc.x, gc.y, gc.z, gc.w};
#pragma unroll
            for (int e = 0; e < 8; ++e) y[e] = (hv[e] - mu) * rstd * gg[e] * vg[e];
            *(v4u*)(dst + 8 * qq) = pack8(y);
        }
    }
    LBAR();
}

struct Args { const void* in[21]; float* out; unsigned char* ws; };
__global__ void __launch_bounds__(NTHREADS, 2) mega_fwd(Args a) {
    extern __shared__ __attribute__((aligned(16))) unsigned char lds_raw[];
    LAS unsigned char* lds = (LAS unsigned char*)lds_raw;
    cg::grid_group grid = cg::this_grid();
    Ctx C;
    C.x = (const float*)a.in[0]; C.p = (const float*)a.in[1]; C.positions = (const int*)a.in[2]; C.norm_g = (const float*)a.in[3]; C.w_in = (const float*)a.in[4];
    C.conv_w = (const float*)a.in[5]; C.conv_b = (const float*)a.in[6]; C.b_ig = (const float*)a.in[7]; C.b_fg = (const float*)a.in[8]; C.m_norm_g = (const float*)a.in[9];
    C.pos_k = (const float*)a.in[10]; C.pos_v = (const float*)a.in[11]; C.ck_w1 = (const float*)a.in[12]; C.ck_w2 = (const float*)a.in[13]; C.cv_w1 = (const float*)a.in[14]; C.cv_w2 = (const float*)a.in[15];
    C.w_out = (const float*)a.in[16]; C.gate_w = (const float*)a.in[17]; C.ple_w = (const float*)a.in[18]; C.ple_g = (const float*)a.in[19]; C.final_g = (const float*)a.in[20];
    C.out = a.out; C.ws = a.ws;
    unsigned char* ws = a.ws;
    if (threadIdx.x < 8) ((volatile LAS unsigned*)(lds + LDS_MISC + 4096))[threadIdx.x] = 0u;
    __syncthreads();
    C.wbase = (int)__builtin_amdgcn_readfirstlane((int)threadIdx.x) & ~63;
    XcdBarrier bar = xcd_barrier_post((unsigned*)ws, (volatile LAS unsigned*)(lds + LDS_MISC + 4096), C.tid() == 0);
#define GSYNC() xcd_barrier(bar, C.tid() == 0)
    C.G = gridDim.x; { const int bx = blockIdx.x; C.vcu = (C.G % 8 == 0) ? (bx % 8) * (C.G / 8) + bx / 8 : bx; }

#ifndef PROBE_SEL
#define PROBE_SEL 0
#endif
#if PROBE_SEL
    unsigned long long ts_[12]; int nts_ = 0;
#define STAMP() do { ts_[nts_++] = __builtin_amdgcn_s_memrealtime(); } while (0)
#else
#define STAMP() do { } while (0)
#endif
    STAMP();
#ifndef PHMASK
#define PHMASK 0xffff
#endif
#if PHMASK & 1
    phase0(C, lds);
#endif
    if (a.ws == nullptr) grid.sync();
    if (C.tid() == 0) __hip_atomic_fetch_or((unsigned*)(ws + 16384) + 64 * ((int)blockIdx.x & 7) + 40, 1u << xb_xcc_id(), __ATOMIC_RELAXED, __HIP_MEMORY_SCOPE_AGENT);
    GSYNC(); STAMP();
    bool loc_ok;
    { unsigned all = 0u, okb = (C.G == 256) ? 1u : 0u;
      for (int k = 0; k < 8; ++k) { const unsigned mk = xb_ld((unsigned*)(ws + 16384) + 64 * k + 40); okb &= (__builtin_popcount(mk) == 1) ? 1u : 0u; all |= mk; }
      okb &= (__builtin_popcount(all) == 8) ? 1u : 0u;
      loc_ok = __builtin_amdgcn_readfirstlane((int)okb) != 0; }
#define LSYNC() do { if (loc_ok) xcd_barrier_local(bar, C.tid() == 0); else xcd_barrier(bar, C.tid() == 0); } while (0)
#if PHMASK & 2
    { pg8::Gemm g{C.XN(), C.WinT(), NT, DINP, DM, DM, DM};
      EpiProj E{C.PROJ(), C.gates(), C.rope()};
      const int bx = (int)blockIdx.x;
      if (C.G == 256) {
          if (bx & 1) {
              P1Order S0; S0.init(bx, 0); pg8::Unit u0; S0.next(0, u0);
              float* part = (float*)(C.ws + WS_MIX) + (size_t)(bx >> 1) * 65536;
              int kh = DM / 2; asm volatile("" : "+s"(kh));
              pg8::Gemm gh{C.XN(), C.WinT(), NT, DINP, kh, DM, DM};
              { HalfUnit H{u0.pm, u0.pn, 0, nullptr}; EpiPartSave EP{part}; pg8::gemm_phase<EpiPartSave, HalfUnit, true, true>(lds, gh, H, EP, C.tid()); }
              { P1Order S; S.init(bx, 1); pg8::gemm_phase<EpiProj, P1Order, true, true>(lds, g, S, E, C.tid()); }
              { HalfUnit H{u0.pm, u0.pn, 1, part}; pg8::gemm_phase<EpiProj, HalfUnit, true, true>(lds, gh, H, E, C.tid()); }
          } else {
              P1Order S; S.init(bx, 0);
              pg8::gemm_phase<EpiProj, P1Order, true, true>(lds, g, S, E, C.tid());
              if ((bx >> 3) >= 16) late_weights(C, lds, ((bx >> 3) - 16) * 4 + ((bx & 7) >> 1), 64);
          }
      } else {
          pg8::StaticOrder S; S.init(NT, DINP, C.G, bx);
          pg8::gemm_phase<EpiProj, pg8::StaticOrder, true, true>(lds, g, S, E, C.tid());
          late_weights(C, lds, bx, C.G);
      }
    }
#endif
    GSYNC(); STAMP();
#if PHMASK & 4
    phase2(C, lds);
#endif
    LSYNC(); STAMP();
#if PHMASK & 8
    { int kc = 256; asm volatile("" : "+s"(kc)); pg8::Gemm g{C.PROJ() + PO_KV6, C.Wc1T(), 8192, 256, kc, DM, 1024}; CmpOrder S; S.init(C.G, (int)blockIdx.x);
      EpiCmpPart E{C.HIDP()};
      pg8::gemm_phase<EpiCmpPart, CmpOrder, true, true>(lds, g, S, E, C.tid()); }
#endif
#if PHMASK & 32
    for (int v = C.vcu; v < 256; v += C.G) mlstm_delta_unit(C, lds, v >> 4, v & 15);
#endif
    LSYNC(); STAMP();
#if PHMASK & 16
    phase3b(C, lds);
#endif
#if PHMASK & 32
    mlstm_scan(C);
#endif
    LSYNC(); STAMP();
    for (int v = C.vcu; v < 256; v += C.G) {
        const int bg = v >> 4, s = v & 15, b = bg >> 2, gh = bg & 3;
#if PROBE_SEL == 7
        unsigned long long tm0 = __builtin_amdgcn_s_memrealtime();
#endif
        for (int ph = 0; ph < 2; ++ph) {
            if ((ph == 0) != ((v & 1) != 0)) {
#if PHMASK & 32
                for (int k = 0; k < 2; ++k) mlstm_out_unit(C, lds, b, gh, 2 * s + k);
#endif
            } else {
#if PHMASK & 64
                { bf16x8 qpre[4];
#pragma unroll
                  for (int d0 = 0; d0 < 4; ++d0) qpre[d0] = __builtin_bit_cast(bf16x8, (v4u){0u, 0u, 0u, 0u});
                  const unsigned quad = __builtin_amdgcn_readfirstlane((s == 0 ? 0x0910243fu : (s == 1 ? 0x0c161d3eu : (s == 2 ? 0x000e3a3du : (s == 3 ? 0x040a373cu : (s == 4 ? 0x1215183bu : (s == 5 ? 0x11141c39u : (s == 6 ? 0x06172938u : (s == 7 ? 0x02232636u : (s == 8 ? 0x01193335u : (s == 9 ? 0x051e2734u : (s == 10 ? 0x03202a32u : (s == 11 ? 0x081b2831u : (s == 12 ? 0x0d132c30u : (s == 13 ? 0x0722252fu : (s == 14 ? 0x0f1f212eu : (s == 15 ? 0x0b1a2b2du : 0u)))))))))))))))));
                  for (int k = 0; k < 4; ++k) { const int qbk = (int)((quad >> (8 * k)) & 0xffu), nqb = k < 3 ? (int)((quad >> (8 * k + 8)) & 0xffu) : -1;
                      nsa_unit(C, lds, b, gh, qbk, nqb, qpre, k > 0); } }
#endif
            }
        }
#if PROBE_SEL == 7
        unsigned long long tm2 = __builtin_amdgcn_s_memrealtime();
        ts_[8] = 0; ts_[9] = tm2 - tm1; ts_[4] = 0; ts_[5] = tm1 - tm0;
#endif
    }
    GSYNC(); STAMP();
    for (int ph = 0; ph < 2; ++ph) {
        if ((ph == 0) != ((blockIdx.x & 1) != 0)) {
#if PHMASK & 128
            pg8::Gemm g{C.MIX(), C.WoutT(), NT, DM, DM, DM, DM}; P5Order S; S.init(NT, DM, C.G, (int)blockIdx.x);
            EpiX1 E{C.x, C.X1B()};
            pg8::gemm_phase<EpiX1, P5Order, true, true>(lds, g, S, E, C.tid());
#endif
        } else {
#if PHMASK & 256
            int kple = PLE; asm volatile("" : "+s"(kple)); pg8::Gemm g{C.PB(), C.WpleT(), NT, DM, kple, PLE, PLE}; P5Order S; S.init(NT, DM, C.G, (int)blockIdx.x);
            EpiPl E{C.PL(), C.plss()};
            pg8::gemm_phase<EpiPl, P5Order, true, true>(lds, g, S, E, C.tid());
#endif
        }
    }
    LSYNC(); STAMP();
#if PHMASK & 512
    for (int rnd = 1; rnd >= 0; --rnd) {
        pg8::Gemm g{C.X1B(), C.WgateT(), NT, DM, DM, DM, DM}; OneUnit S{32 * rnd + 4 * ((int)blockIdx.x & 7) + (((int)blockIdx.x >> 3) & 3), (int)blockIdx.x >> 5};
        EpiGateNorm E{C.out, C.X1B(), C.PL(), C.plss(), C.ple_g, C.final_g, (unsigned*)C.x2ss(), (unsigned*)(C.ws + 16384), lds};
        pg8::gemm_phase<EpiGateNorm, OneUnit, true, true>(lds, g, S, E, C.tid());
    }
#endif
    STAMP(); STAMP();
#if PROBE_SEL
    STAMP();
    __syncthreads();
#if PROBE_SEL == 6
    unsigned long long tq0 = __builtin_amdgcn_s_memrealtime();
    grid.sync(); grid.sync(); grid.sync(); grid.sync();
    unsigned long long tq1 = __builtin_amdgcn_s_memrealtime();
    ts_[8] = tq0; ts_[9] = tq1;
#endif
    if (blockIdx.x == 0) {
        float t1, t2; float sc1 = 0.01f, sc2 = 0.005f;
        if (PROBE_SEL == 1) { t1 = (float)(ts_[2] - ts_[1]); t2 = (float)(ts_[6] - ts_[5]); }
        else if (PROBE_SEL == 2) { t1 = (float)(ts_[7] - ts_[6]); t2 = (float)(ts_[8] - ts_[7]); }
        else if (PROBE_SEL == 3) { t1 = (float)(ts_[1] - ts_[0]); t2 = (float)(ts_[5] - ts_[2]); }
        else if (PROBE_SEL == 4) { t1 = (float)(ts_[3] - ts_[2]); t2 = (float)(ts_[4] - ts_[3]); sc1 = 0.1f; sc2 = 0.025f; }
        else if (PROBE_SEL == 8) { t1 = (float)(ts_[9] - ts_[0]); t2 = 0.f; sc1 = 0.001f; sc2 = 0.01f; }
        else if (PROBE_SEL == 7) { t1 = (float)(ts_[9] - ts_[8]); t2 = (float)(ts_[5] - ts_[4]); sc1 = 0.01f; sc2 = 0.005f; }
        else { t1 = (float)(ts_[9] - ts_[8]); t2 = (float)(ts_[5] - ts_[4]); sc1 = 0.1f; sc2 = 0.025f; }
        const float d1 = t1 * 0.01f * sc1;
        const float d2 = t2 * 0.01f * sc2;
        if (C.tid() == 0) C.out[0] += d1;
        for (int i = C.tid(); i < DM; i += NTHREADS) C.out[DM + i] += d2;
    }
#endif
}

extern "C" void kernel_launch(void* const* d_in, const int* in_sizes, int n_in, void* d_out, int out_size, void* d_ws, size_t ws_size, hipStream_t stream) {
    static int grid = 0;
    if (grid == 0) {
        if (n_in != 21 || in_sizes[0] != NT * DM || out_size != NT * DM || ws_size < WS_END) {
            fprintf(stderr, "kernel_launch: unexpected problem (n_in %d, in0 %d, out %d, ws %zu); nothing launched\n", n_in, n_in > 0 ? in_sizes[0] : -1, out_size, ws_size); grid = -1; return; }
        int dev = 0, cus = 0, per_cu = 0;
        if (hipGetDevice(&dev) != hipSuccess || hipDeviceGetAttribute(&cus, hipDeviceAttributeMultiprocessorCount, dev) != hipSuccess) { grid = -1; return; }
        if (hipFuncSetAttribute((const void*)mega_fwd, hipFuncAttributeMaxDynamicSharedMemorySize, LDS_BYTES) != hipSuccess) { fprintf(stderr, "kernel_launch: hipFuncSetAttribute failed\n"); grid = -1; return; }
        if (hipOccupancyMaxActiveBlocksPerMultiprocessor(&per_cu, (const void*)mega_fwd, NTHREADS, LDS_BYTES) != hipSuccess || per_cu < 1) {
            fprintf(stderr, "kernel_launch: occupancy query says %d blocks/CU; nothing launched\n", per_cu); grid = -1; return; }
        grid = cus * 1;
        if (grid != 256) { fprintf(stderr, "kernel_launch: built for 256 CUs (got %d); nothing launched\n", cus); grid = -1; return; }
    }
    if (grid < 0) return;
    if (hipMemsetAsync(d_ws, 0, 32768 + (size_t)NT * 4, stream) != hipSuccess) { fprintf(stderr, "kernel_launch: memset failed\n"); return; }
    Args a{};
    for (int i = 0; i < 21; ++i) a.in[i] = d_in[i];
    a.out = (float*)d_out; a.ws = (unsigned char*)d_ws;
    void* args[] = {&a};
    hipError_t e = hipLaunchCooperativeKernel((const void*)mega_fwd, dim3(grid), dim3(NTHREADS), args, LDS_BYTES, stream);
    if (e != hipSuccess) fprintf(stderr, "cooperative launch failed: %s (grid %d)\n", hipGetErrorString(e), grid);
}
```

```cpp
#include <hip/hip_runtime.h>
#include <hip/hip_cooperative_groups.h>
#include <cstdio>
#include <cstdint>
namespace cg = cooperative_groups;

namespace pg8 {
#define PG8_LAS __attribute__((address_space(3)))
typedef unsigned short bf16_t;
typedef short bf16x8 __attribute__((ext_vector_type(8)));
typedef float f32x4 __attribute__((ext_vector_type(4)));
typedef unsigned u32x4 __attribute__((ext_vector_type(4)));
constexpr int BM = 256, BK = 64, HALF = 128, HTB = HALF * BK * 2, STAGE_BYTES = 8 * HTB, NXCD = 8, WGM = 4;

__host__ __device__ __forceinline__ int lds_byte(int r, int c) { const int st = (r >> 4) * 2 + (c >> 5), rr = r & 15, cc = c & 31, ob = rr * 64 + cc * 2; return st * 1024 + (ob ^ (((ob >> 9) & 1) << 5)); }
__host__ __device__ __forceinline__ void stage_rc(int b, int& R, int& C) { const int st = b / 1024, sb = b % 1024, swz = sb ^ (((sb >> 9) & 1) << 5); R = (st >> 1) * 16 + swz / 64; C = (st & 1) * 32 + (swz % 64) / 2; }
__host__ __device__ __forceinline__ int perm32(int rho) { const int n = rho >> 4, i = rho & 15; return 8 * (i >> 2) + 4 * n + (i & 3); }

struct Unit { int pm, pn, ks; };
struct Gemm { const bf16_t* A; const bf16_t* Bt; int M, N, K, ld, lda; };

struct SplitKOrder {
    int nM, nwg, G, c;
    __host__ __device__ void init(int M, int nsplit, int G_, int c_) { nM = M / BM; nwg = nM * nsplit; G = G_; c = c_; }
    __host__ __device__ bool next(int i, Unit& u) const { const long L = (long)i * G + c; if (L >= nwg) return false; u.pm = (int)(L % nM); u.pn = 0; u.ks = (int)(L / nM); return true; }
    __device__ __forceinline__ size_t aoff(const Unit& u, const Gemm& g) const { return (size_t)u.pm * BM * (size_t)g.lda * 2 + (size_t)u.ks * g.K * 2; }
    __device__ __forceinline__ void a_ready(const Unit&) const {}
    __device__ __forceinline__ void done(const Unit&) const {}
    template <class A> __device__ __forceinline__ void preload(A&, int) const {}
};
struct StaticOrder {
    int nM, nN, nwg, G, c, wgm, i0;
    __host__ __device__ void init(int M, int N, int G_, int c_, int wgm_ = WGM, int i0_ = 0) { nM = M / BM; nN = N / BM; nwg = nM * nN; G = G_; c = c_; wgm = wgm_; i0 = i0_; }
    __host__ __device__ __forceinline__ bool next(int i, Unit& u) const {
        const long L = (long)(i + i0) * G + c; if (L >= nwg) return false;
        int wgid = (int)L; { const int q = nwg / NXCD, r = nwg % NXCD, xcd = wgid % NXCD, off = wgid / NXCD; wgid = (xcd < r ? xcd * (q + 1) : r * (q + 1) + (xcd - r) * q) + off; }
        const int nig = wgm * nN, gid = wgid / nig, fm = gid * wgm, gsz = (nM - fm) < wgm ? (nM - fm) : wgm;
        u.pm = fm + ((wgid % nig) % gsz); u.pn = (wgid % nig) / gsz; u.ks = 0; return true;
    }
    __device__ __forceinline__ size_t aoff(const Unit& u, const Gemm& g) const { return (size_t)u.pm * BM * (size_t)g.lda * 2; }
    __device__ __forceinline__ void a_ready(const Unit&) const {}
    __device__ __forceinline__ void done(const Unit&) const {}
    template <class A> __device__ __forceinline__ void preload(A&, int) const {}
};

template <class Epi, class Sched, bool ALIGN_EPI = false, bool SP2 = false>
__device__ __forceinline__ void gemm_phase(PG8_LAS unsigned char* lds, const Gemm g, const Sched& S, const Epi& E, int tid_in) {
    int tid = tid_in; asm volatile("" : "+v"(tid));
    const int wid = __builtin_amdgcn_readfirstlane(tid >> 6), lane = tid & 63, wr = wid >> 2, wc = wid & 3, fr = lane & 15, fq = lane >> 4;
    const int K = g.K, nt = K / BK, LD = g.ld;
    unsigned voffA[2], voffB[2];
#pragma unroll
    for (int i = 0; i < 2; ++i) { int R, C; stage_rc(tid * 16 + i * 8192, R, C); const int Rb = Epi::PERM ? ((R & ~31) + perm32(R & 31)) : R;
        voffA[i] = (unsigned)(R * g.lda + C) * 2u; voffB[i] = (unsigned)(Rb * LD + C) * 2u; }
    const size_t kstep = (size_t)(BK * 2);
    const size_t hstep = (size_t)HALF * LD * 2, hstepA = (size_t)HALF * g.lda * 2;
    const size_t tstep = 2 * hstep;
    const unsigned ldsw = (unsigned)wid * 1024u;
    const int aoff = lds_byte(wr * 64 + fr, fq * 8), boff = lds_byte(wc * 32 + fr, fq * 8);
#define PG8_SA(b, h) (((b) * 2 + (h)) * HTB)
#define PG8_SB(b, h) ((4 + (b) * 2 + (h)) * HTB)
#define PG8_STAGE(bufoff, gbase, voff) do { _Pragma("unroll") for (int _i = 0; _i < 2; ++_i) \
        __builtin_amdgcn_global_load_lds((const unsigned*)((const char*)(gbase) + (voff)[_i]), (PG8_LAS unsigned*)(lds + (bufoff) + ldsw + _i * 8192), 16, 0, 0); } while (0)
#define PG8_LDA(dst, b, h) do { _Pragma("unroll") for (int m = 0; m < 4; ++m) _Pragma("unroll") for (int k = 0; k < 2; ++k) dst[m][k] = *(const PG8_LAS bf16x8*)(lds + PG8_SA(b, h) + aoff + m * 2048 + k * 1024); } while (0)
#define PG8_LDB(dst, b, h) do { _Pragma("unroll") for (int n = 0; n < 2; ++n) _Pragma("unroll") for (int k = 0; k < 2; ++k) dst[n][k] = *(const PG8_LAS bf16x8*)(lds + PG8_SB(b, h) + boff + n * 2048 + k * 1024); } while (0)
#define PG8_MMA(ai, bj, At, Bt) do { __builtin_amdgcn_s_setprio(1); _Pragma("unroll") for (int m = 0; m < 4; ++m) _Pragma("unroll") for (int n = 0; n < 2; ++n) _Pragma("unroll") for (int k = 0; k < 2; ++k) \
        acc[ai][bj][m][n] = __builtin_amdgcn_mfma_f32_16x16x32_bf16(Bt[n][k], At[m][k], acc[ai][bj][m][n], 0, 0, 0); __builtin_amdgcn_s_setprio(0); } while (0)
#define PG8_WAIT_V(n) asm volatile("s_waitcnt vmcnt(" #n ")" ::: "memory")
#define PG8_WAIT_L(n) asm volatile("s_waitcnt lgkmcnt(" #n ")" ::: "memory")
#define PG8_BAR __builtin_amdgcn_s_barrier()
#define PG8_SCHED __builtin_amdgcn_sched_barrier(0)
    Unit cur, nxt; int ui = 0;
    if (!S.next(0, cur)) return;
    f32x4 acc[2][2][4][2];
#pragma unroll
    for (int a = 0; a < 2; ++a)
#pragma unroll
        for (int b = 0; b < 2; ++b)
#pragma unroll
            for (int m = 0; m < 4; ++m)
#pragma unroll
                for (int n = 0; n < 2; ++n) acc[a][b][m][n] = (f32x4){0.f, 0.f, 0.f, 0.f};
    S.preload(acc, tid);
    bf16x8 At[4][2], B0[2][2], B1[2][2];
    const char* cA = (const char*)g.A + S.aoff(cur, g); const char* cB = (const char*)g.Bt + (size_t)cur.pn * tstep + (size_t)cur.ks * K * 2;
    S.a_ready(cur);
    if constexpr (SP2) {
        PG8_STAGE(PG8_SB(0, 0), cB, voffB); PG8_STAGE(PG8_SB(0, 1), cB + hstep, voffB); PG8_STAGE(PG8_SA(0, 0), cA, voffA); PG8_STAGE(PG8_SA(0, 1), cA + hstepA, voffA);
        if (wr == 1) PG8_BAR;
        PG8_WAIT_V(2); PG8_BAR;
        PG8_STAGE(PG8_SB(1, 0), cB + kstep, voffB); PG8_STAGE(PG8_SA(1, 0), cA + kstep, voffA); PG8_STAGE(PG8_SB(1, 1), cB + hstep + kstep, voffB);
        PG8_WAIT_V(6); PG8_BAR;
    } else {
        PG8_STAGE(PG8_SB(0, 0), cB, voffB); PG8_STAGE(PG8_SA(0, 0), cA, voffA); PG8_STAGE(PG8_SB(0, 1), cB + hstep, voffB); PG8_STAGE(PG8_SA(0, 1), cA + hstepA, voffA);
        if (wr == 1) PG8_BAR;
        PG8_WAIT_V(4); PG8_BAR;
        PG8_STAGE(PG8_SB(1, 0), cB + kstep, voffB); PG8_STAGE(PG8_SA(1, 0), cA + kstep, voffA); PG8_STAGE(PG8_SB(1, 1), cB + hstep + kstep, voffB);
        PG8_WAIT_V(6); PG8_BAR;
    }
    for (;;) {
        const bool has_next = S.next(ui + 1, nxt);
        const char* nA = has_next ? (const char*)g.A + S.aoff(nxt, g) : cA; const char* nB = has_next ? (const char*)g.Bt + (size_t)nxt.pn * tstep + (size_t)nxt.ks * K * 2 : cB;
        for (int t = 0; t < nt; t += 2) {
            const bool last = (t == nt - 2);
            const char* a1 = cA + (size_t)(t + 1) * kstep;
            const char* a2 = last ? nA : cA + (size_t)(t + 2) * kstep; const char* b2 = last ? nB : cB + (size_t)(t + 2) * kstep;
            const char* a3 = a2 + kstep; const char* b3 = b2 + kstep;
            if (last && has_next) S.a_ready(nxt);
            if constexpr (SP2) {
            PG8_LDB(B0, 0, 0); PG8_LDB(B1, 0, 1); PG8_SCHED; PG8_LDA(At, 0, 0); PG8_STAGE(PG8_SA(1, 1), a1 + hstepA, voffA);
            PG8_WAIT_V(8); PG8_WAIT_L(0); PG8_BAR; PG8_MMA(0, 0, At, B0); PG8_MMA(0, 1, At, B1); PG8_BAR; PG8_SCHED;
            PG8_LDA(At, 0, 1); PG8_STAGE(PG8_SB(0, 0), b2, voffB); PG8_STAGE(PG8_SB(0, 1), b2 + hstep, voffB); PG8_STAGE(PG8_SA(0, 0), a2, voffA);
            PG8_WAIT_V(8); PG8_WAIT_L(0); PG8_BAR; PG8_MMA(1, 0, At, B0); PG8_MMA(1, 1, At, B1); PG8_BAR; PG8_SCHED;
            PG8_LDB(B0, 1, 0); PG8_LDB(B1, 1, 1); PG8_SCHED; PG8_LDA(At, 1, 0); PG8_STAGE(PG8_SA(0, 1), a2 + hstepA, voffA);
            PG8_WAIT_V(8); PG8_WAIT_L(0); PG8_BAR; PG8_MMA(0, 0, At, B0); PG8_MMA(0, 1, At, B1); PG8_BAR; PG8_SCHED;
            PG8_LDA(At, 1, 1); PG8_STAGE(PG8_SB(1, 0), b3, voffB); PG8_STAGE(PG8_SB(1, 1), b3 + hstep, voffB); PG8_STAGE(PG8_SA(1, 0), a3, voffA);
            PG8_WAIT_V(8); PG8_WAIT_L(0); PG8_BAR; PG8_MMA(1, 0, At, B0); PG8_MMA(1, 1, At, B1); PG8_BAR; PG8_SCHED;
            } else {
            PG8_LDB(B0, 0, 0); PG8_SCHED; PG8_LDA(At, 0, 0); PG8_STAGE(PG8_SA(1, 1), a1 + hstepA, voffA);
            PG8_WAIT_L(8); PG8_BAR; PG8_WAIT_L(0); PG8_MMA(0, 0, At, B0); PG8_BAR; PG8_SCHED;
            PG8_LDB(B1, 0, 1); PG8_STAGE(PG8_SB(0, 0), b2, voffB);
            PG8_BAR; PG8_WAIT_L(0); PG8_MMA(0, 1, At, B1); PG8_BAR;
            PG8_LDA(At, 0, 1); PG8_STAGE(PG8_SA(0, 0), a2, voffA);
            PG8_BAR; PG8_WAIT_L(0); PG8_MMA(1, 0, At, B0); PG8_BAR; PG8_SCHED;
            PG8_STAGE(PG8_SB(0, 1), b2 + hstep, voffB);
            PG8_WAIT_V(6); PG8_BAR; PG8_MMA(1, 1, At, B1); PG8_BAR;
            PG8_LDB(B0, 1, 0); PG8_SCHED; PG8_LDA(At, 1, 0); PG8_STAGE(PG8_SA(0, 1), a2 + hstepA, voffA);
            PG8_WAIT_L(8); PG8_BAR; PG8_WAIT_L(0); PG8_MMA(0, 0, At, B0); PG8_BAR; PG8_SCHED;
            PG8_LDB(B1, 1, 1); PG8_STAGE(PG8_SB(1, 0), b3, voffB);
            PG8_BAR; PG8_WAIT_L(0); PG8_MMA(0, 1, At, B1); PG8_BAR;
            PG8_LDA(At, 1, 1); PG8_STAGE(PG8_SA(1, 0), a3, voffA);
            PG8_BAR; PG8_WAIT_L(0); PG8_MMA(1, 0, At, B0); PG8_BAR; PG8_SCHED;
            PG8_STAGE(PG8_SB(1, 1), b3 + hstep, voffB);
            PG8_WAIT_V(6); PG8_BAR; PG8_MMA(1, 1, At, B1); PG8_BAR;
            }
        }
        if constexpr (ALIGN_EPI) { if (wr == 0) PG8_BAR; }
        E(acc, cur, wr, wc, fr, fq);
        if (!has_next) break;
#pragma unroll
        for (int a = 0; a < 2; ++a)
#pragma unroll
            for (int b = 0; b < 2; ++b)
#pragma unroll
                for (int m = 0; m < 4; ++m)
#pragma unroll
                    for (int n = 0; n < 2; ++n) acc[a][b][m][n] = (f32x4){0.f, 0.f, 0.f, 0.f};
        cur = nxt; cA = nA; cB = nB; ++ui;
        if constexpr (ALIGN_EPI) { if (wr == 1) PG8_BAR; }
    }
    PG8_WAIT_V(0);
    if constexpr (!ALIGN_EPI) { if (wr == 0) PG8_BAR; }
    PG8_BAR;
#undef PG8_SA
#undef PG8_SB
#undef PG8_STAGE
#undef PG8_LDA
#undef PG8_LDB
#undef PG8_MMA
#undef PG8_WAIT_V
#undef PG8_WAIT_L
#undef PG8_BAR
#undef PG8_SCHED
}
}

constexpr int NB = 4, SEQ = 4096, DM = 2048, NT = NB * SEQ, PLE = 256;
constexpr int MH = 4, MDH = 256;
constexpr int NHD = 64, NH = 16, NKV = 4;
constexpr int DIN = 8760, DINP = 8960;
constexpr int C_MQ = 0, C_MK = 1024, C_MV = 2048, C_MO = 3072, C_MZ = 4096, C_NQ = 5120, C_KC = 6144, C_VC = 6400, C_KS = 6656, C_VS = 6912,
              C_KW = 7168, C_VW = 7424, C_NZ = 7680, C_NG = 8704, C_GATE = 8752;
constexpr size_t PE = 524288;
constexpr size_t PO_MQK = 0, PO_MV = 64 * PE, PO_MG = 96 * PE, PO_NQ = 160 * PE, PO_KV6 = 192 * PE, PO_NZ = 240 * PE, PO_NG = 272 * PE;
constexpr size_t KVSZ = (size_t)4 * 4 * 4096 * 64;
constexpr float EPSV = 1e-6f, NEGV = -1e30f, LOG2E = 1.4426950408889634f;
constexpr int NWAVES = 8, NTHREADS = 512;
constexpr int LDS_BYTES = 147456;
constexpr int LDS_MISC = 135168;
constexpr int STG_PITCH = 260;

constexpr size_t MiB = 1u << 20;
constexpr size_t WS_GATES = 1 * MiB;
constexpr size_t WS_ROPE  = 2 * MiB;
constexpr size_t WS_U2    = 3 * MiB;
constexpr size_t WS_MX2   = 3 * MiB + 512 * 1024;
constexpr size_t WS_PLSS  = 32768;
constexpr size_t WS_X2SS  = 6 * MiB;
constexpr size_t WS_WOUT  = 8 * MiB;
constexpr size_t WS_WGATE = 16 * MiB;
constexpr size_t WS_WPLE  = 24 * MiB;
constexpr size_t WS_WC1   = 25 * MiB;
constexpr size_t WS_HID   = 26 * MiB;
constexpr size_t WS_KVC   = 30 * MiB;
constexpr size_t WS_PB    = 32 * MiB;
constexpr size_t WS_WIN   = 40 * MiB;
constexpr size_t WS_XN    = 76 * MiB;
constexpr size_t WS_PROJ  = 140 * MiB;
constexpr size_t WS_MIX   = 420 * MiB;
constexpr size_t WS_DN    = 484 * MiB;
constexpr size_t WS_NS    = 484 * MiB + 256 * 1024;
constexpr size_t WS_END   = 485 * MiB;

#define LAS __attribute__((address_space(3)))
#define DI __device__ __forceinline__
typedef unsigned short bf16;
typedef unsigned v4u __attribute__((ext_vector_type(4)));
typedef unsigned v2u __attribute__((ext_vector_type(2)));
typedef float f32x4 __attribute__((ext_vector_type(4)));
typedef float f32x16 __attribute__((ext_vector_type(16)));
typedef short bf16x8 __attribute__((ext_vector_type(8)));
typedef short s16x4 __attribute__((ext_vector_type(4)));
typedef float f32x2_t __attribute__((ext_vector_type(2)));
typedef __bf16 bf16x2_t __attribute__((ext_vector_type(2)));

DI unsigned pk2(float lo, float hi) { f32x2_t v = {lo, hi}; bf16x2_t b = __builtin_convertvector(v, bf16x2_t); return __builtin_bit_cast(unsigned, b); }
DI float bflo(unsigned w) { return __uint_as_float(w << 16); }
DI float bfhi(unsigned w) { return __uint_as_float(w & 0xffff0000u); }
DI float bf2f(bf16 h) { return __uint_as_float((unsigned)h << 16); }
DI float ex2(float x) { return __builtin_amdgcn_exp2f(x); }
DI float fsigmoid(float x) { return __builtin_amdgcn_rcpf(1.f + ex2(-LOG2E * x)); }
DI float fsilu(float x) { return x * fsigmoid(x); }
DI float fgelu_tanh(float x) { const float z = 0.7978845608028654f * (x + 0.044715f * x * x * x); return x * fsigmoid(2.f * z); }
DI float swap32_max(float m) { const auto rr = __builtin_amdgcn_permlane32_swap(__float_as_uint(m), __float_as_uint(m), false, false); return fmaxf(__uint_as_float(rr[0]), __uint_as_float(rr[1])); }
DI int crow(int r, int h) { return (r & 3) + 8 * (r >> 2) + 4 * h; }
DI void unpack8(v4u w, float (&f)[8]) { f[0] = bflo(w.x); f[1] = bfhi(w.x); f[2] = bflo(w.y); f[3] = bfhi(w.y); f[4] = bflo(w.z); f[5] = bfhi(w.z); f[6] = bflo(w.w); f[7] = bfhi(w.w); }
DI v4u pack8(const float (&f)[8]) { v4u w; w.x = pk2(f[0], f[1]); w.y = pk2(f[2], f[3]); w.z = pk2(f[4], f[5]); w.w = pk2(f[6], f[7]); return w; }
DI float wave_sum(float v) {
#pragma unroll
    for (int o = 1; o < 64; o <<= 1) v += __shfl_xor(v, o);
    return v;
}
DI void glds16(const void* gsrc, LAS unsigned char* dst_wave_uniform) {
    __builtin_amdgcn_global_load_lds((const unsigned*)gsrc, (LAS unsigned*)dst_wave_uniform, 16, 0, 0);
}
DI void glds16a(const void* gsrc, unsigned lds_dst) { unsigned keep;
    asm volatile("s_mov_b32 %0, m0\n\ts_mov_b32 m0, %2\n\ts_nop 0\n\tglobal_load_lds_dwordx4 %1, off\n\ts_mov_b32 m0, %0" : "=&s"(keep) : "v"(gsrc), "s"(lds_dst) : "memory"); }
template <int IMM> DI void glds16s(const void* sbase, unsigned voff, unsigned lds_dst) { unsigned keep;
    asm volatile("s_mov_b32 %0, m0\n\ts_mov_b32 m0, %3\n\ts_nop 0\n\tglobal_load_lds_dwordx4 %1, %2 offset:%c4\n\ts_mov_b32 m0, %0" : "=&s"(keep) : "v"(voff), "s"(sbase), "s"(lds_dst), "i"(IMM) : "memory"); }
DI unsigned lds_u32(const LAS void* p) { return (unsigned)(size_t)p; }
#define WAITBAR(N) asm volatile("s_waitcnt vmcnt(" #N ") lgkmcnt(0)\n\ts_barrier" ::: "memory")
#define LBAR() asm volatile("s_waitcnt lgkmcnt(0)\n\ts_barrier" ::: "memory")
#define VM_WAIT() asm volatile("s_waitcnt vmcnt(0)" ::: "memory")
#define MFMA32(a, b, c) __builtin_amdgcn_mfma_f32_32x32x16_bf16((a), (b), (c), 0, 0, 0)


#define XB_TMO      128
#define XB_XCNT(j)  (256  + 64 * (j))
#define XB_XSUB(j)  (1280 + 64 * (j))
#define XB_XGEN(j)  (2304 + 64 * (j))
#define XB_TOP      3328
#define XB_TOPGEN   3392
#define XCD_BAR_WORDS 3456
#define XB_SPIN_CAP (1u << 20)
DI unsigned xb_ld(unsigned* p)              { return __hip_atomic_load(p, __ATOMIC_RELAXED, __HIP_MEMORY_SCOPE_AGENT); }
DI unsigned xb_add(unsigned* p, unsigned v) { return __hip_atomic_fetch_add(p, v, __ATOMIC_RELAXED, __HIP_MEMORY_SCOPE_AGENT); }
DI unsigned xb_xcc_id() { return (unsigned)__builtin_amdgcn_s_getreg((3 << 11) | 20) & 0xFu; }
#define XB_SPIN(cond, bar) do { unsigned _sp = 0; while (cond) { \
    if ((++_sp & 255u) == 0u) { if (xb_ld(&(bar)[XB_TMO])) break; if (_sp > XB_SPIN_CAP) { atomicAdd(&(bar)[XB_TMO], 1u); break; } } } } while (0)
struct XcdBarrier { unsigned* bar; unsigned x; volatile LAS unsigned* st; };
DI XcdBarrier xcd_barrier_post(unsigned* bar, volatile LAS unsigned* st, bool leader) {
    XcdBarrier b; b.bar = bar; b.x = xb_xcc_id(); b.st = st;
    if (leader) (void)xb_add(&bar[XB_XCNT(b.x)], 1u);
    return b;
}
DI void xcd_barrier_complete(unsigned* bar, unsigned x, unsigned& nloc, unsigned& nx) {
    const unsigned G = gridDim.x * gridDim.y * gridDim.z;
    unsigned sum, cnt, mine, sp = 0u;
    for (;;) {
        sum = 0u; cnt = 0u; mine = 0u;
#pragma unroll
        for (unsigned j = 0; j < 16; ++j) { const unsigned c = xb_ld(&bar[XB_XCNT(j)]); sum += c; cnt += (c > 0u) ? 1u : 0u; mine = (j == x) ? c : mine; }
        if (sum == G) break;
        __builtin_amdgcn_s_sleep(1);
        if ((++sp & 255u) == 0u) { if (xb_ld(&bar[XB_TMO])) break; if (sp > XB_SPIN_CAP) { atomicAdd(&bar[XB_TMO], 1u); break; } }
    }
    nloc = mine > 0u ? mine : 1u; nx = cnt > 0u ? cnt : 1u;
}
DI void xcd_barrier_local(const XcdBarrier& b, bool leader) {
    asm volatile("s_waitcnt vmcnt(0)" ::: "memory");
    __syncthreads();
    if (leader) {
        unsigned* bar = b.bar;
        __builtin_amdgcn_s_waitcnt(0);
        unsigned nloc = b.st[0], nx = b.st[1];
        if (nloc == 0u) { xcd_barrier_complete(bar, b.x, nloc, nx); b.st[0] = nloc; b.st[1] = nx; }
        const unsigned old = xb_add(&bar[XB_XSUB(b.x)], 1u);
        const unsigned gen = old / nloc;
        if (old + 1u == (gen + 1u) * nloc) {
            __builtin_amdgcn_fence(__ATOMIC_RELEASE, "agent");
            asm volatile("s_waitcnt vmcnt(0)" ::: "memory");
            __builtin_amdgcn_fence(__ATOMIC_ACQUIRE, "agent");
            xb_add(&bar[XB_XGEN(b.x)], 1u);
            asm volatile("s_waitcnt vmcnt(0)" ::: "memory");
        } else {
            XB_SPIN(xb_ld(&bar[XB_XGEN(b.x)]) == gen, bar);
            __builtin_amdgcn_fence(__ATOMIC_ACQUIRE, "agent");
            asm volatile("s_waitcnt vmcnt(0)" ::: "memory");
        }
    }
    __syncthreads();
}
DI void xcd_barrier(const XcdBarrier& b, bool leader) {
    asm volatile("s_waitcnt vmcnt(0)" ::: "memory");
    __syncthreads();
    if (leader) {
        unsigned* bar = b.bar;
        __builtin_amdgcn_s_waitcnt(0);
        unsigned nloc = b.st[0], nx = b.st[1];
        if (nloc == 0u) { xcd_barrier_complete(bar, b.x, nloc, nx); b.st[0] = nloc; b.st[1] = nx; }
        const unsigned old = xb_add(&bar[XB_XSUB(b.x)], 1u);
        const unsigned gen = old / nloc;
        if (old + 1u == (gen + 1u) * nloc) {
            __builtin_amdgcn_fence(__ATOMIC_RELEASE, "agent");
            asm volatile("s_waitcnt vmcnt(0)" ::: "memory");
            const unsigned og = xb_add(&bar[XB_TOP], 1u);
            const unsigned tg = og / nx;
            if (og + 1u == (tg + 1u) * nx) xb_add(&bar[XB_TOPGEN], 1u);
            else XB_SPIN(xb_ld(&bar[XB_TOPGEN]) == tg, bar);
            __builtin_amdgcn_fence(__ATOMIC_ACQUIRE, "agent");
            xb_add(&bar[XB_XGEN(b.x)], 1u);
            asm volatile("s_waitcnt vmcnt(0)" ::: "memory");
        } else {
            XB_SPIN(xb_ld(&bar[XB_XGEN(b.x)]) == gen, bar);
            __builtin_amdgcn_fence(__ATOMIC_ACQUIRE, "agent");
            asm volatile("s_waitcnt vmcnt(0)" ::: "memory");
        }
    }
    __syncthreads();
}

struct Ctx {
    const float *x, *p; const int* positions; const float *norm_g, *w_in, *conv_w, *conv_b, *b_ig, *b_fg, *m_norm_g, *pos_k, *pos_v, *ck_w1, *ck_w2, *cv_w1, *cv_w2,
                *w_out, *gate_w, *ple_w, *ple_g, *final_g;
    float* out; unsigned char* ws;
    int vcu, G, wbase;
    DI int tid() const { return wbase + (int)__builtin_amdgcn_mbcnt_hi(~0u, __builtin_amdgcn_mbcnt_lo(~0u, 0u)); }
    DI float* gates() const { return (float*)(ws + WS_GATES); }
    DI float* rope() const { return (float*)(ws + WS_ROPE); }
    DI float* u2() const { return (float*)(ws + WS_U2); }
    DI float* mx2() const { return (float*)(ws + WS_MX2); }
    DI float* plss() const { return (float*)(ws + WS_PLSS); }
    DI float* x2ss() const { return (float*)(ws + WS_X2SS); }
    DI float* DN() const { return (float*)(ws + WS_DN); }
    DI float* NS() const { return (float*)(ws + WS_NS); }
    DI bf16* SB() const { return (bf16*)(ws + WS_WIN); }
    DI bf16* WoutT() const { return (bf16*)(ws + WS_WOUT); }
    DI bf16* WgateT() const { return (bf16*)(ws + WS_WGATE); }
    DI bf16* WpleT() const { return (bf16*)(ws + WS_WPLE); }
    DI bf16* Wc1T() const { return (bf16*)(ws + WS_WC1); }
    DI bf16* HID() const { return (bf16*)(ws + WS_HID); }
    DI bf16* KVC() const { return (bf16*)(ws + WS_KVC); }
    DI bf16* PB() const { return (bf16*)(ws + WS_PB); }
    DI bf16* WinT() const { return (bf16*)(ws + WS_WIN); }
    DI bf16* CA() const { return (bf16*)(ws + WS_WIN); }
    DI bf16* XN() const { return (bf16*)(ws + WS_XN); }
    DI bf16* QC() const { return (bf16*)(ws + WS_XN); }
    DI bf16* KC() const { return (bf16*)(ws + WS_XN + 32 * MiB); }
    DI bf16* PROJ() const { return (bf16*)(ws + WS_PROJ); }
    DI bf16* PL() const { return (bf16*)(ws + WS_PROJ); }
    DI bf16* X1B() const { return (bf16*)(ws + WS_PROJ + 64 * MiB); }
    DI bf16* MIX() const { return (bf16*)(ws + WS_MIX); }
    DI bf16* X2B() const { return (bf16*)(ws + WS_XN); }
    DI float* HIDP() const { return (float*)((unsigned char*)out + 32 * MiB); }
    DI float* posb() const { return (float*)(ws + WS_KVC + 1024 * 1024); }
};

DI int map_in(int np) { if (np >= 3072 && np < 5120) { const int k = (np - 3072) >> 8, ct = np & 255; return ct < 128 ? 3072 + 128 * k + ct : 4096 + 128 * k + (ct - 128); }
    return np < 5120 ? np : (np < 7680 ? np + 8 : (np < 8704 ? np + 56 : (np < 8752 ? np - 1016 : (np < 8760 ? np - 3632 : -1)))); }
DI void transpose_item(const float* W, int K, int N, int mode, bf16* WT, int row_off, LAS float* scr, int item, int nblk, int lane) {
    const int kb = item / nblk, nb = item % nblk, k0 = 64 * kb, n0 = 32 * nb;
    const int np = n0 + 4 * (lane & 7);
    const int src = mode ? map_in(np) : np;
    f32x4 v[8];
#pragma unroll
    for (int i = 0; i < 8; ++i) { const int kk = (lane >> 3) + 8 * i; v[i] = (src >= 0) ? __builtin_nontemporal_load((const f32x4*)(W + (size_t)(k0 + kk) * N + src)) : (f32x4){0.f, 0.f, 0.f, 0.f}; }
#pragma unroll
    for (int i = 0; i < 8; ++i) { const int kk = (lane >> 3) + 8 * i; LAS float* d = scr + kk * 33 + 4 * (lane & 7); d[0] = v[i].x; d[1] = v[i].y; d[2] = v[i].z; d[3] = v[i].w; }
    __builtin_amdgcn_fence(__ATOMIC_RELEASE, "wavefront"); __builtin_amdgcn_wave_barrier(); __builtin_amdgcn_fence(__ATOMIC_ACQUIRE, "wavefront");
    const int c = lane & 7;
#pragma unroll
    for (int j = 0; j < 4; ++j) { const int n = (lane >> 3) + 8 * j; const LAS float* s = scr + (8 * c) * 33 + n;
        v4u o; o.x = pk2(s[0 * 33], s[1 * 33]); o.y = pk2(s[2 * 33], s[3 * 33]); o.z = pk2(s[4 * 33], s[5 * 33]); o.w = pk2(s[6 * 33], s[7 * 33]);
        *(v4u*)(WT + (size_t)(row_off + n0 + n) * K + k0 + 8 * c) = o; }
    __builtin_amdgcn_fence(__ATOMIC_RELEASE, "wavefront"); __builtin_amdgcn_wave_barrier(); __builtin_amdgcn_fence(__ATOMIC_ACQUIRE, "wavefront");
}
DI void phase0(const Ctx& C, LAS unsigned char* lds) {
    int tid = C.tid(); asm volatile("" : "+v"(tid));
    const int lane = tid & 63, wave = __builtin_amdgcn_readfirstlane(tid >> 6);
    LAS float* scr = (LAS float*)(lds + wave * 16384);
    const int gw = C.vcu * NWAVES + wave, NGW = C.G * NWAVES;
    constexpr int I_IN = 32 * 280;
    for (int it = gw; it < I_IN; it += NGW) transpose_item(C.w_in, DM, DIN, 1, C.WinT(), 0, scr, it, 280, lane);
    for (int m = gw; m < NT; m += NGW) {
        const f32x4* xr = (const f32x4*)(C.x + (size_t)m * DM);
        f32x4 v[8]; float s = 0.f;
#pragma unroll
        for (int j = 0; j < 4; ++j) { v[2 * j] = __builtin_nontemporal_load(xr + 2 * (lane + 64 * j)); v[2 * j + 1] = __builtin_nontemporal_load(xr + 2 * (lane + 64 * j) + 1); }
#pragma unroll
        for (int j = 0; j < 8; ++j) s += (v[j].x * v[j].x + v[j].y * v[j].y) + (v[j].z * v[j].z + v[j].w * v[j].w);
        const float rstd = 1.f / sqrtf(wave_sum(s) * (1.f / DM) + EPSV);
        v4u* o16 = (v4u*)(C.XN() + (size_t)m * DM);
#pragma unroll
        for (int j = 0; j < 4; ++j) { const f32x4 g0 = *((const f32x4*)C.norm_g + 2 * (lane + 64 * j)), g1 = *((const f32x4*)C.norm_g + 2 * (lane + 64 * j) + 1);
            const f32x4 a = v[2 * j], b2 = v[2 * j + 1];
            v4u w; w.x = pk2(a.x * rstd * g0.x, a.y * rstd * g0.y); w.y = pk2(a.z * rstd * g0.z, a.w * rstd * g0.w); w.z = pk2(b2.x * rstd * g1.x, b2.y * rstd * g1.y); w.w = pk2(b2.z * rstd * g1.z, b2.w * rstd * g1.w);
            o16[lane + 64 * j] = w; }
    }
    const int gt = C.vcu * NTHREADS + tid, NGT = C.G * NTHREADS;
    for (int i = gt; i < NT * 8; i += NGT) {
        const int t = i >> 3, k = i & 7;
        const float invf[8] = {1.0f, 0.1939227432012558f, 0.03760603070259094f, 0.007292664609849453f, 0.0014142135623842478f, 0.00027424818836152554f, 5.3182957344688475e-05f, 1.0313385246263351e-05f};
        float inv = invf[0];
#pragma unroll
        for (int q = 1; q < 8; ++q) inv = (k == q) ? invf[q] : inv;
        const float ang = (float)C.positions[t] * inv;
        float sn, cs; sincosf(ang, &sn, &cs);
        C.rope()[t * 16 + k] = cs; C.rope()[t * 16 + 8 + k] = sn;
    }
}

DI void late_weights(const Ctx& C, LAS unsigned char* lds, int wg, int nwg, int part = 0) {
    int tid = C.tid(); asm volatile("" : "+v"(tid));
    const int lane = tid & 63, wave = __builtin_amdgcn_readfirstlane(tid >> 6);
    LAS float* scr = (LAS float*)(lds + wave * 16384);
    const int gw = wg * NWAVES + wave, NGW = nwg * NWAVES;
    constexpr int I_OUT = 32 * 64, I_GATE = 32 * 64, I_PLE = 4 * 64, I_C1 = 32 * 4;
    constexpr int NITEMS = I_OUT + I_GATE + I_PLE + 2 * I_C1;
    __syncthreads();
    if (part != 2)
    for (int it = gw; it < NITEMS; it += NGW) {
        int r = it;
        if (r < I_OUT) { transpose_item(C.w_out, DM, DM, 0, C.WoutT(), 0, scr, r, 64, lane); continue; } r -= I_OUT;
        if (r < I_GATE) { transpose_item(C.gate_w, DM, DM, 0, C.WgateT(), 0, scr, r, 64, lane); continue; } r -= I_GATE;
        if (r < I_PLE) { transpose_item(C.ple_w, PLE, DM, 0, C.WpleT(), 0, scr, r, 64, lane); continue; } r -= I_PLE;
        if (r < I_C1) { transpose_item(C.ck_w1, DM, 128, 0, C.Wc1T(), 0, scr, r, 4, lane); continue; } r -= I_C1;
        transpose_item(C.cv_w1, DM, 128, 0, C.Wc1T(), 128, scr, r, 4, lane);
    }
    if (part != 1)
    for (int i = wg * NTHREADS + tid; i < NT * PLE / 8; i += nwg * NTHREADS) {
        const f32x4 a = *((const f32x4*)C.p + 2 * i), b = *((const f32x4*)C.p + 2 * i + 1);
        v4u w; w.x = pk2(a.x, a.y); w.y = pk2(a.z, a.w); w.z = pk2(b.x, b.y); w.w = pk2(b.z, b.w);
        *((v4u*)C.PB() + i) = w;
    }
    __syncthreads();
}

typedef pg8::f32x4 gf4;
struct CmpOrder {
    int G, c;
    DI void init(int G_, int c_) { G = G_; c = c_; }
    DI bool next(int i, pg8::Unit& u) const {
        if (G == 256) { if (i) return false; const int g8 = c & 7, li = c >> 3; u.pm = ((li >> 1) & 1) * 16 + 2 * g8 + (li & 1); u.pn = 0; u.ks = li >> 2; return true; }
        const int L = i * G + c; if (L >= 256) return false; u.pm = L & 31; u.pn = 0; u.ks = L >> 5; return true; }
    DI void a_ready(const pg8::Unit&) const {}
    DI void done(const pg8::Unit&) const {}
    template <class A> DI void preload(A&, int) const {}
    DI size_t aoff(const pg8::Unit& u, const pg8::Gemm& g) const { return ((size_t)(u.pm >> 4) * KVSZ + (size_t)(u.pm & 15) * SEQ * 64) * 2 + (size_t)u.ks * g.K * 2; }
};
DI bf16* proj_dst(bf16* P, int pn, int r, int ct) {
    const int b = r >> 12, s = r & (SEQ - 1);
    if (pn < 8) return P + PO_MQK + (size_t)r * 2048 + pn * 256 + ct;
    if (pn < 12) return P + PO_MV + ((size_t)(b * 4 + (pn - 8)) * SEQ + s) * 256 + ct;
    if (pn < 20) return nullptr;
    if (pn < 24) return P + PO_NQ + ((size_t)(b * 16 + (pn - 20) * 4 + (ct >> 6)) * SEQ + s) * 64 + (ct & 63);
    if (pn < 30) return P + PO_KV6 + (size_t)(pn - 24) * KVSZ + ((size_t)(b * 4 + (ct >> 6)) * SEQ + s) * 64 + (ct & 63);
    if (pn < 34) return P + PO_NZ + ((size_t)(b * 16 + (pn - 30) * 4 + (ct >> 6)) * SEQ + s) * 64 + (ct & 63);
    return ct < 64 ? P + PO_NG + (size_t)r * 64 + ct : nullptr;
}
struct EpiProj {
    static constexpr bool PERM = true;
    bf16* O; float* gates; const float* rope;
    DI void operator()(const gf4 (&acc)[2][2][4][2], const pg8::Unit& u, int wr, int wc, int fr, int fq) const {
        const int row0 = u.pm * 256 + wr * 64 + fr, ct0 = wc * 32 + 8 * fq;
        const bool gl = (u.pn == 34) && (wc == 1) && (fq == 2);
        const bool ropew = ((u.pn >= 20 && u.pn <= 24) || u.pn == 26 || u.pn == 28) && ((wc & 1) == 0);
        const float sgn = (fq == 0) ? -1.f : 1.f;
#pragma unroll
        for (int ai = 0; ai < 2; ++ai)
#pragma unroll
            for (int m = 0; m < 4; ++m) { const int row = row0 + ai * 128 + m * 16;
                gf4 c0, c1, s0, s1;
                if (ropew) { c0 = *(const gf4*)(rope + (size_t)row * 16); c1 = *(const gf4*)(rope + (size_t)row * 16 + 4); s0 = *(const gf4*)(rope + (size_t)row * 16 + 8); s1 = *(const gf4*)(rope + (size_t)row * 16 + 12); }
#pragma unroll
                for (int bj = 0; bj < 2; ++bj) { gf4 v0 = acc[ai][bj][m][0], v1 = acc[ai][bj][m][1];
                    if (ropew) {
                        gf4 p0, p1;
#pragma unroll
                        for (int e = 0; e < 4; ++e) { p0[e] = __shfl_xor(v0[e], 16); p1[e] = __shfl_xor(v1[e], 16); }
                        if (fq < 2) {
#pragma unroll
                            for (int e = 0; e < 4; ++e) { v0[e] = v0[e] * c0[e] + sgn * p0[e] * s0[e]; v1[e] = v1[e] * c1[e] + sgn * p1[e] * s1[e]; }
                        }
                    }
                    if (u.pn >= 12 && u.pn < 20) {
                        if (bj == 1) { const gf4 o0 = acc[ai][0][m][0], o1 = acc[ai][0][m][1]; float gg[8];
#pragma unroll
                            for (int e = 0; e < 4; ++e) { gg[e] = v0[e] * __builtin_amdgcn_rcpf((1.f + ex2(-LOG2E * o0[e])) * (1.f + ex2(-LOG2E * v0[e]))); gg[4 + e] = v1[e] * __builtin_amdgcn_rcpf((1.f + ex2(-LOG2E * o1[e])) * (1.f + ex2(-LOG2E * v1[e]))); }
                            const int k = u.pn - 12, b_ = row >> 12, s_ = row & (SEQ - 1);
                            __builtin_nontemporal_store(pack8(gg), (v4u*)(O + PO_MG + ((size_t)(b_ * 4 + (k >> 1)) * SEQ + s_) * 256 + (k & 1) * 128 + ct0)); }
                    } else {
                    if (u.pn >= 30 && u.pn < 34) {
#pragma unroll
                        for (int e = 0; e < 4; ++e) { v0[e] = fsilu(v0[e]); v1[e] = fsilu(v1[e]); }
                    } else if (u.pn == 34) {
#pragma unroll
                        for (int e = 0; e < 4; ++e) { v0[e] = fsigmoid(v0[e]); v1[e] = fsigmoid(v1[e]); }
                    }
                    v4u w; w.x = pk2(v0[0], v0[1]); w.y = pk2(v0[2], v0[3]); w.z = pk2(v1[0], v1[1]); w.w = pk2(v1[2], v1[3]);
                    bf16* dst = proj_dst(O, u.pn, row, ct0 + bj * 128);
                    if (dst) __builtin_nontemporal_store(w, (v4u*)dst); }
                    }
                if (gl) { *(gf4*)(gates + (size_t)row * 8) = acc[ai][0][m][0]; *(gf4*)(gates + (size_t)row * 8 + 4) = acc[ai][0][m][1]; } }
    }
};
struct EpiCmpPart {
    static constexpr bool PERM = true;
    float* HP;
    DI void operator()(const gf4 (&acc)[2][2][4][2], const pg8::Unit& u, int wr, int wc, int fr, int fq) const {
        const int row0 = u.pm * 256 + wr * 64 + fr, col0 = wc * 32 + 8 * fq;
        const bool isv = u.pm >= 16;
        float* base = HP + (size_t)u.ks * 8192 * 128;
#pragma unroll
        for (int ai = 0; ai < 2; ++ai)
#pragma unroll
            for (int m = 0; m < 4; ++m) { const int row = row0 + ai * 128 + m * 16;
                const gf4 v0 = isv ? acc[ai][1][m][0] : acc[ai][0][m][0], v1 = isv ? acc[ai][1][m][1] : acc[ai][0][m][1];
                *(gf4*)(base + (size_t)row * 128 + col0) = v0; *(gf4*)(base + (size_t)row * 128 + col0 + 4) = v1; }
    }
};
struct EpiX1 {
    static constexpr bool PERM = true;
    const float* x; bf16* xb;
    DI void operator()(const gf4 (&acc)[2][2][4][2], const pg8::Unit& u, int wr, int wc, int fr, int fq) const {
        const int row0 = u.pm * 256 + wr * 64 + fr, col0 = u.pn * 256 + wc * 32 + 8 * fq;
        gf4 nx[4];
        { const size_t off = (size_t)row0 * DM + col0; nx[0] = __builtin_nontemporal_load((const gf4*)(x + off)); nx[1] = __builtin_nontemporal_load((const gf4*)(x + off + 4)); nx[2] = __builtin_nontemporal_load((const gf4*)(x + off + 128)); nx[3] = __builtin_nontemporal_load((const gf4*)(x + off + 132)); }
#pragma unroll
        for (int r8 = 0; r8 < 8; ++r8) { const int ai = r8 >> 2, m = r8 & 3; const size_t off = (size_t)(row0 + ai * 128 + m * 16) * DM + col0;
            const gf4 cx0 = nx[0], cx1 = nx[1], cx2 = nx[2], cx3 = nx[3];
            if (r8 < 7) { const int ai2 = (r8 + 1) >> 2, m2 = (r8 + 1) & 3; const size_t o2 = (size_t)(row0 + ai2 * 128 + m2 * 16) * DM + col0;
                nx[0] = __builtin_nontemporal_load((const gf4*)(x + o2)); nx[1] = __builtin_nontemporal_load((const gf4*)(x + o2 + 4)); nx[2] = __builtin_nontemporal_load((const gf4*)(x + o2 + 128)); nx[3] = __builtin_nontemporal_load((const gf4*)(x + o2 + 132)); }
            { const gf4 v0 = acc[ai][0][m][0] + cx0, v1 = acc[ai][0][m][1] + cx1; v4u w; w.x = pk2(v0[0], v0[1]); w.y = pk2(v0[2], v0[3]); w.z = pk2(v1[0], v1[1]); w.w = pk2(v1[2], v1[3]); *(v4u*)(xb + off) = w; }
            { const gf4 v0 = acc[ai][1][m][0] + cx2, v1 = acc[ai][1][m][1] + cx3; v4u w; w.x = pk2(v0[0], v0[1]); w.y = pk2(v0[2], v0[3]); w.z = pk2(v1[0], v1[1]); w.w = pk2(v1[2], v1[3]); *(v4u*)(xb + off + 128) = w; }
        }
    }
};
struct EpiPl {
    static constexpr bool PERM = true;
    bf16* PLb; float* ss;
    DI void operator()(const gf4 (&acc)[2][2][4][2], const pg8::Unit& u, int wr, int wc, int fr, int fq) const {
        const int row0 = u.pm * 256 + wr * 64 + fr, col0 = u.pn * 256 + wc * 32 + 8 * fq;
#pragma unroll
        for (int ai = 0; ai < 2; ++ai)
#pragma unroll
            for (int m = 0; m < 4; ++m) { const int row = row0 + ai * 128 + m * 16; const size_t off = (size_t)row * DM + col0; float s = 0.f;
#pragma unroll
                for (int bj = 0; bj < 2; ++bj) { const gf4 v0 = acc[ai][bj][m][0], v1 = acc[ai][bj][m][1];
                    s += (v0[0] * v0[0] + v0[1] * v0[1]) + (v0[2] * v0[2] + v0[3] * v0[3]) + (v1[0] * v1[0] + v1[1] * v1[1]) + (v1[2] * v1[2] + v1[3] * v1[3]);
                    v4u w; w.x = pk2(v0[0], v0[1]); w.y = pk2(v0[2], v0[3]); w.z = pk2(v1[0], v1[1]); w.w = pk2(v1[2], v1[3]);
                    *(v4u*)(PLb + off + bj * 128) = w; }
                s += __shfl_xor(s, 16); s += __shfl_xor(s, 32);
                if (fq == 0) atomicAdd(ss + row, s); }
    }
};
struct OneUnit {
    int pm, pn;
    __device__ bool next(int i, pg8::Unit& u) const { if (i) return false; u.pm = pm; u.pn = pn; u.ks = 0; return true; }
    DI void a_ready(const pg8::Unit&) const {}
    DI void done(const pg8::Unit&) const {}
    template <class A> DI void preload(A&, int) const {}
    DI size_t aoff(const pg8::Unit& u, const pg8::Gemm& g) const { return (size_t)u.pm * 256 * (size_t)g.lda * 2; }
};
struct P1Order {
    pg8::StaticOrder S; int i0, l8;
    DI void init(int bx, int i0_) { S.init(NT, DINP, 256, bx); i0 = i0_; const int x = bx & 7, k = bx >> 3;
        l8 = (x & 1) ? (k < 24 ? 2048 + 8 * k + x : 2048 + 8 * (k - 8) + x - 1) : (k < 16 ? 2048 + 8 * k + x : -1); }
    DI bool next(int i, pg8::Unit& u) const { const int r = i + i0; if (r > 8 || (r == 8 && l8 < 0)) return false;
        pg8::StaticOrder T = S; T.i0 = 0; if (r == 8) { T.c = l8 - 2048; } return T.next(r, u); }
    DI void a_ready(const pg8::Unit&) const {}
    DI void done(const pg8::Unit&) const {}
    template <class A> DI void preload(A&, int) const {}
    DI size_t aoff(const pg8::Unit& u, const pg8::Gemm& g) const { return (size_t)u.pm * 256 * (size_t)g.lda * 2; }
};
struct P5Order {
    pg8::StaticOrder S;
    DI void init(int M, int N, int G_, int c_) { S.init(M, N, G_, c_); }
    DI bool next(int i, pg8::Unit& u) const {
        if (S.G == 256) { if (i > 1) return false; const int x = S.c & 7, li = S.c >> 3; u.pm = 32 * i + 4 * x + (li & 3); u.pn = li >> 2; u.ks = 0; return true; }
        return S.next(i, u); }
    DI void a_ready(const pg8::Unit&) const {}
    DI void done(const pg8::Unit&) const {}
    template <class A> DI void preload(A&, int) const {}
    DI size_t aoff(const pg8::Unit& u, const pg8::Gemm& g) const { return (size_t)u.pm * 256 * (size_t)g.lda * 2; }
};
struct HalfUnit {
    int pm, pn, ks; const float* part;
    __device__ bool next(int i, pg8::Unit& u) const { if (i) return false; u.pm = pm; u.pn = pn; u.ks = ks; return true; }
    DI void a_ready(const pg8::Unit&) const {}
    DI void done(const pg8::Unit&) const {}
    DI void preload(gf4 (&acc)[2][2][4][2], int tid) const {
        if (part == nullptr) return;
#pragma unroll
        for (int i = 0; i < 32; ++i) acc[i >> 4][(i >> 3) & 1][(i >> 1) & 3][i & 1] = __builtin_nontemporal_load((const gf4*)part + i * NTHREADS + tid);
    }
    DI size_t aoff(const pg8::Unit& u, const pg8::Gemm& g) const { return (size_t)u.pm * 256 * (size_t)g.lda * 2 + (size_t)u.ks * g.K * 2; }
};
struct EpiPartSave {
    static constexpr bool PERM = true;
    float* part;
    DI void operator()(const gf4 (&acc)[2][2][4][2], const pg8::Unit&, int wr, int wc, int fr, int fq) const {
        const int tid = (wr * 4 + wc) * 64 + fq * 16 + fr;
#pragma unroll
        for (int i = 0; i < 32; ++i) __builtin_nontemporal_store(acc[i >> 4][(i >> 3) & 1][(i >> 1) & 3][i & 1], (gf4*)part + i * NTHREADS + tid);
    }
};
struct EpiGateNorm {
    static constexpr bool PERM = true;
    float* out; const bf16* x1b; const bf16* PLb; const float* plss; const float* pg; const float* fg; unsigned* slots; unsigned* cnt; LAS unsigned char* lds;
    DI void operator()(gf4 (&acc)[2][2][4][2], const pg8::Unit& u, int wr, int wc, int fr, int fq) const {
        LAS float* P = (LAS float*)(lds + 131072);
        LAS float* S = (LAS float*)(lds + 135168);
        const int tid = (wr * 4 + wc) * 64 + fr + 16 * fq;
        const int row0 = u.pm * 256 + wr * 64 + fr, col0 = u.pn * 256 + wc * 32 + 8 * fq;
        gf4 g0[2], g1[2];
#pragma unroll
        for (int bj = 0; bj < 2; ++bj) { g0[bj] = *(const gf4*)(pg + col0 + bj * 128); g1[bj] = *(const gf4*)(pg + col0 + bj * 128 + 4); }
        v4u nxa[2], npl[2]; float nps;
        { const size_t off = (size_t)row0 * DM + col0; nxa[0] = *(const v4u*)(x1b + off); nxa[1] = *(const v4u*)(x1b + off + 128); npl[0] = *(const v4u*)(PLb + off); npl[1] = *(const v4u*)(PLb + off + 128); nps = plss[row0]; }
#pragma unroll
        for (int r8 = 0; r8 < 8; ++r8) { const int ai = r8 >> 2, m = r8 & 3;
            const v4u cxa0 = nxa[0], cxa1 = nxa[1], cpl0 = npl[0], cpl1 = npl[1]; const float ps = nps;
            if (r8 < 7) { const int ai2 = (r8 + 1) >> 2, m2 = (r8 + 1) & 3; const int row2 = row0 + ai2 * 128 + m2 * 16; const size_t o2 = (size_t)row2 * DM + col0;
                nxa[0] = *(const v4u*)(x1b + o2); nxa[1] = *(const v4u*)(x1b + o2 + 128); npl[0] = *(const v4u*)(PLb + o2); npl[1] = *(const v4u*)(PLb + o2 + 128); nps = plss[row2]; }
            const float rstd = 1.f / sqrtf(ps * (1.f / DM) + EPSV);
            float s = 0.f;
#pragma unroll
            for (int bj = 0; bj < 2; ++bj) {
                float xa[8]; unpack8(bj ? cxa1 : cxa0, xa);
                float pl[8]; unpack8(bj ? cpl1 : cpl0, pl);
                gf4 v0, v1;
#pragma unroll
                for (int e = 0; e < 4; ++e) { v0[e] = xa[e] + fsigmoid(acc[ai][bj][m][0][e]) * (pl[e] * rstd * g0[bj][e]); v1[e] = xa[4 + e] + fsigmoid(acc[ai][bj][m][1][e]) * (pl[4 + e] * rstd * g1[bj][e]); }
                s += (v0[0] * v0[0] + v0[1] * v0[1]) + (v0[2] * v0[2] + v0[3] * v0[3]) + (v1[0] * v1[0] + v1[1] * v1[1]) + (v1[2] * v1[2] + v1[3] * v1[3]);
                acc[ai][bj][m][0] = v0; acc[ai][bj][m][1] = v1; }
            s += __shfl_xor(s, 16); s += __shfl_xor(s, 32);
            if (fq == 0) P[(ai * 128 + wr * 64 + m * 16 + fr) * 4 + wc] = s; }
        __syncthreads();
        if (tid < 256) { const f32x4 p4 = *(const LAS f32x4*)(P + tid * 4); const float t = (p4.x + p4.y) + (p4.z + p4.w);
            __hip_atomic_store(slots + ((size_t)(u.pm * 256 + tid)) * 8 + u.pn, __float_as_uint(t), __ATOMIC_RELAXED, __HIP_MEMORY_SCOPE_AGENT); }
        asm volatile("s_waitcnt vmcnt(0)" ::: "memory");
        __syncthreads();
        if (tid == 0) {
            unsigned* c = cnt + 64 * u.pm;
            __hip_atomic_fetch_add(c, 1u, __ATOMIC_RELAXED, __HIP_MEMORY_SCOPE_AGENT);
            unsigned sp = 0;
            while (__hip_atomic_load(c, __ATOMIC_RELAXED, __HIP_MEMORY_SCOPE_AGENT) < 8u) { if (++sp > (1u << 24)) break; }
            __builtin_amdgcn_fence(__ATOMIC_ACQUIRE, "agent");
            asm volatile("s_waitcnt vmcnt(0)" ::: "memory");
        }
        __syncthreads();
        if (tid < 256) { float t = 0.f;
#pragma unroll
            for (int k = 0; k < 8; ++k) t += __uint_as_float(__hip_atomic_load(slots + ((size_t)(u.pm * 256 + tid)) * 8 + k, __ATOMIC_RELAXED, __HIP_MEMORY_SCOPE_AGENT));
            S[tid] = 1.f / sqrtf(t * (1.f / DM) + EPSV); }
        __syncthreads();
#pragma unroll
        for (int bj = 0; bj < 2; ++bj) { g0[bj] = *(const gf4*)(fg + col0 + bj * 128); g1[bj] = *(const gf4*)(fg + col0 + bj * 128 + 4); }
#pragma unroll
        for (int ai = 0; ai < 2; ++ai)
#pragma unroll
            for (int m = 0; m < 4; ++m) { const int rl = ai * 128 + wr * 64 + m * 16 + fr; const size_t off = (size_t)(u.pm * 256 + rl) * DM + col0; const float rs = S[rl];
#pragma unroll
                for (int bj = 0; bj < 2; ++bj) { gf4 o0, o1;
#pragma unroll
                    for (int e = 0; e < 4; ++e) { o0[e] = acc[ai][bj][m][0][e] * rs * g0[bj][e]; o1[e] = acc[ai][bj][m][1][e] * rs * g1[bj][e]; }
                    __builtin_nontemporal_store(o0, (gf4*)(out + off + bj * 128)); __builtin_nontemporal_store(o1, (gf4*)(out + off + bj * 128 + 4)); } }
        __syncthreads();
    }
};

DI float log_sigmoid(float z) { return fminf(z, 0.f) - 0.6931471805599453f * __builtin_amdgcn_logf(1.f + ex2(-LOG2E * fabsf(z))); }
DI void phase2_scan(const Ctx& C, LAS unsigned char* lds, int bh) {
    int tid = C.tid(); asm volatile("" : "+v"(tid));
    const int lane = tid & 63, wave = tid >> 6;
    const int b = bh >> 2, h = bh & 3;
    LAS float* red = (LAS float*)lds;
    const float bi = C.b_ig[h], bfg = C.b_fg[h];
    float ig[8], lf[8];
#pragma unroll
    for (int e = 0; e < 8; ++e) { const size_t row = (size_t)b * SEQ + tid * 8 + e; ig[e] = C.gates()[row * 8 + h] + bi; lf[e] = log_sigmoid(C.gates()[row * 8 + 4 + h] + bfg); }
    float cs[8]; cs[0] = lf[0];
#pragma unroll
    for (int e = 1; e < 8; ++e) cs[e] = cs[e - 1] + lf[e];
    float incl = cs[7];
#pragma unroll
    for (int o = 1; o < 64; o <<= 1) { const float t = __shfl_up(incl, o); if (lane >= o) incl += t; }
    if (lane == 63) red[wave] = incl;
    __syncthreads();
    float woff = 0.f;
#pragma unroll
    for (int w = 0; w < 8; ++w) woff += (w < wave) ? red[w] : 0.f;
    const float excl = woff + incl - cs[7];
    float u[8], cm[8];
#pragma unroll
    for (int e = 0; e < 8; ++e) u[e] = ig[e] - (excl + cs[e]);
    cm[0] = u[0];
#pragma unroll
    for (int e = 1; e < 8; ++e) cm[e] = fmaxf(cm[e - 1], u[e]);
    float mincl = cm[7];
#pragma unroll
    for (int o = 1; o < 64; o <<= 1) { const float t = __shfl_up(mincl, o); if (lane >= o) mincl = fmaxf(mincl, t); }
    float mexcl = __shfl_up(mincl, 1); if (lane == 0) mexcl = 0.f;
    if (lane == 63) red[8 + wave] = mincl;
    __syncthreads();
    float wmax = 0.f;
#pragma unroll
    for (int w = 0; w < 8; ++w) wmax = (w < wave) ? fmaxf(wmax, red[8 + w]) : wmax;
    const float base = fmaxf(fmaxf(mexcl, wmax), 0.f);
#pragma unroll
    for (int e = 0; e < 8; ++e) { const size_t o = (size_t)bh * SEQ + tid * 8 + e; C.u2()[o] = u[e] * LOG2E; C.mx2()[o] = fmaxf(base, cm[e]) * LOG2E; }
    __syncthreads();
}
DI void phase2(const Ctx& C, LAS unsigned char* lds) {
    int tid = C.tid(); asm volatile("" : "+v"(tid));
    const int lane = tid & 63, wave = __builtin_amdgcn_readfirstlane(tid >> 6);
    if (C.G == 256) { if ((C.vcu & 31) < 2) phase2_scan(C, lds, (C.vcu >> 5) * 2 + (C.vcu & 31)); }
    else if (C.vcu < 16) phase2_scan(C, lds, C.vcu);
    if (C.G < 16) { for (int bh = C.vcu + C.G; bh < 16; bh += C.G) phase2_scan(C, lds, bh); }
    const int gw = C.vcu * NWAVES + wave, NGW = C.G * NWAVES;
    const int grpl = (C.vcu >> 6) * 256 + (C.vcu & 31) * NWAVES + wave;
    const int itA = grpl * 4 + ((C.vcu >> 5) & 1), itB = itA + 2;
    for (int it0 = gw; it0 < (NT / 16) * 4; it0 += 2 * NGW) {
        v4u raw[2][19];
#pragma unroll
        for (int z = 0; z < 2; ++z) { const int it = (C.G == 256) ? (z ? itB : itA) : it0 + z * NGW; const int grp = it >> 2, chunk = it & 3, c0 = chunk * 512 + lane * 8, t0 = grp * 16; const bool first = (t0 & (SEQ - 1)) == 0;
#pragma unroll
            for (int q = 0; q < 19; ++q) { const int tr = t0 - 3 + q; raw[z][q] = ((q < 3 && first) || it >= (NT / 16) * 4) ? (v4u){0u, 0u, 0u, 0u} : __builtin_nontemporal_load((const v4u*)(C.PROJ() + PO_MQK + (size_t)tr * 2048 + c0)); } }
#pragma unroll
        for (int z = 0; z < 2; ++z) { const int it = (C.G == 256) ? (z ? itB : itA) : it0 + z * NGW; if (it >= (NT / 16) * 4) break;
            const int grp = it >> 2, chunk = it & 3, c0 = chunk * 512 + lane * 8, t0 = grp * 16;
            float w[4][8], bb[8];
#pragma unroll
            for (int j = 0; j < 4; ++j) { const f32x4 a = *(const f32x4*)(C.conv_w + j * 2048 + c0), b2 = *(const f32x4*)(C.conv_w + j * 2048 + c0 + 4);
                w[j][0] = a.x; w[j][1] = a.y; w[j][2] = a.z; w[j][3] = a.w; w[j][4] = b2.x; w[j][5] = b2.y; w[j][6] = b2.z; w[j][7] = b2.w; }
            { const f32x4 a = *(const f32x4*)(C.conv_b + c0), b2 = *(const f32x4*)(C.conv_b + c0 + 4); bb[0] = a.x; bb[1] = a.y; bb[2] = a.z; bb[3] = a.w; bb[4] = b2.x; bb[5] = b2.y; bb[6] = b2.z; bb[7] = b2.w; }
            const bool isk = c0 >= 1024;
            const int ch = c0 & 1023;
            bf16* dst = (isk ? C.KC() : C.QC()) + ((size_t)((t0 >> 12) * 4 + (ch >> 8)) * SEQ + (t0 & (SEQ - 1))) * 256 + (ch & 255);
            const float osc = isk ? 0.0625f : 1.f;
            float a0[8], a1[8], a2[8], a3[8];
            unpack8(raw[z][0], a0); unpack8(raw[z][1], a1); unpack8(raw[z][2], a2);
#pragma unroll
            for (int tt = 0; tt < 16; ++tt) {
                unpack8(raw[z][3 + tt], a3);
                float y[8];
#pragma unroll
                for (int e = 0; e < 8; ++e) { const float v = bb[e] + w[3][e] * a3[e] + w[0][e] * a0[e] + w[1][e] * a1[e] + w[2][e] * a2[e]; y[e] = fsilu(v) * osc; a0[e] = a1[e]; a1[e] = a2[e]; a2[e] = a3[e]; }
                *(v4u*)(dst + (size_t)tt * 256) = pack8(y);
            }
        }
    }
    const int pgrp = (C.G == 256) ? (C.vcu >> 5) : 0;
    for (int it = (C.G == 256) ? (C.vcu & 31) * NWAVES + wave : gw; it < 256; it += NGW) {
        const float* ps = (it >> 7) ? C.pos_v : C.pos_k; const bf16* wr = C.Wc1T() + (size_t)it * 2048;
        float a = 0.f;
#pragma unroll
        for (int i = 0; i < 4; ++i) { const int k = 8 * (lane + 64 * i); float wv[8]; unpack8(*(const v4u*)(wr + k), wv);
            const f32x4 p0 = *(const f32x4*)(ps + k), p1 = *(const f32x4*)(ps + k + 4);
            a += ((p0.x * wv[0] + p0.y * wv[1]) + (p0.z * wv[2] + p0.w * wv[3])) + ((p1.x * wv[4] + p1.y * wv[5]) + (p1.z * wv[6] + p1.w * wv[7])); }
        a = wave_sum(a);
        if (lane == 0) C.posb()[pgrp * 256 + it] = a; }
}

DI void phase3b(const Ctx& C, LAS unsigned char* lds) {
    int tid = C.tid(); asm volatile("" : "+v"(tid));
    const int lane = tid & 63, wave = __builtin_amdgcn_readfirstlane(tid >> 6);
    LAS float* w2s = (LAS float*)lds;
    LAS float* scr = (LAS float*)(lds + 65536 + wave * 2048);
    __syncthreads();
    for (int i = tid; i < 2 * 128 * 64 / 4; i += NTHREADS) { const f32x4 v = (i < 2048) ? *((const f32x4*)C.ck_w2 + i) : *((const f32x4*)C.cv_w2 + (i - 2048)); *((LAS f32x4*)w2s + i) = v; }
    __syncthreads();
    const int gw = C.vcu * NWAVES + wave, NGW = C.G * NWAVES;
    for (int it = gw; it < 2048; it += NGW) {
        int r0 = it * 4;
        if (C.G == 256) { const int g8 = C.vcu >> 5, jj = (C.vcu & 31) * NWAVES + wave, t4 = jj >> 6; r0 = (((t4 >> 1) * 16 + 2 * g8 + (t4 & 1)) << 8) + (jj & 63) * 4; }
        const LAS float* w2 = w2s + ((r0 >= 4096) ? 128 * 64 : 0);
        { const int idx = lane * 8; const float* hp = C.HIDP() + (size_t)r0 * 128 + idx;
          f32x4 a = {0.f, 0.f, 0.f, 0.f}, b2 = {0.f, 0.f, 0.f, 0.f};
#pragma unroll
          for (int ks = 0; ks < 8; ++ks) { a += *(const f32x4*)(hp + (size_t)ks * 8192 * 128); b2 += *(const f32x4*)(hp + (size_t)ks * 8192 * 128 + 4); }
          const float* pb = C.posb() + ((C.G == 256) ? (C.vcu >> 5) * 256 : 0) + ((r0 >= 4096) ? 128 : 0) + (idx & 127);
          const f32x4 q0 = *(const f32x4*)pb, q1 = *(const f32x4*)(pb + 4);
          const float f[8] = {a.x + q0.x, a.y + q0.y, a.z + q0.z, a.w + q0.w, b2.x + q1.x, b2.y + q1.y, b2.z + q1.z, b2.w + q1.w};
#pragma unroll
          for (int e = 0; e < 8; ++e) scr[idx + e] = fgelu_tanh(f[e]); }
        __builtin_amdgcn_fence(__ATOMIC_RELEASE, "wavefront"); __builtin_amdgcn_wave_barrier(); __builtin_amdgcn_fence(__ATOMIC_ACQUIRE, "wavefront");
        float acc[4] = {0.f, 0.f, 0.f, 0.f};
#pragma unroll 8
        for (int hh = 0; hh < 128; ++hh) { const float w = w2[hh * 64 + lane];
#pragma unroll
            for (int rr = 0; rr < 4; ++rr) acc[rr] += scr[rr * 128 + hh] * w; }
#pragma unroll
        for (int rr = 0; rr < 4; ++rr) C.KVC()[(size_t)(r0 + rr) * 64 + lane] = (((r0 + rr) & 255) == 255) ? (bf16)0 : (bf16)(pk2(acc[rr], 0.f) & 0xffffu);
        __builtin_amdgcn_fence(__ATOMIC_RELEASE, "wavefront"); __builtin_amdgcn_wave_barrier(); __builtin_amdgcn_fence(__ATOMIC_ACQUIRE, "wavefront");
    }
    __syncthreads();
}

DI void qk_tile64(const LAS unsigned char* Kt, const bf16x8 (&qr)[4], f32x16& p0, f32x16& p1, int r32, int hi) {
    const LAS unsigned char* kb = Kt + hi * 1024 + r32 * 16;
    bf16x8 kf[8];
#pragma unroll
    for (int d0 = 0; d0 < 4; ++d0) { kf[2 * d0] = *(const LAS bf16x8*)(kb + d0 * 2048); kf[2 * d0 + 1] = *(const LAS bf16x8*)(kb + d0 * 2048 + 512); }
    __builtin_amdgcn_sched_barrier(0);
#pragma unroll
    for (int d0 = 0; d0 < 4; ++d0) { p0 = MFMA32(kf[2 * d0], qr[d0], p0); p1 = MFMA32(kf[2 * d0 + 1], qr[d0], p1); }
}
DI s16x4 vtr(const LAS unsigned char* p) { return __builtin_bit_cast(s16x4, __builtin_amdgcn_ds_read_tr16_b64_v4i16((LAS s16x4*)p)); }
DI bf16x8 pack_p(const f32x16& p, int s) {
    v4u w; w.x = pk2(p[8 * s + 0], p[8 * s + 1]); w.y = pk2(p[8 * s + 2], p[8 * s + 3]); w.z = pk2(p[8 * s + 4], p[8 * s + 5]); w.w = pk2(p[8 * s + 6], p[8 * s + 7]);
    return __builtin_bit_cast(bf16x8, w);
}
typedef float f32x2v __attribute__((ext_vector_type(2)));
struct Sm { float m, l; f32x16 o0, o1; };
DI void softmax_pv64_fast(const LAS unsigned char* Vt, f32x16& p0, f32x16& p1, Sm& st, LAS float* wsf, int lane, int r32, int hi, bool en, float SC) {
    const LAS unsigned char* vp = Vt + ((lane >> 4) & 1) * 32 + (lane & 3) * 8 + (4 * hi + ((lane & 15) >> 2)) * 64;
    bf16x8 vfr[8];
#pragma unroll
    for (int db = 0; db < 2; ++db)
#pragma unroll
        for (int s = 0; s < 4; ++s) { const s16x4 lo = vtr(vp + db * 4096 + s * 1024), hh = vtr(vp + db * 4096 + s * 1024 + 512); vfr[4 * db + s] = __builtin_shufflevector(lo, hh, 0, 1, 2, 3, 4, 5, 6, 7); }
    __builtin_amdgcn_sched_barrier(0);
    const bool fresh = st.m < -1.0e29f;
    const float refo = fresh ? 0.f : st.m;
    const float scl = en ? SC : 0.f, offo = en ? -refo : NEGV;
    const f32x2v scl2 = {scl, scl}, offo2 = {offo, offo};
    f32x2v a2[8], c2[8];
#pragma unroll
    for (int q = 0; q < 8; ++q) { a2[q] = (f32x2v){p0[2 * q], p0[2 * q + 1]} * scl2 + offo2; c2[q] = (f32x2v){p1[2 * q], p1[2 * q + 1]} * scl2 + offo2; }
    float mx = fmaxf(fmaxf(a2[0].x, a2[0].y), fmaxf(c2[0].x, c2[0].y));
#pragma unroll
    for (int q = 1; q < 8; ++q) { mx = fmaxf(fmaxf(mx, a2[q].x), a2[q].y); mx = fmaxf(fmaxf(mx, c2[q].x), c2[q].y); }
    mx = swap32_max(mx);
    const bool move = (fresh || mx > 8.f) && (mx > -1.0e29f);
    const float delta = move ? mx : 0.f;
    const float alpha = (move && !fresh) ? ex2(-delta) : 1.f;
    st.m = move ? refo + delta : st.m;
    if (__any(delta != 0.f)) {
        const f32x2v d2 = {delta, delta};
#pragma unroll
        for (int q = 0; q < 8; ++q) { a2[q] -= d2; c2[q] -= d2; }
    }
    f32x2v ps2 = {0.f, 0.f};
#pragma unroll
    for (int q = 0; q < 8; ++q) {
        f32x2v ea, ec; ea.x = ex2(a2[q].x); ea.y = ex2(a2[q].y); ec.x = ex2(c2[q].x); ec.y = ex2(c2[q].y);
        p0[2 * q] = ea.x; p0[2 * q + 1] = ea.y; p1[2 * q] = ec.x; p1[2 * q + 1] = ec.y;
        ps2 += ea; ps2 += ec;
    }
    const float ps = ps2.x + ps2.y;
    st.l = st.l * alpha + ps;
    if (__any(alpha != 1.f)) {
        if (hi == 0) wsf[r32] = alpha;
        __builtin_amdgcn_fence(__ATOMIC_RELEASE, "wavefront"); __builtin_amdgcn_wave_barrier(); __builtin_amdgcn_fence(__ATOMIC_ACQUIRE, "wavefront");
#pragma unroll
        for (int k4 = 0; k4 < 4; ++k4) { const f32x4 a = *(const LAS f32x4*)(wsf + 8 * k4 + 4 * hi);
#pragma unroll
            for (int e = 0; e < 4; ++e) { st.o0[4 * k4 + e] *= a[e]; st.o1[4 * k4 + e] *= a[e]; } }
        __builtin_amdgcn_fence(__ATOMIC_RELEASE, "wavefront"); __builtin_amdgcn_wave_barrier(); __builtin_amdgcn_fence(__ATOMIC_ACQUIRE, "wavefront");
    }
    const bf16x8 pa0 = pack_p(p0, 0), pa1 = pack_p(p0, 1), pa2 = pack_p(p1, 0), pa3 = pack_p(p1, 1);
    __builtin_amdgcn_sched_barrier(0);
#pragma unroll
    for (int db = 0; db < 2; ++db) {
        f32x16 o = db ? st.o1 : st.o0;
#pragma unroll
        for (int s = 0; s < 4; ++s) o = MFMA32(s == 0 ? pa0 : (s == 1 ? pa1 : (s == 2 ? pa2 : pa3)), vfr[4 * db + s], o);
        if (db) st.o1 = o; else st.o0 = o;
    }
}
DI void dma_kv64(const bf16* Ksrc, const bf16* Vsrc, unsigned pitch, LAS unsigned char* Kd, LAS unsigned char* Vd, int wid, int lane) {
    glds16s<0>(Ksrc + wid * 8, (unsigned)lane * pitch * 2u, (unsigned)__builtin_amdgcn_readfirstlane(lds_u32(Kd) + wid * 1024));
    glds16s<0>(Vsrc + (size_t)(16 * (wid & 3)) * pitch + (wid >> 2) * 32, ((unsigned)(lane >> 2) * pitch + (lane & 3) * 8) * 2u, (unsigned)__builtin_amdgcn_readfirstlane(lds_u32(Vd) + wid * 1024));
}
DI void ring_wait(int r) { if (r >= 2) WAITBAR(4); else if (r == 1) WAITBAR(2); else WAITBAR(0); }
DI void fold_branch(const Sm& st, float f, f32x16& fin0, f32x16& fin1, LAS float* wsf, int r32, int hi) {
    if (hi == 0) wsf[r32] = f;
    __builtin_amdgcn_fence(__ATOMIC_RELEASE, "wavefront"); __builtin_amdgcn_wave_barrier(); __builtin_amdgcn_fence(__ATOMIC_ACQUIRE, "wavefront");
#pragma unroll
    for (int k4 = 0; k4 < 4; ++k4) { const f32x4 a = *(const LAS f32x4*)(wsf + 8 * k4 + 4 * hi);
#pragma unroll
        for (int e = 0; e < 4; ++e) { fin0[4 * k4 + e] += st.o0[4 * k4 + e] * a[e]; fin1[4 * k4 + e] += st.o1[4 * k4 + e] * a[e]; } }
    __builtin_amdgcn_fence(__ATOMIC_RELEASE, "wavefront"); __builtin_amdgcn_wave_barrier(); __builtin_amdgcn_fence(__ATOMIC_ACQUIRE, "wavefront");
}

DI void nsa_unit(const Ctx& C, LAS unsigned char* lds, int b, int g, int qb, int nqb, bf16x8 (&qpre)[4], bool havepre) {
    int tid = C.tid(); asm volatile("" : "+v"(tid));
    const int lane = tid & 63, wid = __builtin_amdgcn_readfirstlane(tid >> 6), r32 = lane & 31, hi = lane >> 5;
    const int j = wid & 3, th = wid >> 2, head = 4 * g + j;
    const int tl = 32 * th + r32, t = 64 * qb + tl;
    const size_t row0 = (size_t)b * SEQ + 64 * qb;
    LAS unsigned char* Kb = lds;
    LAS unsigned char* Vb = lds + 32768;
    LAS float* impw = (LAS float*)(lds + 65536);
    LAS float* wsf = (LAS float*)(lds + LDS_MISC) + wid * 64;
    LAS unsigned char* selb = lds + LDS_MISC + 2048;
    LAS float* sc = (LAS float*)(lds + 65536);
    LAS float* stg;
    const float SC = 0.125f * LOG2E;
    bf16x8 qr[4];
    if (havepre) {
#pragma unroll
        for (int d0 = 0; d0 < 4; ++d0) qr[d0] = qpre[d0];
    } else { const bf16* qp = C.PROJ() + PO_NQ + ((size_t)(b * 16 + head) * SEQ + t) * 64 + 8 * hi;
#pragma unroll
      for (int d0 = 0; d0 < 4; ++d0) qr[d0] = *(const bf16x8*)(qp + 16 * d0); }
    const bf16* ngp = C.PROJ() + PO_NG + (row0 + tl) * 64 + head * 3;
    const float g0 = bf2f(ngp[0]), g1 = bf2f(ngp[1]), g2 = bf2f(ngp[2]);
    f32x16 fin0, fin1;
#pragma unroll
    for (int r = 0; r < 16; ++r) { fin0[r] = 0.f; fin1[r] = 0.f; }
    const int bg = b * 4 + g;

    const int nkt = ((4 * qb + 2) >> 6) + 1;
    if (!havepre) {
        LBAR();
        for (int kt = 0; kt < nkt; ++kt)
            dma_kv64(C.KVC() + ((size_t)bg * 256 + 64 * kt) * 64, C.KVC() + ((size_t)4096 + bg * 256 + 64 * kt) * 64, 64, Kb + kt * 8192, Vb + kt * 8192, wid, lane);
    }
    for (int idx = lane; idx < 32 * 66; idx += 64) impw[(j * 64 + 32 * th) * 66 + idx] = 0.f;
    WAITBAR(0);
    const int climit = (t >= 31) ? ((t - 31) >> 4) : -1;
    Sm st; st.m = NEGV; st.l = 0.f;
#pragma unroll
    for (int r = 0; r < 16; ++r) { st.o0[r] = 0.f; st.o1[r] = 0.f; }
    LAS float* fwv = (LAS float*)(lds + 139392);
    LAS float* spv = (LAS float*)(lds + 139392 + 4096);
    const bool need_imp = qb >= 16;
    LAS float* myimp = impw + (j * 64 + tl) * 66;
    for (int kt = 0; kt < nkt; ++kt) {
        f32x16 p0, p1;
#pragma unroll
        for (int r = 0; r < 16; ++r) { p0[r] = 0.f; p1[r] = 0.f; }
        qk_tile64(Kb + kt * 8192, qr, p0, p1, r32, hi);
#pragma unroll
        for (int r = 0; r < 16; ++r) { const int c = 64 * kt + crow(r, hi); p0[r] = (c <= climit) ? p0[r] : NEGV; p1[r] = (c + 32 <= climit) ? p1[r] : NEGV; }
        softmax_pv64_fast(Vb + kt * 8192, p0, p1, st, wsf, lane, r32, hi, climit >= 64 * kt, SC);
        if (need_imp) {
            if (hi == 0) fwv[(j * 64 + tl) * 4 + kt] = st.m;
            float mainv[8], nxtv[8], cur[8];
#pragma unroll
            for (int hf = 0; hf < 2; ++hf)
#pragma unroll
                for (int k4 = 0; k4 < 4; ++k4) {
                    const float a0 = hf ? p1[4 * k4] : p0[4 * k4], a1 = hf ? p1[4 * k4 + 1] : p0[4 * k4 + 1], a2 = hf ? p1[4 * k4 + 2] : p0[4 * k4 + 2], a3 = hf ? p1[4 * k4 + 3] : p0[4 * k4 + 3];
                    mainv[4 * hf + k4] = (a0 + a1) + (a2 + 0.5f * a3); nxtv[4 * hf + k4] = 0.5f * a3; }
#pragma unroll
            for (int q = 0; q < 8; ++q) cur[q] = myimp[16 * kt + 8 * (q >> 2) + 2 * (q & 3) + hi];
#pragma unroll
            for (int q = 0; q < 8; ++q) myimp[16 * kt + 8 * (q >> 2) + 2 * (q & 3) + hi] = cur[q] + mainv[q];
            __builtin_amdgcn_fence(__ATOMIC_RELEASE, "wavefront"); __builtin_amdgcn_wave_barrier(); __builtin_amdgcn_fence(__ATOMIC_ACQUIRE, "wavefront");
#pragma unroll
            for (int q = 0; q < 8; ++q) cur[q] = (q == 7 && hi == 1) ? 0.f : myimp[16 * kt + 8 * (q >> 2) + 2 * (q & 3) + hi + 1];
#pragma unroll
            for (int q = 0; q < 8; ++q) { if (q == 7 && hi == 1) { if (kt < 3) spv[(j * 64 + tl) * 3 + kt] = nxtv[7]; } else myimp[16 * kt + 8 * (q >> 2) + 2 * (q & 3) + hi + 1] = cur[q] + nxtv[q]; }
            __builtin_amdgcn_fence(__ATOMIC_RELEASE, "wavefront"); __builtin_amdgcn_wave_barrier(); __builtin_amdgcn_fence(__ATOMIC_ACQUIRE, "wavefront");
        }
    }
    {
        const float l = st.l + __shfl_xor(st.l, 32);
        const float inv_l = (climit >= 0) ? 1.f / l : 0.f;
#pragma unroll
        for (int r = 0; r < 16; ++r) { fin0[r] = 0.f; fin1[r] = 0.f; }
        fold_branch(st, g0 * inv_l, fin0, fin1, wsf, r32, hi);
        if (need_imp && hi == 0) {
            for (int kt = 0; kt < nkt; ++kt) { const float mr = fwv[(j * 64 + tl) * 4 + kt]; fwv[(j * 64 + tl) * 4 + kt] = ex2(mr - st.m) * inv_l; }
        }
    }
    LBAR();
    dma_kv64(C.PROJ() + PO_KV6 + 2 * KVSZ + (size_t)(b * 4 + g) * SEQ * 64, C.PROJ() + PO_KV6 + 3 * KVSZ + (size_t)(b * 4 + g) * SEQ * 64, 64, Kb, Vb, wid, lane);
    {
        const int tok = tid & 63, part = tid >> 6;
        float cand[8];
        {
            float imp[8];
#pragma unroll
            for (int e = 0; e < 8; ++e) imp[e] = 0.f;
            const int kt = part >> 1;
            if (need_imp && kt < nkt) {
#pragma unroll
                for (int jj = 0; jj < 4; ++jj) {
                    const float f = fwv[(jj * 64 + tok) * 4 + kt];
                    const LAS f32x2_t* ip = (const LAS f32x2_t*)(impw + (jj * 64 + tok) * 66 + part * 8);
#pragma unroll
                    for (int q = 0; q < 4; ++q) { const f32x2_t v = ip[q]; imp[2 * q] += v.x * f; imp[2 * q + 1] += v.y * f; }
                    if ((part & 1) == 0 && part >= 2) imp[0] += spv[(jj * 64 + tok) * 3 + kt - 1] * fwv[(jj * 64 + tok) * 4 + kt - 1];
                }
            }
#pragma unroll
            for (int e = 0; e < 8; ++e) { const int n = part * 8 + e;
                const bool forced = (n == 0) || (n == qb) || (n == qb - 1);
                cand[e] = (n <= qb) ? (imp[e] + (forced ? 1000.f : 0.f)) : NEGV; }
        }
        LBAR();
#pragma unroll
        for (int e = 0; e < 8; e += 4) *(LAS f32x4*)(sc + tok * 68 + part * 8 + e) = (f32x4){cand[e], cand[e + 1], cand[e + 2], cand[e + 3]};
        LBAR();
        if (qb < 16) {
            unsigned byte = 0;
#pragma unroll
            for (int e = 0; e < 8; ++e) { const int n = part * 8 + e; if (n <= qb) byte |= (1u << e); }
            selb[tok * 8 + part] = (unsigned char)byte;
        } else {
            unsigned key[8], srt[8], pr[8];
#pragma unroll
            for (int i = 0; i < 8; ++i) { const float c = sc[(wid * 8 + i) * 68 + lane]; key[i] = (lane <= qb) ? ((__float_as_uint(c) & ~63u) | (unsigned)(63 - lane)) : 0u; srt[i] = key[i]; }
#pragma unroll
            for (int k = 2; k <= 64; k <<= 1)
#pragma unroll
                for (int jx = k >> 1; jx > 0; jx >>= 1) {
                    const bool keepmax = (((lane & jx) == 0) == ((lane & k) == 0));
#pragma unroll
                    for (int i = 0; i < 8; ++i) pr[i] = (unsigned)__shfl_xor((int)srt[i], jx);
                    __builtin_amdgcn_sched_barrier(0);
#pragma unroll
                    for (int i = 0; i < 8; ++i) { const unsigned hi_ = srt[i] > pr[i] ? srt[i] : pr[i], lo_ = srt[i] > pr[i] ? pr[i] : srt[i]; srt[i] = keepmax ? hi_ : lo_; }
                    __builtin_amdgcn_sched_barrier(0);
                }
#pragma unroll
            for (int i = 0; i < 8; ++i) { const unsigned T = (unsigned)__builtin_amdgcn_readlane((int)srt[i], 15);
                const unsigned long long m = __ballot((lane <= qb) && (key[i] >= T));
                if (lane == 0) { v2u w; w.x = (unsigned)m; w.y = (unsigned)(m >> 32); *(LAS v2u*)(selb + (wid * 8 + i) * 8) = w; } }
        }
        LBAR();
    }
    unsigned long long mysel, un;
    { const v2u w = *(const LAS v2u*)(selb + tl * 8); mysel = ((unsigned long long)w.y << 32) | w.x;
      const v2u a = *(const LAS v2u*)(selb + lane * 8); unsigned lo = a.x, hh = a.y;
#pragma unroll
      for (int o = 1; o < 64; o <<= 1) { lo |= __shfl_xor(lo, o); hh |= __shfl_xor(hh, o); }
      un = ((unsigned long long)__builtin_amdgcn_readfirstlane(hh) << 32) | (unsigned)__builtin_amdgcn_readfirstlane(lo); }
    LAS float* accF = (LAS float*)(lds + 65536);
#pragma unroll
    for (int r = 0; r < 16; ++r) { const int tok = 32 * th + crow(r, hi); accF[tok * STG_PITCH + j * 64 + r32] = fin0[r]; accF[tok * STG_PITCH + j * 64 + 32 + r32] = fin1[r]; }
#define NSA_FOLD(F) do { const float f_ = (F); if (hi == 0) wsf[r32] = f_; \
        __builtin_amdgcn_fence(__ATOMIC_RELEASE, "wavefront"); __builtin_amdgcn_wave_barrier(); __builtin_amdgcn_fence(__ATOMIC_ACQUIRE, "wavefront"); \
        _Pragma("unroll") for (int k4 = 0; k4 < 4; ++k4) { const f32x4 a_ = *(const LAS f32x4*)(wsf + 8 * k4 + 4 * hi); \
            _Pragma("unroll") for (int e = 0; e < 4; ++e) { const int tok_ = 32 * th + 8 * k4 + 4 * hi + e; \
                accF[tok_ * STG_PITCH + j * 64 + r32] += st.o0[4 * k4 + e] * a_[e]; accF[tok_ * STG_PITCH + j * 64 + 32 + r32] += st.o1[4 * k4 + e] * a_[e]; } } \
        __builtin_amdgcn_fence(__ATOMIC_RELEASE, "wavefront"); __builtin_amdgcn_wave_barrier(); __builtin_amdgcn_fence(__ATOMIC_ACQUIRE, "wavefront"); } while (0)
#define NSA_QK(bo) f32x16 p0, p1; _Pragma("unroll") for (int r = 0; r < 16; ++r) { p0[r] = 0.f; p1[r] = 0.f; } qk_tile64(Kb + (bo), qr, p0, p1, r32, hi)

    {
        const bf16* Kg = C.PROJ() + PO_KV6 + 2 * KVSZ + (size_t)(b * 4 + g) * SEQ * 64;
        const bf16* Vg = C.PROJ() + PO_KV6 + 3 * KVSZ + (size_t)(b * 4 + g) * SEQ * 64;
        st.m = NEGV; st.l = 0.f;
#pragma unroll
        for (int r = 0; r < 16; ++r) { st.o0[r] = 0.f; st.o1[r] = 0.f; }
        unsigned long long um = un, ui = un; const int ntile = __builtin_popcountll(un);
        ui &= ui - 1;
#pragma unroll
        for (int q = 1; q < 3; ++q) if (q < ntile) { const int n = __builtin_ctzll(ui); ui &= ui - 1; dma_kv64(Kg + (size_t)4096 * n, Vg + (size_t)4096 * n, 64, Kb + q * 8192, Vb + q * 8192, wid, lane); }
        for (int i = 0; i < ntile - 1; ++i) {
            const int n = __builtin_ctzll(um); um &= um - 1;
            ring_wait(ntile - 1 - i);
            if (i + 3 < ntile) { const int n2 = __builtin_ctzll(ui); ui &= ui - 1; const int bo2 = ((i + 3) & 3) * 8192; dma_kv64(Kg + (size_t)4096 * n2, Vg + (size_t)4096 * n2, 64, Kb + bo2, Vb + bo2, wid, lane); }
            const bool seln = (mysel >> n) & 1ull;
            if (__any(seln)) { const int bo = (i & 3) * 8192; NSA_QK(bo); softmax_pv64_fast(Vb + bo, p0, p1, st, wsf, lane, r32, hi, seln, SC); }
        }
        {
            const int i = ntile - 1;
            ring_wait(0);
            const int bo = (i & 3) * 8192; NSA_QK(bo);
#pragma unroll
            for (int r = 0; r < 16; ++r) { const int kv = crow(r, hi); p0[r] = (kv <= tl) ? p0[r] : -3.0e38f; p1[r] = (kv + 32 <= tl) ? p1[r] : -3.0e38f; }
            softmax_pv64_fast(Vb + bo, p0, p1, st, wsf, lane, r32, hi, true, SC);
        }
        const float l = st.l + __shfl_xor(st.l, 32);
        NSA_FOLD(g1 / l);
    }
    WAITBAR(0);
    v4u nzv[4];
    { const bf16* nz = C.PROJ() + PO_NZ + ((size_t)(b * 16 + 4 * g + ((tid & 7) >> 1)) * SEQ + 64 * qb + (tid >> 3)) * 64 + (tid & 1) * 32;
#pragma unroll
      for (int q = 0; q < 4; ++q) nzv[q] = *(const v4u*)(nz + 8 * ((q + ((tid & 7) >> 1)) & 3)); }
    {
        const bf16* Kg = C.PROJ() + PO_KV6 + 4 * KVSZ + (size_t)(b * 4 + g) * SEQ * 64;
        const bf16* Vg = C.PROJ() + PO_KV6 + 5 * KVSZ + (size_t)(b * 4 + g) * SEQ * 64;
        st.m = NEGV; st.l = 0.f;
#pragma unroll
        for (int r = 0; r < 16; ++r) { st.o0[r] = 0.f; st.o1[r] = 0.f; }
        const int n0 = qb >= 8 ? qb - 8 : 0; const int ntile = qb - n0 + 1;
#pragma unroll
        for (int q = 0; q < 3; ++q) if (q < ntile) dma_kv64(Kg + (size_t)4096 * (n0 + q), Vg + (size_t)4096 * (n0 + q), 64, Kb + q * 8192, Vb + q * 8192, wid, lane);
        int i = 0;
        if (qb >= 8) {
            ring_wait(ntile - 1);
            if (3 < ntile) dma_kv64(Kg + (size_t)4096 * (n0 + 3), Vg + (size_t)4096 * (n0 + 3), 64, Kb + 3 * 8192, Vb + 3 * 8192, wid, lane);
            NSA_QK(0);
#pragma unroll
            for (int r = 0; r < 16; ++r) { const int kv = crow(r, hi); p0[r] = (kv > tl) ? p0[r] : -3.0e38f; p1[r] = (kv + 32 > tl) ? p1[r] : -3.0e38f; }
            softmax_pv64_fast(Vb, p0, p1, st, wsf, lane, r32, hi, true, SC);
            i = 1;
        }
        for (; i < ntile - 1; ++i) {
            ring_wait(ntile - 1 - i);
            if (i + 3 < ntile) { const int bo2 = ((i + 3) & 3) * 8192; dma_kv64(Kg + (size_t)4096 * (n0 + i + 3), Vg + (size_t)4096 * (n0 + i + 3), 64, Kb + bo2, Vb + bo2, wid, lane); }
            const int bo = (i & 3) * 8192; NSA_QK(bo);
            softmax_pv64_fast(Vb + bo, p0, p1, st, wsf, lane, r32, hi, true, SC);
        }
        {
            ring_wait(0);
            const int bo = ((ntile - 1) & 3) * 8192; NSA_QK(bo);
#pragma unroll
            for (int r = 0; r < 16; ++r) { const int kv = crow(r, hi); p0[r] = (kv <= tl) ? p0[r] : -3.0e38f; p1[r] = (kv + 32 <= tl) ? p1[r] : -3.0e38f; }
            softmax_pv64_fast(Vb + bo, p0, p1, st, wsf, lane, r32, hi, true, SC);
        }
        const float l = st.l + __shfl_xor(st.l, 32);
        NSA_FOLD(g2 / l);
    }
#undef NSA_FOLD
#undef NSA_QK
    LBAR();
#pragma unroll
    for (int q = 0; q < 4; ++q) asm volatile("" :: "v"(nzv[q]));
    if (nqb >= 0) {
        const int nkt2 = ((4 * nqb + 2) >> 6) + 1;
        for (int kt = 0; kt < nkt2; ++kt)
            dma_kv64(C.KVC() + ((size_t)bg * 256 + 64 * kt) * 64, C.KVC() + ((size_t)4096 + bg * 256 + 64 * kt) * 64, 64, Kb + kt * 8192, Vb + kt * 8192, wid, lane);
        const bf16* qp = C.PROJ() + PO_NQ + ((size_t)(b * 16 + head) * SEQ + 64 * nqb + tl) * 64 + 8 * hi;
#pragma unroll
        for (int d0 = 0; d0 < 4; ++d0) qpre[d0] = *(const bf16x8*)(qp + 16 * d0);
    }
    stg = accF;
    {
        const int tok = tid >> 3, seg = tid & 7;
        bf16* dst = C.MIX() + (row0 + tok) * DM + 1024 + g * 256 + seg * 32;
#pragma unroll
        for (int q = 0; q < 4; ++q) { const int qq = (q + (seg >> 1)) & 3;
            float z[8], o[8]; unpack8(nzv[q], z);
            const f32x4 a = *(const LAS f32x4*)(stg + tok * STG_PITCH + seg * 32 + 8 * qq), c = *(const LAS f32x4*)(stg + tok * STG_PITCH + seg * 32 + 8 * qq + 4);
            o[0] = a.x * z[0]; o[1] = a.y * z[1]; o[2] = a.z * z[2]; o[3] = a.w * z[3];
            o[4] = c.x * z[4]; o[5] = c.y * z[5]; o[6] = c.z * z[6]; o[7] = c.w * z[7];
            *(v4u*)(dst + 8 * qq) = pack8(o);
        }
    }
    LBAR();
}

DI void mlstm_delta_unit(const Ctx& C, LAS unsigned char* lds, int bh, int c) {
    int tid = C.tid(); asm volatile("" : "+v"(tid));
    const int lane = tid & 63, wid = __builtin_amdgcn_readfirstlane(tid >> 6), r32 = lane & 31, hi = lane >> 5;
    const int dkw = wid & 3, dvw = wid >> 2, b = bh >> 2, h = bh & 3;
    const size_t rowb = (size_t)b * SEQ + 256 * c;
    const float mend2 = C.mx2()[(size_t)bh * SEQ + 256 * c + 255];
    const float* u2p = C.u2() + (size_t)bh * SEQ + 256 * c;
    const bf16* Kg = C.KC() + ((size_t)bh * SEQ + 256 * c) * 256;
    const bf16* Vg = C.PROJ() + PO_MV + ((size_t)bh * SEQ + 256 * c) * 256;
    LAS float* u2l = (LAS float*)(lds + LDS_MISC + 2048);
    f32x16 acc[2][4];
#pragma unroll
    for (int a = 0; a < 2; ++a)
#pragma unroll
        for (int d = 0; d < 4; ++d)
#pragma unroll
            for (int r = 0; r < 16; ++r) acc[a][d][r] = 0.f;
    float nacc[2] = {0.f, 0.f};
    const unsigned voK_ = ((unsigned)(lane >> 2) * 256u + (lane & 3) * 8u) * 2u, voV_ = voK_;
#define MD_DMA(st, buf) do { const unsigned Kd_ = (unsigned)__builtin_amdgcn_readfirstlane(lds_u32(lds) + (buf) * 65536u + wid * 1024u), Vd_ = Kd_ + 32768u; \
        const bf16* kb_ = Kg + (size_t)(64 * (st) + 16 * (wid & 3)) * 256 + (wid >> 2) * 32; const bf16* vb_ = Vg + (size_t)(64 * (st) + 16 * (wid & 3)) * 256 + (wid >> 2) * 32; \
        glds16s<0>(kb_, voK_, Kd_); glds16s<0>(kb_ + 64, voK_, Kd_ + 8192u); glds16s<0>(kb_ + 128, voK_, Kd_ + 16384u); glds16s<0>(kb_ + 192, voK_, Kd_ + 24576u); \
        glds16s<0>(vb_, voV_, Vd_); glds16s<0>(vb_ + 64, voV_, Vd_ + 8192u); glds16s<0>(vb_ + 128, voV_, Vd_ + 16384u); glds16s<0>(vb_ + 192, voV_, Vd_ + 24576u); \
        if (wid == 0) glds16s<0>(u2p + 64 * (st), (unsigned)lane * 16u, (unsigned)__builtin_amdgcn_readfirstlane(lds_u32(u2l) + (buf) * 1024u)); } while (0)
    WAITBAR(0);
    MD_DMA(0, 0);
    const int vpn = ((lane >> 4) & 1) * 32 + (lane & 3) * 8 + (8 * hi + ((lane & 15) >> 2)) * 64;
    for (int st = 0; st < 4; ++st) {
        WAITBAR(0);
        if (st + 1 < 4) MD_DMA(st + 1, (st + 1) & 1);
        const LAS unsigned char* Kt = lds + (st & 1) * 65536; const LAS unsigned char* Vt = Kt + 32768;
        const LAS float* u2t = u2l + (st & 1) * 256;
#pragma unroll
        for (int ss = 0; ss < 4; ++ss) {
            const f32x4 ua = *(const LAS f32x4*)(u2t + 16 * ss + 8 * hi), ub = *(const LAS f32x4*)(u2t + 16 * ss + 8 * hi + 4);
            float w[8];
#pragma unroll
            for (int e = 0; e < 4; ++e) { w[e] = ex2(ua[e] - mend2); w[4 + e] = ex2(ub[e] - mend2); }
            bf16x8 af[2];
#pragma unroll
            for (int db = 0; db < 2; ++db) {
                const s16x4 lo = vtr(Kt + (2 * dkw + db) * 4096 + ss * 1024 + vpn), h4 = vtr(Kt + (2 * dkw + db) * 4096 + ss * 1024 + vpn + 256);
                float f[8];
#pragma unroll
                for (int e = 0; e < 4; ++e) { f[e] = bf2f((bf16)lo[e]) * w[e]; f[4 + e] = bf2f((bf16)h4[e]) * w[4 + e]; }
                nacc[db] += ((f[0] + f[1]) + (f[2] + f[3])) + ((f[4] + f[5]) + (f[6] + f[7]));
                af[db] = __builtin_bit_cast(bf16x8, pack8(f));
            }
#pragma unroll
            for (int dbv = 0; dbv < 4; ++dbv) {
                const s16x4 lo = vtr(Vt + (4 * dvw + dbv) * 4096 + ss * 1024 + vpn), h4 = vtr(Vt + (4 * dvw + dbv) * 4096 + ss * 1024 + vpn + 256);
                const bf16x8 vf = __builtin_shufflevector(lo, h4, 0, 1, 2, 3, 4, 5, 6, 7);
                acc[0][dbv] = MFMA32(vf, af[0], acc[0][dbv]); acc[1][dbv] = MFMA32(vf, af[1], acc[1][dbv]);
            }
            asm volatile("" ::: "memory");
        }
    }
#undef MD_DMA
    bf16* dsp = (bf16*)C.out + ((size_t)(bh * 16 + c) << 16);
#pragma unroll
    for (int db = 0; db < 2; ++db)
#pragma unroll
        for (int dbv = 0; dbv < 4; ++dbv)
#pragma unroll
            for (int p2 = 0; p2 < 2; ++p2) {
                unsigned a0 = pk2(acc[db][dbv][8 * p2], acc[db][dbv][8 * p2 + 1]), a1 = pk2(acc[db][dbv][8 * p2 + 2], acc[db][dbv][8 * p2 + 3]);
                unsigned b0 = pk2(acc[db][dbv][8 * p2 + 4], acc[db][dbv][8 * p2 + 5]), b1 = pk2(acc[db][dbv][8 * p2 + 6], acc[db][dbv][8 * p2 + 7]);
                { const auto r0 = __builtin_amdgcn_permlane32_swap(a0, b0, false, false); a0 = r0[0]; b0 = r0[1]; const auto r1 = __builtin_amdgcn_permlane32_swap(a1, b1, false, false); a1 = r1[0]; b1 = r1[1]; }
                v4u w; w.x = a0; w.y = a1; w.z = b0; w.w = b1;
                *(v4u*)(dsp + (size_t)(32 * (2 * dkw + db) + r32) * 256 + 32 * (4 * dvw + dbv) + 16 * p2 + 8 * hi) = w; }
#pragma unroll
    for (int db = 0; db < 2; ++db) { const float n = nacc[db] + __shfl_xor(nacc[db], 32); if (dvw == 0 && hi == 0) C.DN()[(size_t)(bh * 16 + c) * 256 + 32 * (2 * dkw + db) + r32] = n; }
    WAITBAR(0);
}
DI void mlstm_scan(const Ctx& C) {
    int tid = C.tid(); asm volatile("" : "+v"(tid));
    const int gt = C.vcu * NTHREADS + tid, NGT = C.G * NTHREADS;
    for (int it = 0; ; ++it) {
        bool isn; int bh; size_t off;
        if (C.G == 256) {
            if (it == 0) { isn = false; bh = gt >> 13; off = (size_t)(gt & 8191) * 8; }
            else if (it == 1 && tid < 2) { isn = true; bh = C.vcu >> 4; off = (size_t)((C.vcu & 15) * 2 + tid) * 8; }
            else break;
        } else { const int e8 = gt + it * NGT; if (e8 >= 16 * 8192 + 512) break;
            isn = e8 >= 16 * 8192; bh = isn ? ((e8 - 16 * 8192) >> 5) : (e8 >> 13); off = isn ? (size_t)((e8 - 16 * 8192) & 31) * 8 : (size_t)(e8 & 8191) * 8; }
        f32x4 ld[15][2];
        if (isn) { const float* src = C.DN() + (size_t)bh * 16 * 256 + off;
#pragma unroll
            for (int c = 0; c < 15; ++c) { ld[c][0] = *(const f32x4*)(src + c * 256); ld[c][1] = *(const f32x4*)(src + c * 256 + 4); } }
        else { const bf16* src = (const bf16*)C.out + ((size_t)bh * 16 << 16) + off;
#pragma unroll
            for (int c = 0; c < 15; ++c) { float f[8]; unpack8(*(const v4u*)(src + (size_t)c * 65536), f); ld[c][0] = (f32x4){f[0], f[1], f[2], f[3]}; ld[c][1] = (f32x4){f[4], f[5], f[6], f[7]}; } }
        float mr[16]; mr[0] = 0.f;
#pragma unroll
        for (int c = 1; c < 16; ++c) mr[c] = C.mx2()[(size_t)bh * SEQ + 256 * c - 1];
        f32x4 s0 = {0.f, 0.f, 0.f, 0.f}, s1 = {0.f, 0.f, 0.f, 0.f};
#pragma unroll
        for (int c = 0; c < 15; ++c) {
            const float d = ex2(mr[c] - mr[c + 1]);
            s0 = s0 * d + ld[c][0]; s1 = s1 * d + ld[c][1];
            if (isn) { float* dst = C.NS() + (size_t)(bh * 16 + c + 1) * 256 + off; *(f32x4*)dst = s0; *(f32x4*)(dst + 4) = s1; }
            else { v4u w; w.x = pk2(s0[0], s0[1]); w.y = pk2(s0[2], s0[3]); w.z = pk2(s1[0], s1[1]); w.w = pk2(s1[2], s1[3]);
                   *(v4u*)(C.SB() + ((size_t)(bh * 16 + c + 1) << 16) + off) = w; }
        }
    }
}
DI void mlstm_out_unit(const Ctx& C, LAS unsigned char* lds, int b, int h, int iq) {
    int tid = C.tid(); asm volatile("" : "+v"(tid));
    const int lane = tid & 63, wid = __builtin_amdgcn_readfirstlane(tid >> 6), r32 = lane & 31, hi = lane >> 5;
    const int rg = wid & 3, dvh = wid >> 2, bh = b * 4 + h, c = iq >> 1;
    const int ql = 32 * rg + r32, qabs = 128 * iq + ql;
    const size_t rowb = (size_t)b * SEQ;
    LAS float* wsf = (LAS float*)(lds + LDS_MISC) + wid * 64;
    LAS float* u2l = (LAS float*)(lds + LDS_MISC + 2048);
    LAS float* nl = (LAS float*)(lds + LDS_MISC + 5120);
    LAS float* stg = (LAS float*)lds;
    const float* u2p = C.u2() + (size_t)bh * SEQ;
    f32x16 o[4];
#pragma unroll
    for (int d = 0; d < 4; ++d)
#pragma unroll
        for (int r = 0; r < 16; ++r) o[d][r] = 0.f;
    float den = 0.f, den_i = 0.f;
    const int nintra = 2 * (iq & 1) + 2, tt0 = 4 * c;
    const bf16* Kg = C.KC() + (size_t)bh * SEQ * 256;
    const bf16* Vg = C.PROJ() + PO_MV + (size_t)bh * SEQ * 256;
    const bf16* Sg = C.SB() + ((size_t)(bh * 16 + c) << 16);
    const float* ng = C.NS() + (size_t)(bh * 16 + c) * 256;
    const unsigned voK_ = (unsigned)lane * 512u, voS_ = ((unsigned)(lane >> 2) * 256u + (lane & 3) * 8u) * 2u, voV_ = voS_;
#define ML_K(tt, R) do { const unsigned Kd_ = (unsigned)__builtin_amdgcn_readfirstlane(lds_u32(lds) + (R) * 32768u + wid * 1024u); const bf16* kb_ = Kg + (size_t)(64 * (tt)) * 256 + wid * 8; \
        glds16s<0>(kb_, voK_, Kd_); glds16s<0>(kb_ + 64, voK_, Kd_ + 8192u); glds16s<0>(kb_ + 128, voK_, Kd_ + 16384u); glds16s<0>(kb_ + 192, voK_, Kd_ + 24576u); } while (0)
#define ML_V(tt, R) do { const unsigned Vd_ = (unsigned)__builtin_amdgcn_readfirstlane(lds_u32(lds) + (R) * 32768u + wid * 1024u); const bf16* vb_ = Vg + (size_t)(64 * (tt) + 16 * (wid & 3)) * 256 + (wid >> 2) * 32; \
        glds16s<0>(vb_, voV_, Vd_); glds16s<0>(vb_ + 64, voV_, Vd_ + 8192u); glds16s<0>(vb_ + 128, voV_, Vd_ + 16384u); glds16s<0>(vb_ + 192, voV_, Vd_ + 24576u); } while (0)
#define ML_S(sl, R) do { const unsigned Vd_ = (unsigned)__builtin_amdgcn_readfirstlane(lds_u32(lds) + (R) * 32768u + wid * 1024u); const bf16* sb_ = Sg + (size_t)(64 * (sl) + 16 * (wid & 3)) * 256 + (wid >> 2) * 32; \
        glds16s<0>(sb_, voS_, Vd_); glds16s<0>(sb_ + 64, voS_, Vd_ + 8192u); glds16s<0>(sb_ + 128, voS_, Vd_ + 16384u); glds16s<0>(sb_ + 192, voS_, Vd_ + 24576u); } while (0)
    LAS float* gnl = (LAS float*)(lds + LDS_MISC + 6144);
    if (wid == 0) glds16s<0>(u2p + 256 * c, (unsigned)lane * 16u, (unsigned)__builtin_amdgcn_readfirstlane(lds_u32(u2l)));
    if (wid == 2) glds16s<0>(C.m_norm_g + h * 256, (unsigned)lane * 16u, (unsigned)__builtin_amdgcn_readfirstlane(lds_u32(gnl)));
    if (c >= 1) {
        if (wid == 1) glds16s<0>(ng, (unsigned)lane * 16u, (unsigned)__builtin_amdgcn_readfirstlane(lds_u32(nl)));
        ML_S(0, 0); ML_S(1, 1); ML_S(2, 2); ML_S(3, 3);
    } else {
        ML_K(tt0, 0); ML_V(tt0, 1); ML_K(tt0 + 1, 2);
    }
    bf16x8 qf[16];
    { const bf16* qp = C.QC() + ((size_t)bh * SEQ + qabs) * 256 + 8 * hi;
#pragma unroll
      for (int ks = 0; ks < 16; ++ks) qf[ks] = *(const bf16x8*)(qp + 16 * ks); }
    const float mx2 = C.mx2()[(size_t)bh * SEQ + qabs];
    const float mref2 = (c >= 1) ? C.mx2()[(size_t)bh * SEQ + 256 * c - 1] : 0.f;
#define ML_USEQ() do { _Pragma("unroll") for (int ks = 0; ks < 16; ++ks) asm volatile("" :: "v"(qf[ks])); asm volatile("" :: "v"(mx2), "v"(mref2)); } while (0)
    if (c >= 1) {
        const int vpn = ((lane >> 4) & 1) * 32 + (lane & 3) * 8 + (8 * hi + ((lane & 15) >> 2)) * 64;
#pragma unroll
        for (int k = 0; k < 4; ++k) {
            if (k == 0) { WAITBAR(12); ML_USEQ(); } else WAITBAR(8);
            if (k == 1) ML_K(tt0, 0); else if (k == 2) ML_V(tt0, 1); else if (k == 3) ML_K(tt0 + 1, 2);
            const LAS unsigned char* Vt = lds + k * 32768 + (4 * dvh) * 4096 + vpn;
#pragma unroll
            for (int s = 0; s < 4; ++s)
#pragma unroll
                for (int db = 0; db < 4; ++db) {
                    const s16x4 lo = vtr(Vt + db * 4096 + s * 1024), h4 = vtr(Vt + db * 4096 + s * 1024 + 256);
                    const bf16x8 sf = __builtin_shufflevector(lo, h4, 0, 1, 2, 3, 4, 5, 6, 7);
                    o[db] = MFMA32(qf[4 * k + s], sf, o[db]);
                    if (db == 3) asm volatile("" ::: "memory");
                }
        }
        float dq = 0.f;
#pragma unroll
        for (int ks = 0; ks < 16; ++ks) { float qv[8]; unpack8(__builtin_bit_cast(v4u, qf[ks]), qv);
            const f32x4 na = *(const LAS f32x4*)(nl + 16 * ks + 8 * hi), nb = *(const LAS f32x4*)(nl + 16 * ks + 8 * hi + 4);
            dq += ((qv[0] * na[0] + qv[1] * na[1]) + (qv[2] * na[2] + qv[3] * na[3])) + ((qv[4] * nb[0] + qv[5] * nb[1]) + (qv[6] * nb[2] + qv[7] * nb[3])); }
        dq += __shfl_xor(dq, 32);
        const float fq = ex2(mref2 - mx2);
        den_i = fq * dq;
        if (hi == 0) wsf[r32] = fq;
        __builtin_amdgcn_fence(__ATOMIC_RELEASE, "wavefront"); __builtin_amdgcn_wave_barrier(); __builtin_amdgcn_fence(__ATOMIC_ACQUIRE, "wavefront");
#pragma unroll
        for (int k4 = 0; k4 < 4; ++k4) { const f32x4 a = *(const LAS f32x4*)(wsf + 8 * k4 + 4 * hi);
#pragma unroll
            for (int e = 0; e < 4; ++e)
#pragma unroll
                for (int db = 0; db < 4; ++db) o[db][4 * k4 + e] *= a[e]; }
        __builtin_amdgcn_fence(__ATOMIC_RELEASE, "wavefront"); __builtin_amdgcn_wave_barrier(); __builtin_amdgcn_fence(__ATOMIC_ACQUIRE, "wavefront");
    }
    for (int i = 0; i < nintra; ++i) {
        const int tt = tt0 + i;
        if (i == 0) { WAITBAR(4); if (c == 0) ML_USEQ(); ML_V(tt0 + 1, 3); }
        else { WAITBAR(0); if (i + 1 < nintra) { ML_K(tt + 1, 2 * ((i + 1) & 1)); ML_V(tt + 1, 2 * ((i + 1) & 1) + 1); } }
        const LAS unsigned char* Kt = lds + (i & 1) * 65536; const LAS unsigned char* Vt = Kt + 32768;
        const LAS float* u2t = u2l + 64 * i;
        const int kv0 = 64 * tt - 128 * iq;
        if (kv0 > 32 * rg + 31) continue;
        const int lim = ql - kv0;
        const LAS unsigned char* vp = Vt + (4 * dvh) * 4096 + ((lane >> 4) & 1) * 32 + (lane & 3) * 8 + (4 * hi + ((lane & 15) >> 2)) * 64;
#pragma unroll
        for (int hf = 0; hf < 2; ++hf) {
            f32x16 p;
#pragma unroll
            for (int r = 0; r < 16; ++r) p[r] = 0.f;
            { const LAS unsigned char* kb = Kt + hi * 1024 + r32 * 16 + hf * 512;
#pragma unroll
              for (int ks = 0; ks < 16; ++ks) { const bf16x8 b0 = *(const LAS bf16x8*)(kb + ks * 2048); p = MFMA32(b0, qf[ks], p); } }
            float ps = 0.f;
#pragma unroll
            for (int k4 = 0; k4 < 4; ++k4) {
                const f32x4 ua = *(const LAS f32x4*)(u2t + 32 * hf + 8 * k4 + 4 * hi);
#pragma unroll
                for (int e = 0; e < 4; ++e) { const int r = 4 * k4 + e, kv = 32 * hf + 8 * k4 + 4 * hi + e;
                    const float wa = (kv <= lim) ? ex2(ua[e] - mx2) * p[r] : 0.f; p[r] = wa; ps += wa; }
            }
            den += ps;
            const bf16x8 pa0 = pack_p(p, 0), pa1 = pack_p(p, 1);
#pragma unroll
            for (int db = 0; db < 4; ++db) {
#pragma unroll
                for (int s = 0; s < 2; ++s) {
                    const s16x4 lo = vtr(vp + db * 4096 + (2 * hf + s) * 1024), hh = vtr(vp + db * 4096 + (2 * hf + s) * 1024 + 512);
                    const bf16x8 vf = __builtin_shufflevector(lo, hh, 0, 1, 2, 3, 4, 5, 6, 7);
                    o[db] = MFMA32(s == 0 ? pa0 : pa1, vf, o[db]);
                }
            }
        }
    }
#undef ML_K
#undef ML_V
#undef ML_S
#undef ML_USEQ
    const int erow = tid >> 2, eseg = tid & 3;
    const size_t grow = rowb + 128 * iq + erow;
    v4u mgv[8];
    { const bf16* mg = C.PROJ() + PO_MG + ((size_t)bh * SEQ + 128 * iq + erow) * 256 + eseg * 64;
#pragma unroll
      for (int q = 0; q < 8; ++q) mgv[q] = *(const v4u*)(mg + 8 * ((q + 2 * eseg) & 7)); }
    const LAS float* gn = gnl + eseg * 64;
    den += __shfl_xor(den, 32);
    den += den_i;
    const float f = 1.f / fmaxf(fabsf(den), 1.f);
    if (hi == 0) wsf[r32] = f;
    __builtin_amdgcn_fence(__ATOMIC_RELEASE, "wavefront"); __builtin_amdgcn_wave_barrier(); __builtin_amdgcn_fence(__ATOMIC_ACQUIRE, "wavefront");
    float fr[16];
#pragma unroll
    for (int k4 = 0; k4 < 4; ++k4) { const f32x4 a = *(const LAS f32x4*)(wsf + 8 * k4 + 4 * hi); fr[4 * k4] = a.x; fr[4 * k4 + 1] = a.y; fr[4 * k4 + 2] = a.z; fr[4 * k4 + 3] = a.w; }
    LBAR();
#pragma unroll
    for (int db = 0; db < 4; ++db)
#pragma unroll
        for (int r = 0; r < 16; ++r) stg[(32 * rg + crow(r, hi)) * STG_PITCH + 128 * dvh + 32 * db + r32] = o[db][r] * fr[r];
    LBAR();
    {
        const LAS float* sp = stg + erow * STG_PITCH + eseg * 64;
        f32x4 hvv[16];
#pragma unroll
        for (int q = 0; q < 16; ++q) hvv[q] = *(const LAS f32x4*)(sp + 4 * ((q + 4 * eseg) & 15));
        float s1 = 0.f;
#pragma unroll
        for (int q = 0; q < 16; ++q) s1 += (hvv[q].x + hvv[q].y) + (hvv[q].z + hvv[q].w);
        s1 += __shfl_xor(s1, 1); s1 += __shfl_xor(s1, 2);
        const float mu = s1 * (1.f / 256.f);
        float s2 = 0.f;
#pragma unroll
        for (int q = 0; q < 16; ++q) { const float d0 = hvv[q].x - mu, d1 = hvv[q].y - mu, d2 = hvv[q].z - mu, d3 = hvv[q].w - mu; s2 += (d0 * d0 + d1 * d1) + (d2 * d2 + d3 * d3); }
        s2 += __shfl_xor(s2, 1); s2 += __shfl_xor(s2, 2);
        const float rstd = 1.f / sqrtf(s2 * (1.f / 256.f) + EPSV);
        bf16* dst = C.MIX() + grow * DM + h * 256 + eseg * 64;
#pragma unroll
        for (int q = 0; q < 8; ++q) { const int qq = (q + 2 * eseg) & 7;
            float vg[8], y[8]; unpack8(mgv[q], vg);
            const f32x4 a = hvv[2 * q], cc = hvv[2 * q + 1];
            const f32x4 ga = *(const LAS f32x4*)(gn + 8 * qq), gc = *(const LAS f32x4*)(gn + 8 * qq + 4);
            const float hv[8] = {a.x, a.y, a.z, a.w, cc.x, cc.y, cc.z, cc.w}, gg[8] = {ga.x, ga.y, ga.z, ga.w, gc.x, gc.y, gc.z, gc.w};
#pragma unroll
            for (int e = 0; e < 8; ++e) y[e] = (hv[e] - mu) * rstd * gg[e] * vg[e];
            *(v4u*)(dst + 8 * qq) = pack8(y);
        }
    }
    LBAR();
}

struct Args { const void* in[21]; float* out; unsigned char* ws; };
__global__ void __launch_bounds__(NTHREADS, 2) mega_fwd(Args a) {
    extern __shared__ __attribute__((aligned(16))) unsigned char lds_raw[];
    LAS unsigned char* lds = (LAS unsigned char*)lds_raw;
    cg::grid_group grid = cg::this_grid();
    Ctx C;
    C.x = (const float*)a.in[0]; C.p = (const float*)a.in[1]; C.positions = (const int*)a.in[2]; C.norm_g = (const float*)a.in[3]; C.w_in = (const float*)a.in[4];
    C.conv_w = (const float*)a.in[5]; C.conv_b = (const float*)a.in[6]; C.b_ig = (const float*)a.in[7]; C.b_fg = (const float*)a.in[8]; C.m_norm_g = (const float*)a.in[9];
    C.pos_k = (const float*)a.in[10]; C.pos_v = (const float*)a.in[11]; C.ck_w1 = (const float*)a.in[12]; C.ck_w2 = (const float*)a.in[13]; C.cv_w1 = (const float*)a.in[14]; C.cv_w2 = (const float*)a.in[15];
    C.w_out = (const float*)a.in[16]; C.gate_w = (const float*)a.in[17]; C.ple_w = (const float*)a.in[18]; C.ple_g = (const float*)a.in[19]; C.final_g = (const float*)a.in[20];
    C.out = a.out; C.ws = a.ws;
    unsigned char* ws = a.ws;
    if (threadIdx.x < 8) ((volatile LAS unsigned*)(lds + LDS_MISC + 4096))[threadIdx.x] = 0u;
    __syncthreads();
    C.wbase = (int)__builtin_amdgcn_readfirstlane((int)threadIdx.x) & ~63;
    XcdBarrier bar = xcd_barrier_post((unsigned*)ws, (volatile LAS unsigned*)(lds + LDS_MISC + 4096), C.tid() == 0);
#define GSYNC() xcd_barrier(bar, C.tid() == 0)
    C.G = gridDim.x; { const int bx = blockIdx.x; C.vcu = (C.G % 8 == 0) ? (bx % 8) * (C.G / 8) + bx / 8 : bx; }

#ifndef PROBE_SEL
#define PROBE_SEL 0
#endif
#if PROBE_SEL
    unsigned long long ts_[12]; int nts_ = 0;
#define STAMP() do { ts_[nts_++] = __builtin_amdgcn_s_memrealtime(); } while (0)
#else
#define STAMP() do { } while (0)
#endif
    STAMP();
#ifndef PHMASK
#define PHMASK 0xffff
#endif
#if PHMASK & 1
    phase0(C, lds);
#endif
    if (a.ws == nullptr) grid.sync();
    if (C.tid() == 0) __hip_atomic_fetch_or((unsigned*)(ws + 16384) + 64 * ((int)blockIdx.x & 7) + 40, 1u << xb_xcc_id(), __ATOMIC_RELAXED, __HIP_MEMORY_SCOPE_AGENT);
    GSYNC(); STAMP();
    bool loc_ok;
    { unsigned all = 0u, okb = (C.G == 256) ? 1u : 0u;
      for (int k = 0; k < 8; ++k) { const unsigned mk = xb_ld((unsigned*)(ws + 16384) + 64 * k + 40); okb &= (__builtin_popcount(mk) == 1) ? 1u : 0u; all |= mk; }
      okb &= (__builtin_popcount(all) == 8) ? 1u : 0u;
      loc_ok = __builtin_amdgcn_readfirstlane((int)okb) != 0; }
#define LSYNC() do { if (loc_ok) xcd_barrier_local(bar, C.tid() == 0); else xcd_barrier(bar, C.tid() == 0); } while (0)
#if PHMASK & 2
    { pg8::Gemm g{C.XN(), C.WinT(), NT, DINP, DM, DM, DM};
      EpiProj E{C.PROJ(), C.gates(), C.rope()};
      const int bx = (int)blockIdx.x;
      if (C.G == 256) {
          if (bx & 1) {
              P1Order S0; S0.init(bx, 0); pg8::Unit u0; S0.next(0, u0);
              float* part = (float*)(C.ws + WS_MIX) + (size_t)(bx >> 1) * 65536;
              int kh = DM / 2; asm volatile("" : "+s"(kh));
              pg8::Gemm gh{C.XN(), C.WinT(), NT, DINP, kh, DM, DM};
              { HalfUnit H{u0.pm, u0.pn, 0, nullptr}; EpiPartSave EP{part}; pg8::gemm_phase<EpiPartSave, HalfUnit, true, true>(lds, gh, H, EP, C.tid()); }
              { P1Order S; S.init(bx, 1); pg8::gemm_phase<EpiProj, P1Order, true, true>(lds, g, S, E, C.tid()); }
              { HalfUnit H{u0.pm, u0.pn, 1, part}; pg8::gemm_phase<EpiProj, HalfUnit, true, true>(lds, gh, H, E, C.tid()); }
          } else {
              P1Order S; S.init(bx, 0);
              pg8::gemm_phase<EpiProj, P1Order, true, true>(lds, g, S, E, C.tid());
              if ((bx >> 3) >= 16) late_weights(C, lds, ((bx >> 3) - 16) * 4 + ((bx & 7) >> 1), 64);
          }
      } else {
          pg8::StaticOrder S; S.init(NT, DINP, C.G, bx);
          pg8::gemm_phase<EpiProj, pg8::StaticOrder, true, true>(lds, g, S, E, C.tid());
          late_weights(C, lds, bx, C.G);
      }
    }
#endif
    GSYNC(); STAMP();
#if PHMASK & 4
    phase2(C, lds);
#endif
    LSYNC(); STAMP();
#if PHMASK & 8
    { int kc = 256; asm volatile("" : "+s"(kc)); pg8::Gemm g{C.PROJ() + PO_KV6, C.Wc1T(), 8192, 256, kc, DM, 1024}; CmpOrder S; S.init(C.G, (int)blockIdx.x);
      EpiCmpPart E{C.HIDP()};
      pg8::gemm_phase<EpiCmpPart, CmpOrder, true, true>(lds, g, S, E, C.tid()); }
#endif
#if PHMASK & 32
    for (int v = C.vcu; v < 256; v += C.G) mlstm_delta_unit(C, lds, v >> 4, v & 15);
#endif
    LSYNC(); STAMP();
#if PHMASK & 32
    mlstm_scan(C);
#endif
#if PHMASK & 16
    phase3b(C, lds);
#endif
    LSYNC(); STAMP();
    for (int v = C.vcu; v < 256; v += C.G) {
        const int bg = v >> 4, s = v & 15, b = bg >> 2, gh = bg & 3;
#if PROBE_SEL == 7
        unsigned long long tm0 = __builtin_amdgcn_s_memrealtime();
#endif
        for (int ph = 0; ph < 2; ++ph) {
            if ((ph == 0) != ((v & 1) != 0)) {
#if PHMASK & 32
                for (int k = 0; k < 2; ++k) mlstm_out_unit(C, lds, b, gh, 2 * s + k);
#endif
            } else {
#if PHMASK & 64
                { bf16x8 qpre[4];
#pragma unroll
                  for (int d0 = 0; d0 < 4; ++d0) qpre[d0] = __builtin_bit_cast(bf16x8, (v4u){0u, 0u, 0u, 0u});
                  const unsigned quad = __builtin_amdgcn_readfirstlane((s == 0 ? 0x0910243fu : (s == 1 ? 0x0c161d3eu : (s == 2 ? 0x000e3a3du : (s == 3 ? 0x040a373cu : (s == 4 ? 0x1215183bu : (s == 5 ? 0x11141c39u : (s == 6 ? 0x06172938u : (s == 7 ? 0x02232636u : (s == 8 ? 0x01193335u : (s == 9 ? 0x051e2734u : (s == 10 ? 0x03202a32u : (s == 11 ? 0x081b2831u : (s == 12 ? 0x0d132c30u : (s == 13 ? 0x0722252fu : (s == 14 ? 0x0f1f212eu : (s == 15 ? 0x0b1a2b2du : 0u)))))))))))))))));
                  for (int k = 0; k < 4; ++k) { const int qbk = (int)((quad >> (8 * k)) & 0xffu), nqb = k < 3 ? (int)((quad >> (8 * k + 8)) & 0xffu) : -1;
                      nsa_unit(C, lds, b, gh, qbk, nqb, qpre, k > 0); } }
#endif
            }
        }
#if PROBE_SEL == 7
        unsigned long long tm2 = __builtin_amdgcn_s_memrealtime();
        ts_[8] = 0; ts_[9] = tm2 - tm1; ts_[4] = 0; ts_[5] = tm1 - tm0;
#endif
    }
    GSYNC(); STAMP();
    for (int ph = 0; ph < 2; ++ph) {
        if ((ph == 0) != ((blockIdx.x & 1) != 0)) {
#if PHMASK & 128
            pg8::Gemm g{C.MIX(), C.WoutT(), NT, DM, DM, DM, DM}; P5Order S; S.init(NT, DM, C.G, (int)blockIdx.x);
            EpiX1 E{C.x, C.X1B()};
            pg8::gemm_phase<EpiX1, P5Order, true, true>(lds, g, S, E, C.tid());
#endif
        } else {
#if PHMASK & 256
            int kple = PLE; asm volatile("" : "+s"(kple)); pg8::Gemm g{C.PB(), C.WpleT(), NT, DM, kple, PLE, PLE}; P5Order S; S.init(NT, DM, C.G, (int)blockIdx.x);
            EpiPl E{C.PL(), C.plss()};
            pg8::gemm_phase<EpiPl, P5Order, true, true>(lds, g, S, E, C.tid());
#endif
        }
    }
    LSYNC(); STAMP();
#if PHMASK & 512
    for (int rnd = 1; rnd >= 0; --rnd) {
        pg8::Gemm g{C.X1B(), C.WgateT(), NT, DM, DM, DM, DM}; OneUnit S{32 * rnd + 4 * ((int)blockIdx.x & 7) + (((int)blockIdx.x >> 3) & 3), (int)blockIdx.x >> 5};
        EpiGateNorm E{C.out, C.X1B(), C.PL(), C.plss(), C.ple_g, C.final_g, (unsigned*)C.x2ss(), (unsigned*)(C.ws + 16384), lds};
        pg8::gemm_phase<EpiGateNorm, OneUnit, true, true>(lds, g, S, E, C.tid());
    }
#endif
    STAMP(); STAMP();
#if PROBE_SEL
    STAMP();
    __syncthreads();
#if PROBE_SEL == 6
    unsigned long long tq0 = __builtin_amdgcn_s_memrealtime();
    grid.sync(); grid.sync(); grid.sync(); grid.sync();
    unsigned long long tq1 = __builtin_amdgcn_s_memrealtime();
    ts_[8] = tq0; ts_[9] = tq1;
#endif
    if (blockIdx.x == 0) {
        float t1, t2; float sc1 = 0.01f, sc2 = 0.005f;
        if (PROBE_SEL == 1) { t1 = (float)(ts_[2] - ts_[1]); t2 = (float)(ts_[6] - ts_[5]); }
        else if (PROBE_SEL == 2) { t1 = (float)(ts_[7] - ts_[6]); t2 = (float)(ts_[8] - ts_[7]); }
        else if (PROBE_SEL == 3) { t1 = (float)(ts_[1] - ts_[0]); t2 = (float)(ts_[5] - ts_[2]); }
        else if (PROBE_SEL == 4) { t1 = (float)(ts_[3] - ts_[2]); t2 = (float)(ts_[4] - ts_[3]); sc1 = 0.1f; sc2 = 0.025f; }
        else if (PROBE_SEL == 8) { t1 = (float)(ts_[9] - ts_[0]); t2 = 0.f; sc1 = 0.001f; sc2 = 0.01f; }
        else if (PROBE_SEL == 7) { t1 = (float)(ts_[9] - ts_[8]); t2 = (float)(ts_[5] - ts_[4]); sc1 = 0.01f; sc2 = 0.005f; }
        else { t1 = (float)(ts_[9] - ts_[8]); t2 = (float)(ts_[5] - ts_[4]); sc1 = 0.1f; sc2 = 0.025f; }
        const float d1 = t1 * 0.01f * sc1;
        const float d2 = t2 * 0.01f * sc2;
        if (C.tid() == 0) C.out[0] += d1;
        for (int i = C.tid(); i < DM; i += NTHREADS) C.out[DM + i] += d2;
    }
#endif
}

extern "C" void kernel_launch(void* const* d_in, const int* in_sizes, int n_in, void* d_out, int out_size, void* d_ws, size_t ws_size, hipStream_t stream) {
    static int grid = 0;
    if (grid == 0) {
        if (n_in != 21 || in_sizes[0] != NT * DM || out_size != NT * DM || ws_size < WS_END) {
            fprintf(stderr, "kernel_launch: unexpected problem (n_in %d, in0 %d, out %d, ws %zu); nothing launched\n", n_in, n_in > 0 ? in_sizes[0] : -1, out_size, ws_size); grid = -1; return; }
        int dev = 0, cus = 0, per_cu = 0;
        if (hipGetDevice(&dev) != hipSuccess || hipDeviceGetAttribute(&cus, hipDeviceAttributeMultiprocessorCount, dev) != hipSuccess) { grid = -1; return; }
        if (hipFuncSetAttribute((const void*)mega_fwd, hipFuncAttributeMaxDynamicSharedMemorySize, LDS_BYTES) != hipSuccess) { fprintf(stderr, "kernel_launch: hipFuncSetAttribute failed\n"); grid = -1; return; }
        if (hipOccupancyMaxActiveBlocksPerMultiprocessor(&per_cu, (const void*)mega_fwd, NTHREADS, LDS_BYTES) != hipSuccess || per_cu < 1) {
            fprintf(stderr, "kernel_launch: occupancy query says %d blocks/CU; nothing launched\n", per_cu); grid = -1; return; }
        grid = cus * 1;
        if (grid != 256) { fprintf(stderr, "kernel_launch: built for 256 CUs (got %d); nothing launched\n", cus); grid = -1; return; }
    }
    if (grid < 0) return;
    if (hipMemsetAsync(d_ws, 0, 32768 + (size_t)NT * 4, stream) != hipSuccess) { fprintf(stderr, "kernel_launch: memset failed\n"); return; }
    Args a{};
    for (int i = 0; i < 21; ++i) a.in[i] = d_in[i];
    a.out = (float*)d_out; a.ws = (unsigned char*)d_ws;
    void* args[] = {&a};
    hipError_t e = hipLaunchCooperativeKernel((const void*)mega_fwd, dim3(grid), dim3(NTHREADS), args, LDS_BYTES, stream);
    if (e != hipSuccess) fprintf(stderr, "cooperative launch failed: %s (grid %d)\n", hipGetErrorString(e), grid);
}
```

```cpp
#include <hip/hip_runtime.h>
#include <hip/hip_cooperative_groups.h>
#include <cstdio>
#include <cstdint>
namespace cg = cooperative_groups;

namespace pg8 {
#define PG8_LAS __attribute__((address_space(3)))
typedef unsigned short bf16_t;
typedef short bf16x8 __attribute__((ext_vector_type(8)));
typedef float f32x4 __attribute__((ext_vector_type(4)));
typedef unsigned u32x4 __attribute__((ext_vector_type(4)));
constexpr int BM = 256, BK = 64, HALF = 128, HTB = HALF * BK * 2, STAGE_BYTES = 8 * HTB, NXCD = 8, WGM = 4;

__host__ __device__ __forceinline__ int lds_byte(int r, int c) { const int st = (r >> 4) * 2 + (c >> 5), rr = r & 15, cc = c & 31, ob = rr * 64 + cc * 2; return st * 1024 + (ob ^ (((ob >> 9) & 1) << 5)); }
__host__ __device__ __forceinline__ void stage_rc(int b, int& R, int& C) { const int st = b / 1024, sb = b % 1024, swz = sb ^ (((sb >> 9) & 1) << 5); R = (st >> 1) * 16 + swz / 64; C = (st & 1) * 32 + (swz % 64) / 2; }
__host__ __device__ __forceinline__ int perm32(int rho) { const int n = rho >> 4, i = rho & 15; return 8 * (i >> 2) + 4 * n + (i & 3); }

struct Unit { int pm, pn, ks; };
struct Gemm { const bf16_t* A; const bf16_t* Bt; int M, N, K, ld, lda; };

struct SplitKOrder {
    int nM, nwg, G, c;
    __host__ __device__ void init(int M, int nsplit, int G_, int c_) { nM = M / BM; nwg = nM * nsplit; G = G_; c = c_; }
    __host__ __device__ bool next(int i, Unit& u) const { const long L = (long)i * G + c; if (L >= nwg) return false; u.pm = (int)(L % nM); u.pn = 0; u.ks = (int)(L / nM); return true; }
    __device__ __forceinline__ size_t aoff(const Unit& u, const Gemm& g) const { return (size_t)u.pm * BM * (size_t)g.lda * 2 + (size_t)u.ks * g.K * 2; }
    __device__ __forceinline__ void a_ready(const Unit&) const {}
    __device__ __forceinline__ void done(const Unit&) const {}
    template <class A> __device__ __forceinline__ void preload(A&, int) const {}
};
struct StaticOrder {
    int nM, nN, nwg, G, c, wgm, i0;
    __host__ __device__ void init(int M, int N, int G_, int c_, int wgm_ = WGM, int i0_ = 0) { nM = M / BM; nN = N / BM; nwg = nM * nN; G = G_; c = c_; wgm = wgm_; i0 = i0_; }
    __host__ __device__ __forceinline__ bool next(int i, Unit& u) const {
        const long L = (long)(i + i0) * G + c; if (L >= nwg) return false;
        int wgid = (int)L; { const int q = nwg / NXCD, r = nwg % NXCD, xcd = wgid % NXCD, off = wgid / NXCD; wgid = (xcd < r ? xcd * (q + 1) : r * (q + 1) + (xcd - r) * q) + off; }
        const int nig = wgm * nN, gid = wgid / nig, fm = gid * wgm, gsz = (nM - fm) < wgm ? (nM - fm) : wgm;
        u.pm = fm + ((wgid % nig) % gsz); u.pn = (wgid % nig) / gsz; u.ks = 0; return true;
    }
    __device__ __forceinline__ size_t aoff(const Unit& u, const Gemm& g) const { return (size_t)u.pm * BM * (size_t)g.lda * 2; }
    __device__ __forceinline__ void a_ready(const Unit&) const {}
    __device__ __forceinline__ void done(const Unit&) const {}
    template <class A> __device__ __forceinline__ void preload(A&, int) const {}
};

template <class Epi, class Sched, bool ALIGN_EPI = false, bool SP2 = false>
__device__ __forceinline__ void gemm_phase(PG8_LAS unsigned char* lds, const Gemm g, const Sched& S, const Epi& E, int tid_in) {
    int tid = tid_in; asm volatile("" : "+v"(tid));
    const int wid = __builtin_amdgcn_readfirstlane(tid >> 6), lane = tid & 63, wr = wid >> 2, wc = wid & 3, fr = lane & 15, fq = lane >> 4;
    const int K = g.K, nt = K / BK, LD = g.ld;
    unsigned voffA[2], voffB[2];
#pragma unroll
    for (int i = 0; i < 2; ++i) { int R, C; stage_rc(tid * 16 + i * 8192, R, C); const int Rb = Epi::PERM ? ((R & ~31) + perm32(R & 31)) : R;
        voffA[i] = (unsigned)(R * g.lda + C) * 2u; voffB[i] = (unsigned)(Rb * LD + C) * 2u; }
    const size_t kstep = (size_t)(BK * 2);
    const size_t hstep = (size_t)HALF * LD * 2, hstepA = (size_t)HALF * g.lda * 2;
    const size_t tstep = 2 * hstep;
    const unsigned ldsw = (unsigned)wid * 1024u;
    const int aoff = lds_byte(wr * 64 + fr, fq * 8), boff = lds_byte(wc * 32 + fr, fq * 8);
#define PG8_SA(b, h) (((b) * 2 + (h)) * HTB)
#define PG8_SB(b, h) ((4 + (b) * 2 + (h)) * HTB)
#define PG8_STAGE(bufoff, gbase, voff) do { _Pragma("unroll") for (int _i = 0; _i < 2; ++_i) \
        __builtin_amdgcn_global_load_lds((const unsigned*)((const char*)(gbase) + (voff)[_i]), (PG8_LAS unsigned*)(lds + (bufoff) + ldsw + _i * 8192), 16, 0, 0); } while (0)
#define PG8_LDA(dst, b, h) do { _Pragma("unroll") for (int m = 0; m < 4; ++m) _Pragma("unroll") for (int k = 0; k < 2; ++k) dst[m][k] = *(const PG8_LAS bf16x8*)(lds + PG8_SA(b, h) + aoff + m * 2048 + k * 1024); } while (0)
#define PG8_LDB(dst, b, h) do { _Pragma("unroll") for (int n = 0; n < 2; ++n) _Pragma("unroll") for (int k = 0; k < 2; ++k) dst[n][k] = *(const PG8_LAS bf16x8*)(lds + PG8_SB(b, h) + boff + n * 2048 + k * 1024); } while (0)
#define PG8_MMA(ai, bj, At, Bt) do { __builtin_amdgcn_s_setprio(1); _Pragma("unroll") for (int m = 0; m < 4; ++m) _Pragma("unroll") for (int n = 0; n < 2; ++n) _Pragma("unroll") for (int k = 0; k < 2; ++k) \
        acc[ai][bj][m][n] = __builtin_amdgcn_mfma_f32_16x16x32_bf16(Bt[n][k], At[m][k], acc[ai][bj][m][n], 0, 0, 0); __builtin_amdgcn_s_setprio(0); } while (0)
#define PG8_WAIT_V(n) asm volatile("s_waitcnt vmcnt(" #n ")" ::: "memory")
#define PG8_WAIT_L(n) asm volatile("s_waitcnt lgkmcnt(" #n ")" ::: "memory")
#define PG8_BAR __builtin_amdgcn_s_barrier()
#define PG8_SCHED __builtin_amdgcn_sched_barrier(0)
    Unit cur, nxt; int ui = 0;
    if (!S.next(0, cur)) return;
    f32x4 acc[2][2][4][2];
#pragma unroll
    for (int a = 0; a < 2; ++a)
#pragma unroll
        for (int b = 0; b < 2; ++b)
#pragma unroll
            for (int m = 0; m < 4; ++m)
#pragma unroll
                for (int n = 0; n < 2; ++n) acc[a][b][m][n] = (f32x4){0.f, 0.f, 0.f, 0.f};
    S.preload(acc, tid);
    bf16x8 At[4][2], B0[2][2], B1[2][2];
    const char* cA = (const char*)g.A + S.aoff(cur, g); const char* cB = (const char*)g.Bt + (size_t)cur.pn * tstep + (size_t)cur.ks * K * 2;
    S.a_ready(cur);
    if constexpr (SP2) {
        PG8_STAGE(PG8_SB(0, 0), cB, voffB); PG8_STAGE(PG8_SB(0, 1), cB + hstep, voffB); PG8_STAGE(PG8_SA(0, 0), cA, voffA); PG8_STAGE(PG8_SA(0, 1), cA + hstepA, voffA);
        if (wr == 1) PG8_BAR;
        PG8_WAIT_V(2); PG8_BAR;
        PG8_STAGE(PG8_SB(1, 0), cB + kstep, voffB); PG8_STAGE(PG8_SA(1, 0), cA + kstep, voffA); PG8_STAGE(PG8_SB(1, 1), cB + hstep + kstep, voffB);
        PG8_WAIT_V(6); PG8_BAR;
    } else {
        PG8_STAGE(PG8_SB(0, 0), cB, voffB); PG8_STAGE(PG8_SA(0, 0), cA, voffA); PG8_STAGE(PG8_SB(0, 1), cB + hstep, voffB); PG8_STAGE(PG8_SA(0, 1), cA + hstepA, voffA);
        if (wr == 1) PG8_BAR;
        PG8_WAIT_V(4); PG8_BAR;
        PG8_STAGE(PG8_SB(1, 0), cB + kstep, voffB); PG8_STAGE(PG8_SA(1, 0), cA + kstep, voffA); PG8_STAGE(PG8_SB(1, 1), cB + hstep + kstep, voffB);
        PG8_WAIT_V(6); PG8_BAR;
    }
    for (;;) {
        const bool has_next = S.next(ui + 1, nxt);
        const char* nA = has_next ? (const char*)g.A + S.aoff(nxt, g) : cA; const char* nB = has_next ? (const char*)g.Bt + (size_t)nxt.pn * tstep + (size_t)nxt.ks * K * 2 : cB;
        for (int t = 0; t < nt; t += 2) {
            const bool last = (t == nt - 2);
            const char* a1 = cA + (size_t)(t + 1) * kstep;
            const char* a2 = last ? nA : cA + (size_t)(t + 2) * kstep; const char* b2 = last ? nB : cB + (size_t)(t + 2) * kstep;
            const char* a3 = a2 + kstep; const char* b3 = b2 + kstep;
            if (last && has_next) S.a_ready(nxt);
            if constexpr (SP2) {
            PG8_LDB(B0, 0, 0); PG8_LDB(B1, 0, 1); PG8_SCHED; PG8_LDA(At, 0, 0); PG8_STAGE(PG8_SA(1, 1), a1 + hstepA, voffA);
            PG8_WAIT_V(8); PG8_WAIT_L(0); PG8_BAR; PG8_MMA(0, 0, At, B0); PG8_MMA(0, 1, At, B1); PG8_BAR; PG8_SCHED;
            PG8_LDA(At, 0, 1); PG8_STAGE(PG8_SB(0, 0), b2, voffB); PG8_STAGE(PG8_SB(0, 1), b2 + hstep, voffB); PG8_STAGE(PG8_SA(0, 0), a2, voffA);
            PG8_WAIT_V(8); PG8_WAIT_L(0); PG8_BAR; PG8_MMA(1, 0, At, B0); PG8_MMA(1, 1, At, B1); PG8_BAR; PG8_SCHED;
            PG8_LDB(B0, 1, 0); PG8_LDB(B1, 1, 1); PG8_SCHED; PG8_LDA(At, 1, 0); PG8_STAGE(PG8_SA(0, 1), a2 + hstepA, voffA);
            PG8_WAIT_V(8); PG8_WAIT_L(0); PG8_BAR; PG8_MMA(0, 0, At, B0); PG8_MMA(0, 1, At, B1); PG8_BAR; PG8_SCHED;
            PG8_LDA(At, 1, 1); PG8_STAGE(PG8_SB(1, 0), b3, voffB); PG8_STAGE(PG8_SB(1, 1), b3 + hstep, voffB); PG8_STAGE(PG8_SA(1, 0), a3, voffA);
            PG8_WAIT_V(8); PG8_WAIT_L(0); PG8_BAR; PG8_MMA(1, 0, At, B0); PG8_MMA(1, 1, At, B1); PG8_BAR; PG8_SCHED;
            } else {
            PG8_LDB(B0, 0, 0); PG8_SCHED; PG8_LDA(At, 0, 0); PG8_STAGE(PG8_SA(1, 1), a1 + hstepA, voffA);
            PG8_WAIT_L(8); PG8_BAR; PG8_WAIT_L(0); PG8_MMA(0, 0, At, B0); PG8_BAR; PG8_SCHED;
            PG8_LDB(B1, 0, 1); PG8_STAGE(PG8_SB(0, 0), b2, voffB);
            PG8_BAR; PG8_WAIT_L(0); PG8_MMA(0, 1, At, B1); PG8_BAR;
            PG8_LDA(At, 0, 1); PG8_STAGE(PG8_SA(0, 0), a2, voffA);
            PG8_BAR; PG8_WAIT_L(0); PG8_MMA(1, 0, At, B0); PG8_BAR; PG8_SCHED;
            PG8_STAGE(PG8_SB(0, 1), b2 + hstep, voffB);
            PG8_WAIT_V(6); PG8_BAR; PG8_MMA(1, 1, At, B1); PG8_BAR;
            PG8_LDB(B0, 1, 0); PG8_SCHED; PG8_LDA(At, 1, 0); PG8_STAGE(PG8_SA(0, 1), a2 + hstepA, voffA);
            PG8_WAIT_L(8); PG8_BAR; PG8_WAIT_L(0); PG8_MMA(0, 0, At, B0); PG8_BAR; PG8_SCHED;
            PG8_LDB(B1, 1, 1); PG8_STAGE(PG8_SB(1, 0), b3, voffB);
            PG8_BAR; PG8_WAIT_L(0); PG8_MMA(0, 1, At, B1); PG8_BAR;
            PG8_LDA(At, 1, 1); PG8_STAGE(PG8_SA(1, 0), a3, voffA);
            PG8_BAR; PG8_WAIT_L(0); PG8_MMA(1, 0, At, B0); PG8_BAR; PG8_SCHED;
            PG8_STAGE(PG8_SB(1, 1), b3 + hstep, voffB);
            PG8_WAIT_V(6); PG8_BAR; PG8_MMA(1, 1, At, B1); PG8_BAR;
            }
        }
        if constexpr (ALIGN_EPI) { if (wr == 0) PG8_BAR; }
        E(acc, cur, wr, wc, fr, fq);
        if (!has_next) break;
#pragma unroll
        for (int a = 0; a < 2; ++a)
#pragma unroll
            for (int b = 0; b < 2; ++b)
#pragma unroll
                for (int m = 0; m < 4; ++m)
#pragma unroll
                    for (int n = 0; n < 2; ++n) acc[a][b][m][n] = (f32x4){0.f, 0.f, 0.f, 0.f};
        cur = nxt; cA = nA; cB = nB; ++ui;
        if constexpr (ALIGN_EPI) { if (wr == 1) PG8_BAR; }
    }
    PG8_WAIT_V(0);
    if constexpr (!ALIGN_EPI) { if (wr == 0) PG8_BAR; }
    PG8_BAR;
#undef PG8_SA
#undef PG8_SB
#undef PG8_STAGE
#undef PG8_LDA
#undef PG8_LDB
#undef PG8_MMA
#undef PG8_WAIT_V
#undef PG8_WAIT_L
#undef PG8_BAR
#undef PG8_SCHED
}
}

constexpr int NB = 4, SEQ = 4096, DM = 2048, NT = NB * SEQ, PLE = 256;
constexpr int MH = 4, MDH = 256;
constexpr int NHD = 64, NH = 16, NKV = 4;
constexpr int DIN = 8760, DINP = 8960;
constexpr int C_MQ = 0, C_MK = 1024, C_MV = 2048, C_MO = 3072, C_MZ = 4096, C_NQ = 5120, C_KC = 6144, C_VC = 6400, C_KS = 6656, C_VS = 6912,
              C_KW = 7168, C_VW = 7424, C_NZ = 7680, C_NG = 8704, C_GATE = 8752;
constexpr size_t PE = 524288;
constexpr size_t PO_MQK = 0, PO_MV = 64 * PE, PO_MG = 96 * PE, PO_NQ = 160 * PE, PO_KV6 = 192 * PE, PO_NZ = 240 * PE, PO_NG = 272 * PE;
constexpr size_t KVSZ = (size_t)4 * 4 * 4096 * 64;
constexpr float EPSV = 1e-6f, NEGV = -1e30f, LOG2E = 1.4426950408889634f;
constexpr int NWAVES = 8, NTHREADS = 512;
constexpr int LDS_BYTES = 147456;
constexpr int LDS_MISC = 135168;
constexpr int STG_PITCH = 260;

constexpr size_t MiB = 1u << 20;
constexpr size_t WS_GATES = 1 * MiB;
constexpr size_t WS_ROPE  = 2 * MiB;
constexpr size_t WS_U2    = 3 * MiB;
constexpr size_t WS_MX2   = 3 * MiB + 512 * 1024;
constexpr size_t WS_PLSS  = 32768;
constexpr size_t WS_X2SS  = 6 * MiB;
constexpr size_t WS_WOUT  = 8 * MiB;
constexpr size_t WS_WGATE = 16 * MiB;
constexpr size_t WS_WPLE  = 24 * MiB;
constexpr size_t WS_WC1   = 25 * MiB;
constexpr size_t WS_HID   = 26 * MiB;
constexpr size_t WS_KVC   = 30 * MiB;
constexpr size_t WS_PB    = 32 * MiB;
constexpr size_t WS_WIN   = 40 * MiB;
constexpr size_t WS_XN    = 76 * MiB;
constexpr size_t WS_PROJ  = 140 * MiB;
constexpr size_t WS_MIX   = 420 * MiB;
constexpr size_t WS_DN    = 484 * MiB;
constexpr size_t WS_NS    = 484 * MiB + 256 * 1024;
constexpr size_t WS_END   = 485 * MiB;

#define LAS __attribute__((address_space(3)))
#define DI __device__ __forceinline__
typedef unsigned short bf16;
typedef unsigned v4u __attribute__((ext_vector_type(4)));
typedef unsigned v2u __attribute__((ext_vector_type(2)));
typedef float f32x4 __attribute__((ext_vector_type(4)));
typedef float f32x16 __attribute__((ext_vector_type(16)));
typedef short bf16x8 __attribute__((ext_vector_type(8)));
typedef short s16x4 __attribute__((ext_vector_type(4)));
typedef float f32x2_t __attribute__((ext_vector_type(2)));
typedef __bf16 bf16x2_t __attribute__((ext_vector_type(2)));

DI unsigned pk2(float lo, float hi) { f32x2_t v = {lo, hi}; bf16x2_t b = __builtin_convertvector(v, bf16x2_t); return __builtin_bit_cast(unsigned, b); }
DI float bflo(unsigned w) { return __uint_as_float(w << 16); }
DI float bfhi(unsigned w) { return __uint_as_float(w & 0xffff0000u); }
DI float bf2f(bf16 h) { return __uint_as_float((unsigned)h << 16); }
DI float ex2(float x) { return __builtin_amdgcn_exp2f(x); }
DI float fsigmoid(float x) { return __builtin_amdgcn_rcpf(1.f + ex2(-LOG2E * x)); }
DI float fsilu(float x) { return x * fsigmoid(x); }
DI float fgelu_tanh(float x) { const float z = 0.7978845608028654f * (x + 0.044715f * x * x * x); return x * fsigmoid(2.f * z); }
DI float swap32_max(float m) { const auto rr = __builtin_amdgcn_permlane32_swap(__float_as_uint(m), __float_as_uint(m), false, false); return fmaxf(__uint_as_float(rr[0]), __uint_as_float(rr[1])); }
DI int crow(int r, int h) { return (r & 3) + 8 * (r >> 2) + 4 * h; }
DI void unpack8(v4u w, float (&f)[8]) { f[0] = bflo(w.x); f[1] = bfhi(w.x); f[2] = bflo(w.y); f[3] = bfhi(w.y); f[4] = bflo(w.z); f[5] = bfhi(w.z); f[6] = bflo(w.w); f[7] = bfhi(w.w); }
DI v4u pack8(const float (&f)[8]) { v4u w; w.x = pk2(f[0], f[1]); w.y = pk2(f[2], f[3]); w.z = pk2(f[4], f[5]); w.w = pk2(f[6], f[7]); return w; }
DI float wave_sum(float v) {
#pragma unroll
    for (int o = 1; o < 64; o <<= 1) v += __shfl_xor(v, o);
    return v;
}
DI void glds16(const void* gsrc, LAS unsigned char* dst_wave_uniform) {
    __builtin_amdgcn_global_load_lds((const unsigned*)gsrc, (LAS unsigned*)dst_wave_uniform, 16, 0, 0);
}
DI void glds16a(const void* gsrc, unsigned lds_dst) { unsigned keep;
    asm volatile("s_mov_b32 %0, m0\n\ts_mov_b32 m0, %2\n\ts_nop 0\n\tglobal_load_lds_dwordx4 %1, off\n\ts_mov_b32 m0, %0" : "=&s"(keep) : "v"(gsrc), "s"(lds_dst) : "memory"); }
template <int IMM> DI void glds16s(const void* sbase, unsigned voff, unsigned lds_dst) { unsigned keep;
    asm volatile("s_mov_b32 %0, m0\n\ts_mov_b32 m0, %3\n\ts_nop 0\n\tglobal_load_lds_dwordx4 %1, %2 offset:%c4\n\ts_mov_b32 m0, %0" : "=&s"(keep) : "v"(voff), "s"(sbase), "s"(lds_dst), "i"(IMM) : "memory"); }
DI unsigned lds_u32(const LAS void* p) { return (unsigned)(size_t)p; }
#define WAITBAR(N) asm volatile("s_waitcnt vmcnt(" #N ") lgkmcnt(0)\n\ts_barrier" ::: "memory")
#define LBAR() asm volatile("s_waitcnt lgkmcnt(0)\n\ts_barrier" ::: "memory")
#define VM_WAIT() asm volatile("s_waitcnt vmcnt(0)" ::: "memory")
#define MFMA32(a, b, c) __builtin_amdgcn_mfma_f32_32x32x16_bf16((a), (b), (c), 0, 0, 0)


#define XB_TMO      128
#define XB_XCNT(j)  (256  + 64 * (j))
#define XB_XSUB(j)  (1280 + 64 * (j))
#define XB_XGEN(j)  (2304 + 64 * (j))
#define XB_TOP      3328
#define XB_TOPGEN   3392
#define XCD_BAR_WORDS 3456
#define XB_SPIN_CAP (1u << 20)
DI unsigned xb_ld(unsigned* p)              { return __hip_atomic_load(p, __ATOMIC_RELAXED, __HIP_MEMORY_SCOPE_AGENT); }
DI unsigned xb_add(unsigned* p, unsigned v) { return __hip_atomic_fetch_add(p, v, __ATOMIC_RELAXED, __HIP_MEMORY_SCOPE_AGENT); }
DI unsigned xb_xcc_id() { return (unsigned)__builtin_amdgcn_s_getreg((3 << 11) | 20) & 0xFu; }
#define XB_SPIN(cond, bar) do { unsigned _sp = 0; while (cond) { \
    if ((++_sp & 255u) == 0u) { if (xb_ld(&(bar)[XB_TMO])) break; if (_sp > XB_SPIN_CAP) { atomicAdd(&(bar)[XB_TMO], 1u); break; } } } } while (0)
struct XcdBarrier { unsigned* bar; unsigned x; volatile LAS unsigned* st; };
DI XcdBarrier xcd_barrier_post(unsigned* bar, volatile LAS unsigned* st, bool leader) {
    XcdBarrier b; b.bar = bar; b.x = xb_xcc_id(); b.st = st;
    if (leader) (void)xb_add(&bar[XB_XCNT(b.x)], 1u);
    return b;
}
DI void xcd_barrier_complete(unsigned* bar, unsigned x, unsigned& nloc, unsigned& nx) {
    const unsigned G = gridDim.x * gridDim.y * gridDim.z;
    unsigned sum, cnt, mine, sp = 0u;
    for (;;) {
        sum = 0u; cnt = 0u; mine = 0u;
#pragma unroll
        for (unsigned j = 0; j < 16; ++j) { const unsigned c = xb_ld(&bar[XB_XCNT(j)]); sum += c; cnt += (c > 0u) ? 1u : 0u; mine = (j == x) ? c : mine; }
        if (sum == G) break;
        __builtin_amdgcn_s_sleep(1);
        if ((++sp & 255u) == 0u) { if (xb_ld(&bar[XB_TMO])) break; if (sp > XB_SPIN_CAP) { atomicAdd(&bar[XB_TMO], 1u); break; } }
    }
    nloc = mine > 0u ? mine : 1u; nx = cnt > 0u ? cnt : 1u;
}
DI void xcd_barrier_local(const XcdBarrier& b, bool leader) {
    asm volatile("s_waitcnt vmcnt(0)" ::: "memory");
    __syncthreads();
    if (leader) {
        unsigned* bar = b.bar;
        __builtin_amdgcn_s_waitcnt(0);
        unsigned nloc = b.st[0], nx = b.st[1];
        if (nloc == 0u) { xcd_barrier_complete(bar, b.x, nloc, nx); b.st[0] = nloc; b.st[1] = nx; }
        const unsigned old = xb_add(&bar[XB_XSUB(b.x)], 1u);
        const unsigned gen = old / nloc;
        if (old + 1u == (gen + 1u) * nloc) {
            __builtin_amdgcn_fence(__ATOMIC_RELEASE, "agent");
            asm volatile("s_waitcnt vmcnt(0)" ::: "memory");
            __builtin_amdgcn_fence(__ATOMIC_ACQUIRE, "agent");
            xb_add(&bar[XB_XGEN(b.x)], 1u);
            asm volatile("s_waitcnt vmcnt(0)" ::: "memory");
        } else {
            XB_SPIN(xb_ld(&bar[XB_XGEN(b.x)]) == gen, bar);
            __builtin_amdgcn_fence(__ATOMIC_ACQUIRE, "agent");
            asm volatile("s_waitcnt vmcnt(0)" ::: "memory");
        }
    }
    __syncthreads();
}
DI void xcd_barrier(const XcdBarrier& b, bool leader) {
    asm volatile("s_waitcnt vmcnt(0)" ::: "memory");
    __syncthreads();
    if (leader) {
        unsigned* bar = b.bar;
        __builtin_amdgcn_s_waitcnt(0);
        unsigned nloc = b.st[0], nx = b.st[1];
        if (nloc == 0u) { xcd_barrier_complete(bar, b.x, nloc, nx); b.st[0] = nloc; b.st[1] = nx; }
        const unsigned old = xb_add(&bar[XB_XSUB(b.x)], 1u);
        const unsigned gen = old / nloc;
        if (old + 1u == (gen + 1u) * nloc) {
            __builtin_amdgcn_fence(__ATOMIC_RELEASE, "agent");
            asm volatile("s_waitcnt vmcnt(0)" ::: "memory");
            const unsigned og = xb_add(&bar[XB_TOP], 1u);
            const unsigned tg = og / nx;
            if (og + 1u == (tg + 1u) * nx) xb_add(&bar[XB_TOPGEN], 1u);
            else XB_SPIN(xb_ld(&bar[XB_TOPGEN]) == tg, bar);
            __builtin_amdgcn_fence(__ATOMIC_ACQUIRE, "agent");
            xb_add(&bar[XB_XGEN(b.x)], 1u);
            asm volatile("s_waitcnt vmcnt(0)" ::: "memory");
        } else {
            XB_SPIN(xb_ld(&bar[XB_XGEN(b.x)]) == gen, bar);
            __builtin_amdgcn_fence(__ATOMIC_ACQUIRE, "agent");
            asm volatile("s_waitcnt vmcnt(0)" ::: "memory");
        }
    }
    __syncthreads();
}

struct Ctx {
    const float *x, *p; const int* positions; const float *norm_g, *w_in, *conv_w, *conv_b, *b_ig, *b_fg, *m_norm_g, *pos_k, *pos_v, *ck_w1, *ck_w2, *cv_w1, *cv_w2,
                *w_out, *gate_w, *ple_w, *ple_g, *final_g;
    float* out; unsigned char* ws;
    int vcu, G, wbase;
    DI int tid() const { return wbase + (int)__builtin_amdgcn_mbcnt_hi(~0u, __builtin_amdgcn_mbcnt_lo(~0u, 0u)); }
    DI float* gates() const { return (float*)(ws + WS_GATES); }
    DI float* rope() const { return (float*)(ws + WS_ROPE); }
    DI float* u2() const { return (float*)(ws + WS_U2); }
    DI float* mx2() const { return (float*)(ws + WS_MX2); }
    DI float* plss() const { return (float*)(ws + WS_PLSS); }
    DI float* x2ss() const { return (float*)(ws + WS_X2SS); }
    DI float* DN() const { return (float*)(ws + WS_DN); }
    DI float* NS() const { return (float*)(ws + WS_NS); }
    DI bf16* SB() const { return (bf16*)(ws + WS_WIN); }
    DI bf16* WoutT() const { return (bf16*)(ws + WS_WOUT); }
    DI bf16* WgateT() const { return (bf16*)(ws + WS_WGATE); }
    DI bf16* WpleT() const { return (bf16*)(ws + WS_WPLE); }
    DI bf16* Wc1T() const { return (bf16*)(ws + WS_WC1); }
    DI bf16* HID() const { return (bf16*)(ws + WS_HID); }
    DI bf16* KVC() const { return (bf16*)(ws + WS_KVC); }
    DI bf16* PB() const { return (bf16*)(ws + WS_PB); }
    DI bf16* WinT() const { return (bf16*)(ws + WS_WIN); }
    DI bf16* CA() const { return (bf16*)(ws + WS_WIN); }
    DI bf16* XN() const { return (bf16*)(ws + WS_XN); }
    DI bf16* QC() const { return (bf16*)(ws + WS_XN); }
    DI bf16* KC() const { return (bf16*)(ws + WS_XN + 32 * MiB); }
    DI bf16* PROJ() const { return (bf16*)(ws + WS_PROJ); }
    DI bf16* PL() const { return (bf16*)(ws + WS_PROJ); }
    DI bf16* X1B() const { return (bf16*)(ws + WS_PROJ + 64 * MiB); }
    DI bf16* MIX() const { return (bf16*)(ws + WS_MIX); }
    DI bf16* X2B() const { return (bf16*)(ws + WS_XN); }
    DI float* HIDP() const { return (float*)((unsigned char*)out + 32 * MiB); }
    DI float* posb() const { return (float*)(ws + WS_KVC + 1024 * 1024); }
};

DI int map_in(int np) { if (np >= 3072 && np < 5120) { const int k = (np - 3072) >> 8, ct = np & 255; return ct < 128 ? 3072 + 128 * k + ct : 4096 + 128 * k + (ct - 128); }
    return np < 5120 ? np : (np < 7680 ? np + 8 : (np < 8704 ? np + 56 : (np < 8752 ? np - 1016 : (np < 8760 ? np - 3632 : -1)))); }
DI void transpose_item(const float* W, int K, int N, int mode, bf16* WT, int row_off, LAS float* scr, int item, int nblk, int lane) {
    const int kb = item / nblk, nb = item % nblk, k0 = 64 * kb, n0 = 32 * nb;
    const int np = n0 + 4 * (lane & 7);
    const int src = mode ? map_in(np) : np;
    f32x4 v[8];
#pragma unroll
    for (int i = 0; i < 8; ++i) { const int kk = (lane >> 3) + 8 * i; v[i] = (src >= 0) ? __builtin_nontemporal_load((const f32x4*)(W + (size_t)(k0 + kk) * N + src)) : (f32x4){0.f, 0.f, 0.f, 0.f}; }
#pragma unroll
    for (int i = 0; i < 8; ++i) { const int kk = (lane >> 3) + 8 * i; LAS float* d = scr + kk * 33 + 4 * (lane & 7); d[0] = v[i].x; d[1] = v[i].y; d[2] = v[i].z; d[3] = v[i].w; }
    __builtin_amdgcn_fence(__ATOMIC_RELEASE, "wavefront"); __builtin_amdgcn_wave_barrier(); __builtin_amdgcn_fence(__ATOMIC_ACQUIRE, "wavefront");
    const int c = lane & 7;
#pragma unroll
    for (int j = 0; j < 4; ++j) { const int n = (lane >> 3) + 8 * j; const LAS float* s = scr + (8 * c) * 33 + n;
        v4u o; o.x = pk2(s[0 * 33], s[1 * 33]); o.y = pk2(s[2 * 33], s[3 * 33]); o.z = pk2(s[4 * 33], s[5 * 33]); o.w = pk2(s[6 * 33], s[7 * 33]);
        *(v4u*)(WT + (size_t)(row_off + n0 + n) * K + k0 + 8 * c) = o; }
    __builtin_amdgcn_fence(__ATOMIC_RELEASE, "wavefront"); __builtin_amdgcn_wave_barrier(); __builtin_amdgcn_fence(__ATOMIC_ACQUIRE, "wavefront");
}
DI void phase0(const Ctx& C, LAS unsigned char* lds) {
    int tid = C.tid(); asm volatile("" : "+v"(tid));
    const int lane = tid & 63, wave = __builtin_amdgcn_readfirstlane(tid >> 6);
    LAS float* scr = (LAS float*)(lds + wave * 16384);
    const int gw = C.vcu * NWAVES + wave, NGW = C.G * NWAVES;
    constexpr int I_IN = 32 * 280;
    for (int it = gw; it < I_IN; it += NGW) transpose_item(C.w_in, DM, DIN, 1, C.WinT(), 0, scr, it, 280, lane);
    for (int m = gw; m < NT; m += NGW) {
        const f32x4* xr = (const f32x4*)(C.x + (size_t)m * DM);
        f32x4 v[8]; float s = 0.f;
#pragma unroll
        for (int j = 0; j < 4; ++j) { v[2 * j] = __builtin_nontemporal_load(xr + 2 * (lane + 64 * j)); v[2 * j + 1] = __builtin_nontemporal_load(xr + 2 * (lane + 64 * j) + 1); }
#pragma unroll
        for (int j = 0; j < 8; ++j) s += (v[j].x * v[j].x + v[j].y * v[j].y) + (v[j].z * v[j].z + v[j].w * v[j].w);
        const float rstd = 1.f / sqrtf(wave_sum(s) * (1.f / DM) + EPSV);
        v4u* o16 = (v4u*)(C.XN() + (size_t)m * DM);
#pragma unroll
        for (int j = 0; j < 4; ++j) { const f32x4 g0 = *((const f32x4*)C.norm_g + 2 * (lane + 64 * j)), g1 = *((const f32x4*)C.norm_g + 2 * (lane + 64 * j) + 1);
            const f32x4 a = v[2 * j], b2 = v[2 * j + 1];
            v4u w; w.x = pk2(a.x * rstd * g0.x, a.y * rstd * g0.y); w.y = pk2(a.z * rstd * g0.z, a.w * rstd * g0.w); w.z = pk2(b2.x * rstd * g1.x, b2.y * rstd * g1.y); w.w = pk2(b2.z * rstd * g1.z, b2.w * rstd * g1.w);
            o16[lane + 64 * j] = w; }
    }
    const int gt = C.vcu * NTHREADS + tid, NGT = C.G * NTHREADS;
    for (int i = gt; i < NT * 8; i += NGT) {
        const int t = i >> 3, k = i & 7;
        const float invf[8] = {1.0f, 0.1939227432012558f, 0.03760603070259094f, 0.007292664609849453f, 0.0014142135623842478f, 0.00027424818836152554f, 5.3182957344688475e-05f, 1.0313385246263351e-05f};
        float inv = invf[0];
#pragma unroll
        for (int q = 1; q < 8; ++q) inv = (k == q) ? invf[q] : inv;
        const float ang = (float)C.positions[t] * inv;
        float sn, cs; sincosf(ang, &sn, &cs);
        C.rope()[t * 16 + k] = cs; C.rope()[t * 16 + 8 + k] = sn;
    }
}

DI void late_weights(const Ctx& C, LAS unsigned char* lds, int wg, int nwg, int part = 0) {
    int tid = C.tid(); asm volatile("" : "+v"(tid));
    const int lane = tid & 63, wave = __builtin_amdgcn_readfirstlane(tid >> 6);
    LAS float* scr = (LAS float*)(lds + wave * 16384);
    const int gw = wg * NWAVES + wave, NGW = nwg * NWAVES;
    constexpr int I_OUT = 32 * 64, I_GATE = 32 * 64, I_PLE = 4 * 64, I_C1 = 32 * 4;
    constexpr int NITEMS = I_OUT + I_GATE + I_PLE + 2 * I_C1;
    __syncthreads();
    if (part != 2)
    for (int it = gw; it < NITEMS; it += NGW) {
        int r = it;
        if (r < I_OUT) { transpose_item(C.w_out, DM, DM, 0, C.WoutT(), 0, scr, r, 64, lane); continue; } r -= I_OUT;
        if (r < I_GATE) { transpose_item(C.gate_w, DM, DM, 0, C.WgateT(), 0, scr, r, 64, lane); continue; } r -= I_GATE;
        if (r < I_PLE) { transpose_item(C.ple_w, PLE, DM, 0, C.WpleT(), 0, scr, r, 64, lane); continue; } r -= I_PLE;
        if (r < I_C1) { transpose_item(C.ck_w1, DM, 128, 0, C.Wc1T(), 0, scr, r, 4, lane); continue; } r -= I_C1;
        transpose_item(C.cv_w1, DM, 128, 0, C.Wc1T(), 128, scr, r, 4, lane);
    }
    if (part != 1)
    for (int i = wg * NTHREADS + tid; i < NT * PLE / 8; i += nwg * NTHREADS) {
        const f32x4 a = *((const f32x4*)C.p + 2 * i), b = *((const f32x4*)C.p + 2 * i + 1);
        v4u w; w.x = pk2(a.x, a.y); w.y = pk2(a.z, a.w); w.z = pk2(b.x, b.y); w.w = pk2(b.z, b.w);
        *((v4u*)C.PB() + i) = w;
    }
    __syncthreads();
}

typedef pg8::f32x4 gf4;
struct CmpOrder {
    int G, c;
    DI void init(int G_, int c_) { G = G_; c = c_; }
    DI bool next(int i, pg8::Unit& u) const {
        if (G == 256) { if (i) return false; const int g8 = c & 7, li = c >> 3; u.pm = ((li >> 1) & 1) * 16 + 2 * g8 + (li & 1); u.pn = 0; u.ks = li >> 2; return true; }
        const int L = i * G + c; if (L >= 256) return false; u.pm = L & 31; u.pn = 0; u.ks = L >> 5; return true; }
    DI void a_ready(const pg8::Unit&) const {}
    DI void done(const pg8::Unit&) const {}
    template <class A> DI void preload(A&, int) const {}
    DI size_t aoff(const pg8::Unit& u, const pg8::Gemm& g) const { return ((size_t)(u.pm >> 4) * KVSZ + (size_t)(u.pm & 15) * SEQ * 64) * 2 + (size_t)u.ks * g.K * 2; }
};
DI bf16* proj_dst(bf16* P, int pn, int r, int ct) {
    const int b = r >> 12, s = r & (SEQ - 1);
    if (pn < 8) return P + PO_MQK + (size_t)r * 2048 + pn * 256 + ct;
    if (pn < 12) return P + PO_MV + ((size_t)(b * 4 + (pn - 8)) * SEQ + s) * 256 + ct;
    if (pn < 20) return nullptr;
    if (pn < 24) return P + PO_NQ + ((size_t)(b * 16 + (pn - 20) * 4 + (ct >> 6)) * SEQ + s) * 64 + (ct & 63);
    if (pn < 30) return P + PO_KV6 + (size_t)(pn - 24) * KVSZ + ((size_t)(b * 4 + (ct >> 6)) * SEQ + s) * 64 + (ct & 63);
    if (pn < 34) return P + PO_NZ + ((size_t)(b * 16 + (pn - 30) * 4 + (ct >> 6)) * SEQ + s) * 64 + (ct & 63);
    return ct < 64 ? P + PO_NG + (size_t)r * 64 + ct : nullptr;
}
struct EpiProj {
    static constexpr bool PERM = true;
    bf16* O; float* gates; const float* rope;
    DI void operator()(const gf4 (&acc)[2][2][4][2], const pg8::Unit& u, int wr, int wc, int fr, int fq) const {
        const int row0 = u.pm * 256 + wr * 64 + fr, ct0 = wc * 32 + 8 * fq;
        const bool gl = (u.pn == 34) && (wc == 1) && (fq == 2);
        const bool ropew = ((u.pn >= 20 && u.pn <= 24) || u.pn == 26 || u.pn == 28) && ((wc & 1) == 0);
        const float sgn = (fq == 0) ? -1.f : 1.f;
#pragma unroll
        for (int ai = 0; ai < 2; ++ai)
#pragma unroll
            for (int m = 0; m < 4; ++m) { const int row = row0 + ai * 128 + m * 16;
                gf4 c0, c1, s0, s1;
                if (ropew) { c0 = *(const gf4*)(rope + (size_t)row * 16); c1 = *(const gf4*)(rope + (size_t)row * 16 + 4); s0 = *(const gf4*)(rope + (size_t)row * 16 + 8); s1 = *(const gf4*)(rope + (size_t)row * 16 + 12); }
#pragma unroll
                for (int bj = 0; bj < 2; ++bj) { gf4 v0 = acc[ai][bj][m][0], v1 = acc[ai][bj][m][1];
                    if (ropew) {
                        gf4 p0, p1;
#pragma unroll
                        for (int e = 0; e < 4; ++e) { p0[e] = __shfl_xor(v0[e], 16); p1[e] = __shfl_xor(v1[e], 16); }
                        if (fq < 2) {
#pragma unroll
                            for (int e = 0; e < 4; ++e) { v0[e] = v0[e] * c0[e] + sgn * p0[e] * s0[e]; v1[e] = v1[e] * c1[e] + sgn * p1[e] * s1[e]; }
                        }
                    }
                    if (u.pn >= 12 && u.pn < 20) {
                        if (bj == 1) { const gf4 o0 = acc[ai][0][m][0], o1 = acc[ai][0][m][1]; float gg[8];
#pragma unroll
                            for (int e = 0; e < 4; ++e) { gg[e] = v0[e] * __builtin_amdgcn_rcpf((1.f + ex2(-LOG2E * o0[e])) * (1.f + ex2(-LOG2E * v0[e]))); gg[4 + e] = v1[e] * __builtin_amdgcn_rcpf((1.f + ex2(-LOG2E * o1[e])) * (1.f + ex2(-LOG2E * v1[e]))); }
                            const int k = u.pn - 12, b_ = row >> 12, s_ = row & (SEQ - 1);
                            __builtin_nontemporal_store(pack8(gg), (v4u*)(O + PO_MG + ((size_t)(b_ * 4 + (k >> 1)) * SEQ + s_) * 256 + (k & 1) * 128 + ct0)); }
                    } else {
                    if (u.pn >= 30 && u.pn < 34) {
#pragma unroll
                        for (int e = 0; e < 4; ++e) { v0[e] = fsilu(v0[e]); v1[e] = fsilu(v1[e]); }
                    } else if (u.pn == 34) {
#pragma unroll
                        for (int e = 0; e < 4; ++e) { v0[e] = fsigmoid(v0[e]); v1[e] = fsigmoid(v1[e]); }
                    }
                    v4u w; w.x = pk2(v0[0], v0[1]); w.y = pk2(v0[2], v0[3]); w.z = pk2(v1[0], v1[1]); w.w = pk2(v1[2], v1[3]);
                    bf16* dst = proj_dst(O, u.pn, row, ct0 + bj * 128);
                    if (dst) __builtin_nontemporal_store(w, (v4u*)dst); }
                    }
                if (gl) { *(gf4*)(gates + (size_t)row * 8) = acc[ai][0][m][0]; *(gf4*)(gates + (size_t)row * 8 + 4) = acc[ai][0][m][1]; } }
    }
};
struct EpiCmpPart {
    static constexpr bool PERM = true;
    float* HP;
    DI void operator()(const gf4 (&acc)[2][2][4][2], const pg8::Unit& u, int wr, int wc, int fr, int fq) const {
        const int row0 = u.pm * 256 + wr * 64 + fr, col0 = wc * 32 + 8 * fq;
        const bool isv = u.pm >= 16;
        float* base = HP + (size_t)u.ks * 8192 * 128;
#pragma unroll
        for (int ai = 0; ai < 2; ++ai)
#pragma unroll
            for (int m = 0; m < 4; ++m) { const int row = row0 + ai * 128 + m * 16;
                const gf4 v0 = isv ? acc[ai][1][m][0] : acc[ai][0][m][0], v1 = isv ? acc[ai][1][m][1] : acc[ai][0][m][1];
                *(gf4*)(base + (size_t)row * 128 + col0) = v0; *(gf4*)(base + (size_t)row * 128 + col0 + 4) = v1; }
    }
};
struct EpiX1 {
    static constexpr bool PERM = true;
    const float* x; bf16* xb;
    DI void operator()(const gf4 (&acc)[2][2][4][2], const pg8::Unit& u, int wr, int wc, int fr, int fq) const {
        const int row0 = u.pm * 256 + wr * 64 + fr, col0 = u.pn * 256 + wc * 32 + 8 * fq;
        gf4 nx[4];
        { const size_t off = (size_t)row0 * DM + col0; nx[0] = __builtin_nontemporal_load((const gf4*)(x + off)); nx[1] = __builtin_nontemporal_load((const gf4*)(x + off + 4)); nx[2] = __builtin_nontemporal_load((const gf4*)(x + off + 128)); nx[3] = __builtin_nontemporal_load((const gf4*)(x + off + 132)); }
#pragma unroll
        for (int r8 = 0; r8 < 8; ++r8) { const int ai = r8 >> 2, m = r8 & 3; const size_t off = (size_t)(row0 + ai * 128 + m * 16) * DM + col0;
            const gf4 cx0 = nx[0], cx1 = nx[1], cx2 = nx[2], cx3 = nx[3];
            if (r8 < 7) { const int ai2 = (r8 + 1) >> 2, m2 = (r8 + 1) & 3; const size_t o2 = (size_t)(row0 + ai2 * 128 + m2 * 16) * DM + col0;
                nx[0] = __builtin_nontemporal_load((const gf4*)(x + o2)); nx[1] = __builtin_nontemporal_load((const gf4*)(x + o2 + 4)); nx[2] = __builtin_nontemporal_load((const gf4*)(x + o2 + 128)); nx[3] = __builtin_nontemporal_load((const gf4*)(x + o2 + 132)); }
            { const gf4 v0 = acc[ai][0][m][0] + cx0, v1 = acc[ai][0][m][1] + cx1; v4u w; w.x = pk2(v0[0], v0[1]); w.y = pk2(v0[2], v0[3]); w.z = pk2(v1[0], v1[1]); w.w = pk2(v1[2], v1[3]); *(v4u*)(xb + off) = w; }
            { const gf4 v0 = acc[ai][1][m][0] + cx2, v1 = acc[ai][1][m][1] + cx3; v4u w; w.x = pk2(v0[0], v0[1]); w.y = pk2(v0[2], v0[3]); w.z = pk2(v1[0], v1[1]); w.w = pk2(v1[2], v1[3]); *(v4u*)(xb + off + 128) = w; }
        }
    }
};
struct EpiPl {
    static constexpr bool PERM = true;
    bf16* PLb; float* ss;
    DI void operator()(const gf4 (&acc)[2][2][4][2], const pg8::Unit& u, int wr, int wc, int fr, int fq) const {
        const int row0 = u.pm * 256 + wr * 64 + fr, col0 = u.pn * 256 + wc * 32 + 8 * fq;
#pragma unroll
        for (int ai = 0; ai < 2; ++ai)
#pragma unroll
            for (int m = 0; m < 4; ++m) { const int row = row0 + ai * 128 + m * 16; const size_t off = (size_t)row * DM + col0; float s = 0.f;
#pragma unroll
                for (int bj = 0; bj < 2; ++bj) { const gf4 v0 = acc[ai][bj][m][0], v1 = acc[ai][bj][m][1];
                    s += (v0[0] * v0[0] + v0[1] * v0[1]) + (v0[2] * v0[2] + v0[3] * v0[3]) + (v1[0] * v1[0] + v1[1] * v1[1]) + (v1[2] * v1[2] + v1[3] * v1[3]);
                    v4u w; w.x = pk2(v0[0], v0[1]); w.y = pk2(v0[2], v0[3]); w.z = pk2(v1[0], v1[1]); w.w = pk2(v1[2], v1[3]);
                    *(v4u*)(PLb + off + bj * 128) = w; }
                s += __shfl_xor(s, 16); s += __shfl_xor(s, 32);
                if (fq == 0) atomicAdd(ss + row, s); }
    }
};
struct OneUnit {
    int pm, pn;
    __device__ bool next(int i, pg8::Unit& u) const { if (i) return false; u.pm = pm; u.pn = pn; u.ks = 0; return true; }
    DI void a_ready(const pg8::Unit&) const {}
    DI void done(const pg8::Unit&) const {}
    template <class A> DI void preload(A&, int) const {}
    DI size_t aoff(const pg8::Unit& u, const pg8::Gemm& g) const { return (size_t)u.pm * 256 * (size_t)g.lda * 2; }
};
struct P1Order {
    pg8::StaticOrder S; int i0, l8;
    DI void init(int bx, int i0_) { S.init(NT, DINP, 256, bx); i0 = i0_; const int x = bx & 7, k = bx >> 3;
        l8 = (x & 1) ? (k < 24 ? 2048 + 8 * k + x : 2048 + 8 * (k - 8) + x - 1) : (k < 16 ? 2048 + 8 * k + x : -1); }
    DI bool next(int i, pg8::Unit& u) const { const int r = i + i0; if (r > 8 || (r == 8 && l8 < 0)) return false;
        pg8::StaticOrder T = S; T.i0 = 0; if (r == 8) { T.c = l8 - 2048; } return T.next(r, u); }
    DI void a_ready(const pg8::Unit&) const {}
    DI void done(const pg8::Unit&) const {}
    template <class A> DI void preload(A&, int) const {}
    DI size_t aoff(const pg8::Unit& u, const pg8::Gemm& g) const { return (size_t)u.pm * 256 * (size_t)g.lda * 2; }
};
struct P5Order {
    pg8::StaticOrder S;
    DI void init(int M, int N, int G_, int c_) { S.init(M, N, G_, c_); }
    DI bool next(int i, pg8::Unit& u) const {
        if (S.G == 256) { if (i > 1) return false; const int x = S.c & 7, li = S.c >> 3; u.pm = 32 * i + 4 * x + (li & 3); u.pn = li >> 2; u.ks = 0; return true; }
        return S.next(i, u); }
    DI void a_ready(const pg8::Unit&) const {}
    DI void done(const pg8::Unit&) const {}
    template <class A> DI void preload(A&, int) const {}
    DI size_t aoff(const pg8::Unit& u, const pg8::Gemm& g) const { return (size_t)u.pm * 256 * (size_t)g.lda * 2; }
};
struct HalfUnit {
    int pm, pn, ks; const float* part;
    __device__ bool next(int i, pg8::Unit& u) const { if (i) return false; u.pm = pm; u.pn = pn; u.ks = ks; return true; }
    DI void a_ready(const pg8::Unit&) const {}
    DI void done(const pg8::Unit&) const {}
    DI void preload(gf4 (&acc)[2][2][4][2], int tid) const {
        if (part == nullptr) return;
#pragma unroll
        for (int i = 0; i < 32; ++i) acc[i >> 4][(i >> 3) & 1][(i >> 1) & 3][i & 1] = __builtin_nontemporal_load((const gf4*)part + i * NTHREADS + tid);
    }
    DI size_t aoff(const pg8::Unit& u, const pg8::Gemm& g) const { return (size_t)u.pm * 256 * (size_t)g.lda * 2 + (size_t)u.ks * g.K * 2; }
};
struct EpiPartSave {
    static constexpr bool PERM = true;
    float* part;
    DI void operator()(const gf4 (&acc)[2][2][4][2], const pg8::Unit&, int wr, int wc, int fr, int fq) const {
        const int tid = (wr * 4 + wc) * 64 + fq * 16 + fr;
#pragma unroll
        for (int i = 0; i < 32; ++i) __builtin_nontemporal_store(acc[i >> 4][(i >> 3) & 1][(i >> 1) & 3][i & 1], (gf4*)part + i * NTHREADS + tid);
    }
};
struct EpiGateNorm {
    static constexpr bool PERM = true;
    float* out; const bf16* x1b; const bf16* PLb; const float* plss; const float* pg; const float* fg; unsigned* slots; unsigned* cnt; LAS unsigned char* lds;
    DI void operator()(gf4 (&acc)[2][2][4][2], const pg8::Unit& u, int wr, int wc, int fr, int fq) const {
        LAS float* P = (LAS float*)(lds + 131072);
        LAS float* S = (LAS float*)(lds + 135168);
        const int tid = (wr * 4 + wc) * 64 + fr + 16 * fq;
        const int row0 = u.pm * 256 + wr * 64 + fr, col0 = u.pn * 256 + wc * 32 + 8 * fq;
        gf4 g0[2], g1[2];
#pragma unroll
        for (int bj = 0; bj < 2; ++bj) { g0[bj] = *(const gf4*)(pg + col0 + bj * 128); g1[bj] = *(const gf4*)(pg + col0 + bj * 128 + 4); }
        v4u nxa[2], npl[2]; float nps;
        { const size_t off = (size_t)row0 * DM + col0; nxa[0] = *(const v4u*)(x1b + off); nxa[1] = *(const v4u*)(x1b + off + 128); npl[0] = *(const v4u*)(PLb + off); npl[1] = *(const v4u*)(PLb + off + 128); nps = plss[row0]; }
#pragma unroll
        for (int r8 = 0; r8 < 8; ++r8) { const int ai = r8 >> 2, m = r8 & 3;
            const v4u cxa0 = nxa[0], cxa1 = nxa[1], cpl0 = npl[0], cpl1 = npl[1]; const float ps = nps;
            if (r8 < 7) { const int ai2 = (r8 + 1) >> 2, m2 = (r8 + 1) & 3; const int row2 = row0 + ai2 * 128 + m2 * 16; const size_t o2 = (size_t)row2 * DM + col0;
                nxa[0] = *(const v4u*)(x1b + o2); nxa[1] = *(const v4u*)(x1b + o2 + 128); npl[0] = *(const v4u*)(PLb + o2); npl[1] = *(const v4u*)(PLb + o2 + 128); nps = plss[row2]; }
            const float rstd = 1.f / sqrtf(ps * (1.f / DM) + EPSV);
            float s = 0.f;
#pragma unroll
            for (int bj = 0; bj < 2; ++bj) {
                float xa[8]; unpack8(bj ? cxa1 : cxa0, xa);
                float pl[8]; unpack8(bj ? cpl1 : cpl0, pl);
                gf4 v0, v1;
#pragma unroll
                for (int e = 0; e < 4; ++e) { v0[e] = xa[e] + fsigmoid(acc[ai][bj][m][0][e]) * (pl[e] * rstd * g0[bj][e]); v1[e] = xa[4 + e] + fsigmoid(acc[ai][bj][m][1][e]) * (pl[4 + e] * rstd * g1[bj][e]); }
                s += (v0[0] * v0[0] + v0[1] * v0[1]) + (v0[2] * v0[2] + v0[3] * v0[3]) + (v1[0] * v1[0] + v1[1] * v1[1]) + (v1[2] * v1[2] + v1[3] * v1[3]);
                acc[ai][bj][m][0] = v0; acc[ai][bj][m][1] = v1; }
            s += __shfl_xor(s, 16); s += __shfl_xor(s, 32);
            if (fq == 0) P[(ai * 128 + wr * 64 + m * 16 + fr) * 4 + wc] = s; }
        __syncthreads();
        if (tid < 256) { const f32x4 p4 = *(const LAS f32x4*)(P + tid * 4); const float t = (p4.x + p4.y) + (p4.z + p4.w);
            __hip_atomic_store(slots + ((size_t)(u.pm * 256 + tid)) * 8 + u.pn, __float_as_uint(t), __ATOMIC_RELAXED, __HIP_MEMORY_SCOPE_AGENT); }
        asm volatile("s_waitcnt vmcnt(0)" ::: "memory");
        __syncthreads();
        if (tid == 0) {
            unsigned* c = cnt + 64 * u.pm;
            __hip_atomic_fetch_add(c, 1u, __ATOMIC_RELAXED, __HIP_MEMORY_SCOPE_AGENT);
            unsigned sp = 0;
            while (__hip_atomic_load(c, __ATOMIC_RELAXED, __HIP_MEMORY_SCOPE_AGENT) < 8u) { if (++sp > (1u << 24)) break; }
            __builtin_amdgcn_fence(__ATOMIC_ACQUIRE, "agent");
            asm volatile("s_waitcnt vmcnt(0)" ::: "memory");
        }
        __syncthreads();
        if (tid < 256) { float t = 0.f;
#pragma unroll
            for (int k = 0; k < 8; ++k) t += __uint_as_float(__hip_atomic_load(slots + ((size_t)(u.pm * 256 + tid)) * 8 + k, __ATOMIC_RELAXED, __HIP_MEMORY_SCOPE_AGENT));
            S[tid] = 1.f / sqrtf(t * (1.f / DM) + EPSV); }
        __syncthreads();
#pragma unroll
        for (int bj = 0; bj < 2; ++bj) { g0[bj] = *(const gf4*)(fg + col0 + bj * 128); g1[bj] = *(const gf4*)(fg + col0 + bj * 128 + 4); }
#pragma unroll
        for (int ai = 0; ai < 2; ++ai)
#pragma unroll
            for (int m = 0; m < 4; ++m) { const int rl = ai * 128 + wr * 64 + m * 16 + fr; const size_t off = (size_t)(u.pm * 256 + rl) * DM + col0; const float rs = S[rl];
#pragma unroll
                for (int bj = 0; bj < 2; ++bj) { gf4 o0, o1;
#pragma unroll
                    for (int e = 0; e < 4; ++e) { o0[e] = acc[ai][bj][m][0][e] * rs * g0[bj][e]; o1[e] = acc[ai][bj][m][1][e] * rs * g1[bj][e]; }
                    __builtin_nontemporal_store(o0, (gf4*)(out + off + bj * 128)); __builtin_nontemporal_store(o1, (gf4*)(out + off + bj * 128 + 4)); } }
        __syncthreads();
    }
};

DI float log_sigmoid(float z) { return fminf(z, 0.f) - 0.6931471805599453f * __builtin_amdgcn_logf(1.f + ex2(-LOG2E * fabsf(z))); }
DI void phase2_scan(const Ctx& C, LAS unsigned char* lds, int bh) {
    int tid = C.tid(); asm volatile("" : "+v"(tid));
    const int lane = tid & 63, wave = tid >> 6;
    const int b = bh >> 2, h = bh & 3;
    LAS float* red = (LAS float*)lds;
    const float bi = C.b_ig[h], bfg = C.b_fg[h];
    float ig[8], lf[8];
#pragma unroll
    for (int e = 0; e < 8; ++e) { const size_t row = (size_t)b * SEQ + tid * 8 + e; ig[e] = C.gates()[row * 8 + h] + bi; lf[e] = log_sigmoid(C.gates()[row * 8 + 4 + h] + bfg); }
    float cs[8]; cs[0] = lf[0];
#pragma unroll
    for (int e = 1; e < 8; ++e) cs[e] = cs[e - 1] + lf[e];
    float incl = cs[7];
#pragma unroll
    for (int o = 1; o < 64; o <<= 1) { const float t = __shfl_up(incl, o); if (lane >= o) incl += t; }
    if (lane == 63) red[wave] = incl;
    __syncthreads();
    float woff = 0.f;
#pragma unroll
    for (int w = 0; w < 8; ++w) woff += (w < wave) ? red[w] : 0.f;
    const float excl = woff + incl - cs[7];
    float u[8], cm[8];
#pragma unroll
    for (int e = 0; e < 8; ++e) u[e] = ig[e] - (excl + cs[e]);
    cm[0] = u[0];
#pragma unroll
    for (int e = 1; e < 8; ++e) cm[e] = fmaxf(cm[e - 1], u[e]);
    float mincl = cm[7];
#pragma unroll
    for (int o = 1; o < 64; o <<= 1) { const float t = __shfl_up(mincl, o); if (lane >= o) mincl = fmaxf(mincl, t); }
    float mexcl = __shfl_up(mincl, 1); if (lane == 0) mexcl = 0.f;
    if (lane == 63) red[8 + wave] = mincl;
    __syncthreads();
    float wmax = 0.f;
#pragma unroll
    for (int w = 0; w < 8; ++w) wmax = (w < wave) ? fmaxf(wmax, red[8 + w]) : wmax;
    const float base = fmaxf(fmaxf(mexcl, wmax), 0.f);
#pragma unroll
    for (int e = 0; e < 8; ++e) { const size_t o = (size_t)bh * SEQ + tid * 8 + e; C.u2()[o] = u[e] * LOG2E; C.mx2()[o] = fmaxf(base, cm[e]) * LOG2E; }
    __syncthreads();
}
DI void phase2(const Ctx& C, LAS unsigned char* lds) {
    int tid = C.tid(); asm volatile("" : "+v"(tid));
    const int lane = tid & 63, wave = __builtin_amdgcn_readfirstlane(tid >> 6);
    if (C.G == 256) { if ((C.vcu & 31) < 2) phase2_scan(C, lds, (C.vcu >> 5) * 2 + (C.vcu & 31)); }
    else if (C.vcu < 16) phase2_scan(C, lds, C.vcu);
    if (C.G < 16) { for (int bh = C.vcu + C.G; bh < 16; bh += C.G) phase2_scan(C, lds, bh); }
    const int gw = C.vcu * NWAVES + wave, NGW = C.G * NWAVES;
    const int grpl = (C.vcu >> 6) * 256 + (C.vcu & 31) * NWAVES + wave;
    const int itA = grpl * 4 + ((C.vcu >> 5) & 1), itB = itA + 2;
    for (int it0 = gw; it0 < (NT / 16) * 4; it0 += 2 * NGW) {
        v4u raw[2][19];
#pragma unroll
        for (int z = 0; z < 2; ++z) { const int it = (C.G == 256) ? (z ? itB : itA) : it0 + z * NGW; const int grp = it >> 2, chunk = it & 3, c0 = chunk * 512 + lane * 8, t0 = grp * 16; const bool first = (t0 & (SEQ - 1)) == 0;
#pragma unroll
            for (int q = 0; q < 19; ++q) { const int tr = t0 - 3 + q; raw[z][q] = ((q < 3 && first) || it >= (NT / 16) * 4) ? (v4u){0u, 0u, 0u, 0u} : __builtin_nontemporal_load((const v4u*)(C.PROJ() + PO_MQK + (size_t)tr * 2048 + c0)); } }
#pragma unroll
        for (int z = 0; z < 2; ++z) { const int it = (C.G == 256) ? (z ? itB : itA) : it0 + z * NGW; if (it >= (NT / 16) * 4) break;
            const int grp = it >> 2, chunk = it & 3, c0 = chunk * 512 + lane * 8, t0 = grp * 16;
            float w[4][8], bb[8];
#pragma unroll
            for (int j = 0; j < 4; ++j) { const f32x4 a = *(const f32x4*)(C.conv_w + j * 2048 + c0), b2 = *(const f32x4*)(C.conv_w + j * 2048 + c0 + 4);
                w[j][0] = a.x; w[j][1] = a.y; w[j][2] = a.z; w[j][3] = a.w; w[j][4] = b2.x; w[j][5] = b2.y; w[j][6] = b2.z; w[j][7] = b2.w; }
            { const f32x4 a = *(const f32x4*)(C.conv_b + c0), b2 = *(const f32x4*)(C.conv_b + c0 + 4); bb[0] = a.x; bb[1] = a.y; bb[2] = a.z; bb[3] = a.w; bb[4] = b2.x; bb[5] = b2.y; bb[6] = b2.z; bb[7] = b2.w; }
            const bool isk = c0 >= 1024;
            const int ch = c0 & 1023;
            bf16* dst = (isk ? C.KC() : C.QC()) + ((size_t)((t0 >> 12) * 4 + (ch >> 8)) * SEQ + (t0 & (SEQ - 1))) * 256 + (ch & 255);
            const float osc = isk ? 0.0625f : 1.f;
            float a0[8], a1[8], a2[8], a3[8];
            unpack8(raw[z][0], a0); unpack8(raw[z][1], a1); unpack8(raw[z][2], a2);
#pragma unroll
            for (int tt = 0; tt < 16; ++tt) {
                unpack8(raw[z][3 + tt], a3);
                float y[8];
#pragma unroll
                for (int e = 0; e < 8; ++e) { const float v = bb[e] + w[3][e] * a3[e] + w[0][e] * a0[e] + w[1][e] * a1[e] + w[2][e] * a2[e]; y[e] = fsilu(v) * osc; a0[e] = a1[e]; a1[e] = a2[e]; a2[e] = a3[e]; }
                if (isk) *(v4u*)(dst + (size_t)tt * 256) = pack8(y); else __builtin_nontemporal_store(pack8(y), (v4u*)(dst + (size_t)tt * 256));
            }
        }
    }
    const int pgrp = (C.G == 256) ? (C.vcu >> 5) : 0;
    for (int it = (C.G == 256) ? (C.vcu & 31) * NWAVES + wave : gw; it < 256; it += NGW) {
        const float* ps = (it >> 7) ? C.pos_v : C.pos_k; const bf16* wr = C.Wc1T() + (size_t)it * 2048;
        float a = 0.f;
#pragma unroll
        for (int i = 0; i < 4; ++i) { const int k = 8 * (lane + 64 * i); float wv[8]; unpack8(*(const v4u*)(wr + k), wv);
            const f32x4 p0 = *(const f32x4*)(ps + k), p1 = *(const f32x4*)(ps + k + 4);
            a += ((p0.x * wv[0] + p0.y * wv[1]) + (p0.z * wv[2] + p0.w * wv[3])) + ((p1.x * wv[4] + p1.y * wv[5]) + (p1.z * wv[6] + p1.w * wv[7])); }
        a = wave_sum(a);
        if (lane == 0) C.posb()[pgrp * 256 + it] = a; }
}

DI void phase3b(const Ctx& C, LAS unsigned char* lds) {
    int tid = C.tid(); asm volatile("" : "+v"(tid));
    const int lane = tid & 63, wave = __builtin_amdgcn_readfirstlane(tid >> 6);
    LAS float* w2s = (LAS float*)lds;
    LAS float* scr = (LAS float*)(lds + 65536 + wave * 2048);
    __syncthreads();
    for (int i = tid; i < 2 * 128 * 64 / 4; i += NTHREADS) { const f32x4 v = (i < 2048) ? *((const f32x4*)C.ck_w2 + i) : *((const f32x4*)C.cv_w2 + (i - 2048)); *((LAS f32x4*)w2s + i) = v; }
    __syncthreads();
    const int gw = C.vcu * NWAVES + wave, NGW = C.G * NWAVES;
    for (int it = gw; it < 2048; it += NGW) {
        int r0 = it * 4;
        if (C.G == 256) { const int g8 = C.vcu >> 5, jj = (C.vcu & 31) * NWAVES + wave, t4 = jj >> 6; r0 = (((t4 >> 1) * 16 + 2 * g8 + (t4 & 1)) << 8) + (jj & 63) * 4; }
        const LAS float* w2 = w2s + ((r0 >= 4096) ? 128 * 64 : 0);
        { const int idx = lane * 8; const float* hp = C.HIDP() + (size_t)r0 * 128 + idx;
          f32x4 a = {0.f, 0.f, 0.f, 0.f}, b2 = {0.f, 0.f, 0.f, 0.f};
#pragma unroll
          for (int ks = 0; ks < 8; ++ks) { a += *(const f32x4*)(hp + (size_t)ks * 8192 * 128); b2 += *(const f32x4*)(hp + (size_t)ks * 8192 * 128 + 4); }
          const float* pb = C.posb() + ((C.G == 256) ? (C.vcu >> 5) * 256 : 0) + ((r0 >= 4096) ? 128 : 0) + (idx & 127);
          const f32x4 q0 = *(const f32x4*)pb, q1 = *(const f32x4*)(pb + 4);
          const float f[8] = {a.x + q0.x, a.y + q0.y, a.z + q0.z, a.w + q0.w, b2.x + q1.x, b2.y + q1.y, b2.z + q1.z, b2.w + q1.w};
#pragma unroll
          for (int e = 0; e < 8; ++e) scr[idx + e] = fgelu_tanh(f[e]); }
        __builtin_amdgcn_fence(__ATOMIC_RELEASE, "wavefront"); __builtin_amdgcn_wave_barrier(); __builtin_amdgcn_fence(__ATOMIC_ACQUIRE, "wavefront");
        float acc[4] = {0.f, 0.f, 0.f, 0.f};
#pragma unroll 8
        for (int hh = 0; hh < 128; ++hh) { const float w = w2[hh * 64 + lane];
#pragma unroll
            for (int rr = 0; rr < 4; ++rr) acc[rr] += scr[rr * 128 + hh] * w; }
#pragma unroll
        for (int rr = 0; rr < 4; ++rr) C.KVC()[(size_t)(r0 + rr) * 64 + lane] = (((r0 + rr) & 255) == 255) ? (bf16)0 : (bf16)(pk2(acc[rr], 0.f) & 0xffffu);
        __builtin_amdgcn_fence(__ATOMIC_RELEASE, "wavefront"); __builtin_amdgcn_wave_barrier(); __builtin_amdgcn_fence(__ATOMIC_ACQUIRE, "wavefront");
    }
    __syncthreads();
}

DI void qk_tile64(const LAS unsigned char* Kt, const bf16x8 (&qr)[4], f32x16& p0, f32x16& p1, int r32, int hi) {
    const LAS unsigned char* kb = Kt + hi * 1024 + r32 * 16;
    bf16x8 kf[8];
#pragma unroll
    for (int d0 = 0; d0 < 4; ++d0) { kf[2 * d0] = *(const LAS bf16x8*)(kb + d0 * 2048); kf[2 * d0 + 1] = *(const LAS bf16x8*)(kb + d0 * 2048 + 512); }
    __builtin_amdgcn_sched_barrier(0);
#pragma unroll
    for (int d0 = 0; d0 < 4; ++d0) { p0 = MFMA32(kf[2 * d0], qr[d0], p0); p1 = MFMA32(kf[2 * d0 + 1], qr[d0], p1); }
}
DI s16x4 vtr(const LAS unsigned char* p) { return __builtin_bit_cast(s16x4, __builtin_amdgcn_ds_read_tr16_b64_v4i16((LAS s16x4*)p)); }
DI bf16x8 pack_p(const f32x16& p, int s) {
    v4u w; w.x = pk2(p[8 * s + 0], p[8 * s + 1]); w.y = pk2(p[8 * s + 2], p[8 * s + 3]); w.z = pk2(p[8 * s + 4], p[8 * s + 5]); w.w = pk2(p[8 * s + 6], p[8 * s + 7]);
    return __builtin_bit_cast(bf16x8, w);
}
typedef float f32x2v __attribute__((ext_vector_type(2)));
struct Sm { float m, l; f32x16 o0, o1; };
DI void softmax_pv64_fast(const LAS unsigned char* Vt, f32x16& p0, f32x16& p1, Sm& st, LAS float* wsf, int lane, int r32, int hi, bool en, float SC) {
    const LAS unsigned char* vp = Vt + ((lane >> 4) & 1) * 32 + (lane & 3) * 8 + (4 * hi + ((lane & 15) >> 2)) * 64;
    bf16x8 vfr[8];
#pragma unroll
    for (int db = 0; db < 2; ++db)
#pragma unroll
        for (int s = 0; s < 4; ++s) { const s16x4 lo = vtr(vp + db * 4096 + s * 1024), hh = vtr(vp + db * 4096 + s * 1024 + 512); vfr[4 * db + s] = __builtin_shufflevector(lo, hh, 0, 1, 2, 3, 4, 5, 6, 7); }
    __builtin_amdgcn_sched_barrier(0);
    const bool fresh = st.m < -1.0e29f;
    const float refo = fresh ? 0.f : st.m;
    const float scl = en ? SC : 0.f, offo = en ? -refo : NEGV;
    const f32x2v scl2 = {scl, scl}, offo2 = {offo, offo};
    f32x2v a2[8], c2[8];
#pragma unroll
    for (int q = 0; q < 8; ++q) { a2[q] = (f32x2v){p0[2 * q], p0[2 * q + 1]} * scl2 + offo2; c2[q] = (f32x2v){p1[2 * q], p1[2 * q + 1]} * scl2 + offo2; }
    float mx = fmaxf(fmaxf(a2[0].x, a2[0].y), fmaxf(c2[0].x, c2[0].y));
#pragma unroll
    for (int q = 1; q < 8; ++q) { mx = fmaxf(fmaxf(mx, a2[q].x), a2[q].y); mx = fmaxf(fmaxf(mx, c2[q].x), c2[q].y); }
    mx = swap32_max(mx);
    const bool move = (fresh || mx > 8.f) && (mx > -1.0e29f);
    const float delta = move ? mx : 0.f;
    const float alpha = (move && !fresh) ? ex2(-delta) : 1.f;
    st.m = move ? refo + delta : st.m;
    if (__any(delta != 0.f)) {
        const f32x2v d2 = {delta, delta};
#pragma unroll
        for (int q = 0; q < 8; ++q) { a2[q] -= d2; c2[q] -= d2; }
    }
    f32x2v ps2 = {0.f, 0.f};
#pragma unroll
    for (int q = 0; q < 8; ++q) {
        f32x2v ea, ec; ea.x = ex2(a2[q].x); ea.y = ex2(a2[q].y); ec.x = ex2(c2[q].x); ec.y = ex2(c2[q].y);
        p0[2 * q] = ea.x; p0[2 * q + 1] = ea.y; p1[2 * q] = ec.x; p1[2 * q + 1] = ec.y;
        ps2 += ea; ps2 += ec;
    }
    const float ps = ps2.x + ps2.y;
    st.l = st.l * alpha + ps;
    if (__any(alpha != 1.f)) {
        if (hi == 0) wsf[r32] = alpha;
        __builtin_amdgcn_fence(__ATOMIC_RELEASE, "wavefront"); __builtin_amdgcn_wave_barrier(); __builtin_amdgcn_fence(__ATOMIC_ACQUIRE, "wavefront");
#pragma unroll
        for (int k4 = 0; k4 < 4; ++k4) { const f32x4 a = *(const LAS f32x4*)(wsf + 8 * k4 + 4 * hi);
#pragma unroll
            for (int e = 0; e < 4; ++e) { st.o0[4 * k4 + e] *= a[e]; st.o1[4 * k4 + e] *= a[e]; } }
        __builtin_amdgcn_fence(__ATOMIC_RELEASE, "wavefront"); __builtin_amdgcn_wave_barrier(); __builtin_amdgcn_fence(__ATOMIC_ACQUIRE, "wavefront");
    }
    const bf16x8 pa0 = pack_p(p0, 0), pa1 = pack_p(p0, 1), pa2 = pack_p(p1, 0), pa3 = pack_p(p1, 1);
    __builtin_amdgcn_sched_barrier(0);
#pragma unroll
    for (int db = 0; db < 2; ++db) {
        f32x16 o = db ? st.o1 : st.o0;
#pragma unroll
        for (int s = 0; s < 4; ++s) o = MFMA32(s == 0 ? pa0 : (s == 1 ? pa1 : (s == 2 ? pa2 : pa3)), vfr[4 * db + s], o);
        if (db) st.o1 = o; else st.o0 = o;
    }
}
DI void dma_kv64(const bf16* Ksrc, const bf16* Vsrc, unsigned pitch, LAS unsigned char* Kd, LAS unsigned char* Vd, int wid, int lane) {
    glds16s<0>(Ksrc + wid * 8, (unsigned)lane * pitch * 2u, (unsigned)__builtin_amdgcn_readfirstlane(lds_u32(Kd) + wid * 1024));
    glds16s<0>(Vsrc + (size_t)(16 * (wid & 3)) * pitch + (wid >> 2) * 32, ((unsigned)(lane >> 2) * pitch + (lane & 3) * 8) * 2u, (unsigned)__builtin_amdgcn_readfirstlane(lds_u32(Vd) + wid * 1024));
}
DI void ring_wait(int r) { if (r >= 2) WAITBAR(4); else if (r == 1) WAITBAR(2); else WAITBAR(0); }
DI void fold_branch(const Sm& st, float f, f32x16& fin0, f32x16& fin1, LAS float* wsf, int r32, int hi) {
    if (hi == 0) wsf[r32] = f;
    __builtin_amdgcn_fence(__ATOMIC_RELEASE, "wavefront"); __builtin_amdgcn_wave_barrier(); __builtin_amdgcn_fence(__ATOMIC_ACQUIRE, "wavefront");
#pragma unroll
    for (int k4 = 0; k4 < 4; ++k4) { const f32x4 a = *(const LAS f32x4*)(wsf + 8 * k4 + 4 * hi);
#pragma unroll
        for (int e = 0; e < 4; ++e) { fin0[4 * k4 + e] += st.o0[4 * k4 + e] * a[e]; fin1[4 * k4 + e] += st.o1[4 * k4 + e] * a[e]; } }
    __builtin_amdgcn_fence(__ATOMIC_RELEASE, "wavefront"); __builtin_amdgcn_wave_barrier(); __builtin_amdgcn_fence(__ATOMIC_ACQUIRE, "wavefront");
}

DI void nsa_unit(const Ctx& C, LAS unsigned char* lds, int b, int g, int qb, int nqb, bf16x8 (&qpre)[4], bool havepre) {
    int tid = C.tid(); asm volatile("" : "+v"(tid));
    const int lane = tid & 63, wid = __builtin_amdgcn_readfirstlane(tid >> 6), r32 = lane & 31, hi = lane >> 5;
    const int j = wid & 3, th = wid >> 2, head = 4 * g + j;
    const int tl = 32 * th + r32, t = 64 * qb + tl;
    const size_t row0 = (size_t)b * SEQ + 64 * qb;
    LAS unsigned char* Kb = lds;
    LAS unsigned char* Vb = lds + 32768;
    LAS float* impw = (LAS float*)(lds + 65536);
    LAS float* wsf = (LAS float*)(lds + LDS_MISC) + wid * 64;
    LAS unsigned char* selb = lds + LDS_MISC + 2048;
    LAS float* sc = (LAS float*)(lds + 65536);
    LAS float* stg;
    const float SC = 0.125f * LOG2E;
    bf16x8 qr[4];
    if (havepre) {
#pragma unroll
        for (int d0 = 0; d0 < 4; ++d0) qr[d0] = qpre[d0];
    } else { const bf16* qp = C.PROJ() + PO_NQ + ((size_t)(b * 16 + head) * SEQ + t) * 64 + 8 * hi;
#pragma unroll
      for (int d0 = 0; d0 < 4; ++d0) qr[d0] = *(const bf16x8*)(qp + 16 * d0); }
    const bf16* ngp = C.PROJ() + PO_NG + (row0 + tl) * 64 + head * 3;
    const float g0 = bf2f(ngp[0]), g1 = bf2f(ngp[1]), g2 = bf2f(ngp[2]);
    f32x16 fin0, fin1;
#pragma unroll
    for (int r = 0; r < 16; ++r) { fin0[r] = 0.f; fin1[r] = 0.f; }
    const int bg = b * 4 + g;

    const int nkt = ((4 * qb + 2) >> 6) + 1;
    if (!havepre) {
        LBAR();
        for (int kt = 0; kt < nkt; ++kt)
            dma_kv64(C.KVC() + ((size_t)bg * 256 + 64 * kt) * 64, C.KVC() + ((size_t)4096 + bg * 256 + 64 * kt) * 64, 64, Kb + kt * 8192, Vb + kt * 8192, wid, lane);
    }
    for (int idx = lane; idx < 32 * 66; idx += 64) impw[(j * 64 + 32 * th) * 66 + idx] = 0.f;
    WAITBAR(0);
    const int climit = (t >= 31) ? ((t - 31) >> 4) : -1;
    Sm st; st.m = NEGV; st.l = 0.f;
#pragma unroll
    for (int r = 0; r < 16; ++r) { st.o0[r] = 0.f; st.o1[r] = 0.f; }
    LAS float* fwv = (LAS float*)(lds + 139392);
    LAS float* spv = (LAS float*)(lds + 139392 + 4096);
    const bool need_imp = qb >= 16;
    LAS float* myimp = impw + (j * 64 + tl) * 66;
    for (int kt = 0; kt < nkt; ++kt) {
        f32x16 p0, p1;
#pragma unroll
        for (int r = 0; r < 16; ++r) { p0[r] = 0.f; p1[r] = 0.f; }
        qk_tile64(Kb + kt * 8192, qr, p0, p1, r32, hi);
#pragma unroll
        for (int r = 0; r < 16; ++r) { const int c = 64 * kt + crow(r, hi); p0[r] = (c <= climit) ? p0[r] : NEGV; p1[r] = (c + 32 <= climit) ? p1[r] : NEGV; }
        softmax_pv64_fast(Vb + kt * 8192, p0, p1, st, wsf, lane, r32, hi, climit >= 64 * kt, SC);
        if (need_imp) {
            if (hi == 0) fwv[(j * 64 + tl) * 4 + kt] = st.m;
            float mainv[8], nxtv[8], cur[8];
#pragma unroll
            for (int hf = 0; hf < 2; ++hf)
#pragma unroll
                for (int k4 = 0; k4 < 4; ++k4) {
                    const float a0 = hf ? p1[4 * k4] : p0[4 * k4], a1 = hf ? p1[4 * k4 + 1] : p0[4 * k4 + 1], a2 = hf ? p1[4 * k4 + 2] : p0[4 * k4 + 2], a3 = hf ? p1[4 * k4 + 3] : p0[4 * k4 + 3];
                    mainv[4 * hf + k4] = (a0 + a1) + (a2 + 0.5f * a3); nxtv[4 * hf + k4] = 0.5f * a3; }
#pragma unroll
            for (int q = 0; q < 8; ++q) cur[q] = myimp[16 * kt + 8 * (q >> 2) + 2 * (q & 3) + hi];
#pragma unroll
            for (int q = 0; q < 8; ++q) myimp[16 * kt + 8 * (q >> 2) + 2 * (q & 3) + hi] = cur[q] + mainv[q];
            __builtin_amdgcn_fence(__ATOMIC_RELEASE, "wavefront"); __builtin_amdgcn_wave_barrier(); __builtin_amdgcn_fence(__ATOMIC_ACQUIRE, "wavefront");
#pragma unroll
            for (int q = 0; q < 8; ++q) cur[q] = (q == 7 && hi == 1) ? 0.f : myimp[16 * kt + 8 * (q >> 2) + 2 * (q & 3) + hi + 1];
#pragma unroll
            for (int q = 0; q < 8; ++q) { if (q == 7 && hi == 1) { if (kt < 3) spv[(j * 64 + tl) * 3 + kt] = nxtv[7]; } else myimp[16 * kt + 8 * (q >> 2) + 2 * (q & 3) + hi + 1] = cur[q] + nxtv[q]; }
            __builtin_amdgcn_fence(__ATOMIC_RELEASE, "wavefront"); __builtin_amdgcn_wave_barrier(); __builtin_amdgcn_fence(__ATOMIC_ACQUIRE, "wavefront");
        }
    }
    {
        const float l = st.l + __shfl_xor(st.l, 32);
        const float inv_l = (climit >= 0) ? 1.f / l : 0.f;
#pragma unroll
        for (int r = 0; r < 16; ++r) { fin0[r] = 0.f; fin1[r] = 0.f; }
        fold_branch(st, g0 * inv_l, fin0, fin1, wsf, r32, hi);
        if (need_imp && hi == 0) {
            for (int kt = 0; kt < nkt; ++kt) { const float mr = fwv[(j * 64 + tl) * 4 + kt]; fwv[(j * 64 + tl) * 4 + kt] = ex2(mr - st.m) * inv_l; }
        }
    }
    LBAR();
    dma_kv64(C.PROJ() + PO_KV6 + 2 * KVSZ + (size_t)(b * 4 + g) * SEQ * 64, C.PROJ() + PO_KV6 + 3 * KVSZ + (size_t)(b * 4 + g) * SEQ * 64, 64, Kb, Vb, wid, lane);
    {
        const int tok = tid & 63, part = tid >> 6;
        float cand[8];
        {
            float imp[8];
#pragma unroll
            for (int e = 0; e < 8; ++e) imp[e] = 0.f;
            const int kt = part >> 1;
            if (need_imp && kt < nkt) {
#pragma unroll
                for (int jj = 0; jj < 4; ++jj) {
                    const float f = fwv[(jj * 64 + tok) * 4 + kt];
                    const LAS f32x2_t* ip = (const LAS f32x2_t*)(impw + (jj * 64 + tok) * 66 + part * 8);
#pragma unroll
                    for (int q = 0; q < 4; ++q) { const f32x2_t v = ip[q]; imp[2 * q] += v.x * f; imp[2 * q + 1] += v.y * f; }
                    if ((part & 1) == 0 && part >= 2) imp[0] += spv[(jj * 64 + tok) * 3 + kt - 1] * fwv[(jj * 64 + tok) * 4 + kt - 1];
                }
            }
#pragma unroll
            for (int e = 0; e < 8; ++e) { const int n = part * 8 + e;
                const bool forced = (n == 0) || (n == qb) || (n == qb - 1);
                cand[e] = (n <= qb) ? (imp[e] + (forced ? 1000.f : 0.f)) : NEGV; }
        }
        LBAR();
#pragma unroll
        for (int e = 0; e < 8; e += 4) *(LAS f32x4*)(sc + tok * 68 + part * 8 + e) = (f32x4){cand[e], cand[e + 1], cand[e + 2], cand[e + 3]};
        LBAR();
        if (qb < 16) {
            unsigned byte = 0;
#pragma unroll
            for (int e = 0; e < 8; ++e) { const int n = part * 8 + e; if (n <= qb) byte |= (1u << e); }
            selb[tok * 8 + part] = (unsigned char)byte;
        } else {
            unsigned key[8], srt[8], pr[8];
#pragma unroll
            for (int i = 0; i < 8; ++i) { const float c = sc[(wid * 8 + i) * 68 + lane]; key[i] = (lane <= qb) ? ((__float_as_uint(c) & ~63u) | (unsigned)(63 - lane)) : 0u; srt[i] = key[i]; }
#pragma unroll
            for (int k = 2; k <= 64; k <<= 1)
#pragma unroll
                for (int jx = k >> 1; jx > 0; jx >>= 1) {
                    const bool keepmax = (((lane & jx) == 0) == ((lane & k) == 0));
#pragma unroll
                    for (int i = 0; i < 8; ++i) pr[i] = (unsigned)__shfl_xor((int)srt[i], jx);
                    __builtin_amdgcn_sched_barrier(0);
#pragma unroll
                    for (int i = 0; i < 8; ++i) { const unsigned hi_ = srt[i] > pr[i] ? srt[i] : pr[i], lo_ = srt[i] > pr[i] ? pr[i] : srt[i]; srt[i] = keepmax ? hi_ : lo_; }
                    __builtin_amdgcn_sched_barrier(0);
                }
#pragma unroll
            for (int i = 0; i < 8; ++i) { const unsigned T = (unsigned)__builtin_amdgcn_readlane((int)srt[i], 15);
                const unsigned long long m = __ballot((lane <= qb) && (key[i] >= T));
                if (lane == 0) { v2u w; w.x = (unsigned)m; w.y = (unsigned)(m >> 32); *(LAS v2u*)(selb + (wid * 8 + i) * 8) = w; } }
        }
        LBAR();
    }
    unsigned long long mysel, un;
    { const v2u w = *(const LAS v2u*)(selb + tl * 8); mysel = ((unsigned long long)w.y << 32) | w.x;
      const v2u a = *(const LAS v2u*)(selb + lane * 8); unsigned lo = a.x, hh = a.y;
#pragma unroll
      for (int o = 1; o < 64; o <<= 1) { lo |= __shfl_xor(lo, o); hh |= __shfl_xor(hh, o); }
      un = ((unsigned long long)__builtin_amdgcn_readfirstlane(hh) << 32) | (unsigned)__builtin_amdgcn_readfirstlane(lo); }
    LAS float* accF = (LAS float*)(lds + 65536);
#pragma unroll
    for (int r = 0; r < 16; ++r) { const int tok = 32 * th + crow(r, hi); accF[tok * STG_PITCH + j * 64 + r32] = fin0[r]; accF[tok * STG_PITCH + j * 64 + 32 + r32] = fin1[r]; }
#define NSA_FOLD(F) do { const float f_ = (F); if (hi == 0) wsf[r32] = f_; \
        __builtin_amdgcn_fence(__ATOMIC_RELEASE, "wavefront"); __builtin_amdgcn_wave_barrier(); __builtin_amdgcn_fence(__ATOMIC_ACQUIRE, "wavefront"); \
        _Pragma("unroll") for (int k4 = 0; k4 < 4; ++k4) { const f32x4 a_ = *(const LAS f32x4*)(wsf + 8 * k4 + 4 * hi); \
            _Pragma("unroll") for (int e = 0; e < 4; ++e) { const int tok_ = 32 * th + 8 * k4 + 4 * hi + e; \
                accF[tok_ * STG_PITCH + j * 64 + r32] += st.o0[4 * k4 + e] * a_[e]; accF[tok_ * STG_PITCH + j * 64 + 32 + r32] += st.o1[4 * k4 + e] * a_[e]; } } \
        __builtin_amdgcn_fence(__ATOMIC_RELEASE, "wavefront"); __builtin_amdgcn_wave_barrier(); __builtin_amdgcn_fence(__ATOMIC_ACQUIRE, "wavefront"); } while (0)
#define NSA_QK(bo) f32x16 p0, p1; _Pragma("unroll") for (int r = 0; r < 16; ++r) { p0[r] = 0.f; p1[r] = 0.f; } qk_tile64(Kb + (bo), qr, p0, p1, r32, hi)

    {
        const bf16* Kg = C.PROJ() + PO_KV6 + 2 * KVSZ + (size_t)(b * 4 + g) * SEQ * 64;
        const bf16* Vg = C.PROJ() + PO_KV6 + 3 * KVSZ + (size_t)(b * 4 + g) * SEQ * 64;
        st.m = NEGV; st.l = 0.f;
#pragma unroll
        for (int r = 0; r < 16; ++r) { st.o0[r] = 0.f; st.o1[r] = 0.f; }
        unsigned long long um = un, ui = un; const int ntile = __builtin_popcountll(un);
        ui &= ui - 1;
#pragma unroll
        for (int q = 1; q < 3; ++q) if (q < ntile) { const int n = __builtin_ctzll(ui); ui &= ui - 1; dma_kv64(Kg + (size_t)4096 * n, Vg + (size_t)4096 * n, 64, Kb + q * 8192, Vb + q * 8192, wid, lane); }
        for (int i = 0; i < ntile - 1; ++i) {
            const int n = __builtin_ctzll(um); um &= um - 1;
            ring_wait(ntile - 1 - i);
            if (i + 3 < ntile) { const int n2 = __builtin_ctzll(ui); ui &= ui - 1; const int bo2 = ((i + 3) & 3) * 8192; dma_kv64(Kg + (size_t)4096 * n2, Vg + (size_t)4096 * n2, 64, Kb + bo2, Vb + bo2, wid, lane); }
            const bool seln = (mysel >> n) & 1ull;
            if (__any(seln)) { const int bo = (i & 3) * 8192; NSA_QK(bo); softmax_pv64_fast(Vb + bo, p0, p1, st, wsf, lane, r32, hi, seln, SC); }
        }
        {
            const int i = ntile - 1;
            ring_wait(0);
            const int bo = (i & 3) * 8192; NSA_QK(bo);
#pragma unroll
            for (int r = 0; r < 16; ++r) { const int kv = crow(r, hi); p0[r] = (kv <= tl) ? p0[r] : -3.0e38f; p1[r] = (kv + 32 <= tl) ? p1[r] : -3.0e38f; }
            softmax_pv64_fast(Vb + bo, p0, p1, st, wsf, lane, r32, hi, true, SC);
        }
        const float l = st.l + __shfl_xor(st.l, 32);
        NSA_FOLD(g1 / l);
    }
    WAITBAR(0);
    v4u nzv[4];
    { const bf16* nz = C.PROJ() + PO_NZ + ((size_t)(b * 16 + 4 * g + ((tid & 7) >> 1)) * SEQ + 64 * qb + (tid >> 3)) * 64 + (tid & 1) * 32;
#pragma unroll
      for (int q = 0; q < 4; ++q) nzv[q] = *(const v4u*)(nz + 8 * ((q + ((tid & 7) >> 1)) & 3)); }
    {
        const bf16* Kg = C.PROJ() + PO_KV6 + 4 * KVSZ + (size_t)(b * 4 + g) * SEQ * 64;
        const bf16* Vg = C.PROJ() + PO_KV6 + 5 * KVSZ + (size_t)(b * 4 + g) * SEQ * 64;
        st.m = NEGV; st.l = 0.f;
#pragma unroll
        for (int r = 0; r < 16; ++r) { st.o0[r] = 0.f; st.o1[r] = 0.f; }
        const int n0 = qb >= 8 ? qb - 8 : 0; const int ntile = qb - n0 + 1;
#pragma unroll
        for (int q = 0; q < 3; ++q) if (q < ntile) dma_kv64(Kg + (size_t)4096 * (n0 + q), Vg + (size_t)4096 * (n0 + q), 64, Kb + q * 8192, Vb + q * 8192, wid, lane);
        int i = 0;
        if (qb >= 8) {
            ring_wait(ntile - 1);
            if (3 < ntile) dma_kv64(Kg + (size_t)4096 * (n0 + 3), Vg + (size_t)4096 * (n0 + 3), 64, Kb + 3 * 8192, Vb + 3 * 8192, wid, lane);
            NSA_QK(0);
#pragma unroll
            for (int r = 0; r < 16; ++r) { const int kv = crow(r, hi); p0[r] = (kv > tl) ? p0[r] : -3.0e38f; p1[r] = (kv + 32 > tl) ? p1[r] : -3.0e38f; }
            softmax_pv64_fast(Vb, p0, p1, st, wsf, lane, r32, hi, true, SC);
            i = 1;
        }
        for (; i < ntile - 1; ++i) {
            ring_wait(ntile - 1 - i);
            if (i + 3 < ntile) { const int bo2 = ((i + 3) & 3) * 8192; dma_kv64(Kg + (size_t)4096 * (n0 + i + 3), Vg + (size_t)4096 * (n0 + i + 3), 64, Kb + bo2, Vb + bo2, wid, lane); }
            const int bo = (i & 3) * 8192; NSA_QK(bo);
            softmax_pv64_fast(Vb + bo, p0, p1, st, wsf, lane, r32, hi, true, SC);
        }
        {
            ring_wait(0);
            const int bo = ((ntile - 1) & 3) * 8192; NSA_QK(bo);
#pragma unroll
            for (int r = 0; r < 16; ++r) { const int kv = crow(r, hi); p0[r] = (kv <= tl) ? p0[r] : -3.0e38f; p1[r] = (kv + 32 <= tl) ? p1[r] : -3.0e38f; }
            softmax_pv64_fast(Vb + bo, p0, p1, st, wsf, lane, r32, hi, true, SC);
        }
        const float l = st.l + __shfl_xor(st.l, 32);
        NSA_FOLD(g2 / l);
    }
#undef NSA_FOLD
#undef NSA_QK
    LBAR();
#pragma unroll
    for (int q = 0; q < 4; ++q) asm volatile("" :: "v"(nzv[q]));
    if (nqb >= 0) {
        const int nkt2 = ((4 * nqb + 2) >> 6) + 1;
        for (int kt = 0; kt < nkt2; ++kt)
            dma_kv64(C.KVC() + ((size_t)bg * 256 + 64 * kt) * 64, C.KVC() + ((size_t)4096 + bg * 256 + 64 * kt) * 64, 64, Kb + kt * 8192, Vb + kt * 8192, wid, lane);
        const bf16* qp = C.PROJ() + PO_NQ + ((size_t)(b * 16 + head) * SEQ + 64 * nqb + tl) * 64 + 8 * hi;
#pragma unroll
        for (int d0 = 0; d0 < 4; ++d0) qpre[d0] = *(const bf16x8*)(qp + 16 * d0);
    }
    stg = accF;
    {
        const int tok = tid >> 3, seg = tid & 7;
        bf16* dst = C.MIX() + (row0 + tok) * DM + 1024 + g * 256 + seg * 32;
#pragma unroll
        for (int q = 0; q < 4; ++q) { const int qq = (q + (seg >> 1)) & 3;
            float z[8], o[8]; unpack8(nzv[q], z);
            const f32x4 a = *(const LAS f32x4*)(stg + tok * STG_PITCH + seg * 32 + 8 * qq), c = *(const LAS f32x4*)(stg + tok * STG_PITCH + seg * 32 + 8 * qq + 4);
            o[0] = a.x * z[0]; o[1] = a.y * z[1]; o[2] = a.z * z[2]; o[3] = a.w * z[3];
            o[4] = c.x * z[4]; o[5] = c.y * z[5]; o[6] = c.z * z[6]; o[7] = c.w * z[7];
            *(v4u*)(dst + 8 * qq) = pack8(o);
        }
    }
    LBAR();
}

DI void mlstm_delta_unit(const Ctx& C, LAS unsigned char* lds, int bh, int c) {
    int tid = C.tid(); asm volatile("" : "+v"(tid));
    const int lane = tid & 63, wid = __builtin_amdgcn_readfirstlane(tid >> 6), r32 = lane & 31, hi = lane >> 5;
    const int dkw = wid & 3, dvw = wid >> 2, b = bh >> 2, h = bh & 3;
    const size_t rowb = (size_t)b * SEQ + 256 * c;
    const float mend2 = C.mx2()[(size_t)bh * SEQ + 256 * c + 255];
    const float* u2p = C.u2() + (size_t)bh * SEQ + 256 * c;
    const bf16* Kg = C.KC() + ((size_t)bh * SEQ + 256 * c) * 256;
    const bf16* Vg = C.PROJ() + PO_MV + ((size_t)bh * SEQ + 256 * c) * 256;
    LAS float* u2l = (LAS float*)(lds + LDS_MISC + 2048);
    f32x16 acc[2][4];
#pragma unroll
    for (int a = 0; a < 2; ++a)
#pragma unroll
        for (int d = 0; d < 4; ++d)
#pragma unroll
            for (int r = 0; r < 16; ++r) acc[a][d][r] = 0.f;
    float nacc[2] = {0.f, 0.f};
    const unsigned voK_ = ((unsigned)(lane >> 2) * 256u + (lane & 3) * 8u) * 2u, voV_ = voK_;
#define MD_DMA(st, buf) do { const unsigned Kd_ = (unsigned)__builtin_amdgcn_readfirstlane(lds_u32(lds) + (buf) * 65536u + wid * 1024u), Vd_ = Kd_ + 32768u; \
        const bf16* kb_ = Kg + (size_t)(64 * (st) + 16 * (wid & 3)) * 256 + (wid >> 2) * 32; const bf16* vb_ = Vg + (size_t)(64 * (st) + 16 * (wid & 3)) * 256 + (wid >> 2) * 32; \
        glds16s<0>(kb_, voK_, Kd_); glds16s<0>(kb_ + 64, voK_, Kd_ + 8192u); glds16s<0>(kb_ + 128, voK_, Kd_ + 16384u); glds16s<0>(kb_ + 192, voK_, Kd_ + 24576u); \
        glds16s<0>(vb_, voV_, Vd_); glds16s<0>(vb_ + 64, voV_, Vd_ + 8192u); glds16s<0>(vb_ + 128, voV_, Vd_ + 16384u); glds16s<0>(vb_ + 192, voV_, Vd_ + 24576u); \
        if (wid == 0) glds16s<0>(u2p + 64 * (st), (unsigned)lane * 16u, (unsigned)__builtin_amdgcn_readfirstlane(lds_u32(u2l) + (buf) * 1024u)); } while (0)
    WAITBAR(0);
    MD_DMA(0, 0);
    const int vpn = ((lane >> 4) & 1) * 32 + (lane & 3) * 8 + (8 * hi + ((lane & 15) >> 2)) * 64;
    for (int st = 0; st < 4; ++st) {
        WAITBAR(0);
        if (st + 1 < 4) MD_DMA(st + 1, (st + 1) & 1);
        const LAS unsigned char* Kt = lds + (st & 1) * 65536; const LAS unsigned char* Vt = Kt + 32768;
        const LAS float* u2t = u2l + (st & 1) * 256;
#pragma unroll
        for (int ss = 0; ss < 4; ++ss) {
            const f32x4 ua = *(const LAS f32x4*)(u2t + 16 * ss + 8 * hi), ub = *(const LAS f32x4*)(u2t + 16 * ss + 8 * hi + 4);
            float w[8];
#pragma unroll
            for (int e = 0; e < 4; ++e) { w[e] = ex2(ua[e] - mend2); w[4 + e] = ex2(ub[e] - mend2); }
            bf16x8 af[2];
#pragma unroll
            for (int db = 0; db < 2; ++db) {
                const s16x4 lo = vtr(Kt + (2 * dkw + db) * 4096 + ss * 1024 + vpn), h4 = vtr(Kt + (2 * dkw + db) * 4096 + ss * 1024 + vpn + 256);
                float f[8];
#pragma unroll
                for (int e = 0; e < 4; ++e) { f[e] = bf2f((bf16)lo[e]) * w[e]; f[4 + e] = bf2f((bf16)h4[e]) * w[4 + e]; }
                nacc[db] += ((f[0] + f[1]) + (f[2] + f[3])) + ((f[4] + f[5]) + (f[6] + f[7]));
                af[db] = __builtin_bit_cast(bf16x8, pack8(f));
            }
#pragma unroll
            for (int dbv = 0; dbv < 4; ++dbv) {
                const s16x4 lo = vtr(Vt + (4 * dvw + dbv) * 4096 + ss * 1024 + vpn), h4 = vtr(Vt + (4 * dvw + dbv) * 4096 + ss * 1024 + vpn + 256);
                const bf16x8 vf = __builtin_shufflevector(lo, h4, 0, 1, 2, 3, 4, 5, 6, 7);
                acc[0][dbv] = MFMA32(vf, af[0], acc[0][dbv]); acc[1][dbv] = MFMA32(vf, af[1], acc[1][dbv]);
            }
            asm volatile("" ::: "memory");
        }
    }
#undef MD_DMA
    bf16* dsp = (bf16*)C.out + ((size_t)(bh * 16 + c) << 16);
#pragma unroll
    for (int db = 0; db < 2; ++db)
#pragma unroll
        for (int dbv = 0; dbv < 4; ++dbv)
#pragma unroll
            for (int p2 = 0; p2 < 2; ++p2) {
                unsigned a0 = pk2(acc[db][dbv][8 * p2], acc[db][dbv][8 * p2 + 1]), a1 = pk2(acc[db][dbv][8 * p2 + 2], acc[db][dbv][8 * p2 + 3]);
                unsigned b0 = pk2(acc[db][dbv][8 * p2 + 4], acc[db][dbv][8 * p2 + 5]), b1 = pk2(acc[db][dbv][8 * p2 + 6], acc[db][dbv][8 * p2 + 7]);
                { const auto r0 = __builtin_amdgcn_permlane32_swap(a0, b0, false, false); a0 = r0[0]; b0 = r0[1]; const auto r1 = __builtin_amdgcn_permlane32_swap(a1, b1, false, false); a1 = r1[0]; b1 = r1[1]; }
                v4u w; w.x = a0; w.y = a1; w.z = b0; w.w = b1;
                *(v4u*)(dsp + (size_t)(32 * (2 * dkw + db) + r32) * 256 + 32 * (4 * dvw + dbv) + 16 * p2 + 8 * hi) = w; }
#pragma unroll
    for (int db = 0; db < 2; ++db) { const float n = nacc[db] + __shfl_xor(nacc[db], 32); if (dvw == 0 && hi == 0) C.DN()[(size_t)(bh * 16 + c) * 256 + 32 * (2 * dkw + db) + r32] = n; }
    WAITBAR(0);
}
DI void mlstm_scan(const Ctx& C) {
    int tid = C.tid(); asm volatile("" : "+v"(tid));
    const int gt = C.vcu * NTHREADS + tid, NGT = C.G * NTHREADS;
    for (int it = 0; ; ++it) {
        bool isn; int bh; size_t off;
        if (C.G == 256) {
            if (it == 0) { isn = false; bh = gt >> 13; off = (size_t)(gt & 8191) * 8; }
            else if (it == 1 && tid < 2) { isn = true; bh = C.vcu >> 4; off = (size_t)((C.vcu & 15) * 2 + tid) * 8; }
            else break;
        } else { const int e8 = gt + it * NGT; if (e8 >= 16 * 8192 + 512) break;
            isn = e8 >= 16 * 8192; bh = isn ? ((e8 - 16 * 8192) >> 5) : (e8 >> 13); off = isn ? (size_t)((e8 - 16 * 8192) & 31) * 8 : (size_t)(e8 & 8191) * 8; }
        f32x4 ld[15][2];
        if (isn) { const float* src = C.DN() + (size_t)bh * 16 * 256 + off;
#pragma unroll
            for (int c = 0; c < 15; ++c) { ld[c][0] = *(const f32x4*)(src + c * 256); ld[c][1] = *(const f32x4*)(src + c * 256 + 4); } }
        else { const bf16* src = (const bf16*)C.out + ((size_t)bh * 16 << 16) + off;
#pragma unroll
            for (int c = 0; c < 15; ++c) { float f[8]; unpack8(*(const v4u*)(src + (size_t)c * 65536), f); ld[c][0] = (f32x4){f[0], f[1], f[2], f[3]}; ld[c][1] = (f32x4){f[4], f[5], f[6], f[7]}; } }
        float mr[16]; mr[0] = 0.f;
#pragma unroll
        for (int c = 1; c < 16; ++c) mr[c] = C.mx2()[(size_t)bh * SEQ + 256 * c - 1];
        f32x4 s0 = {0.f, 0.f, 0.f, 0.f}, s1 = {0.f, 0.f, 0.f, 0.f};
#pragma unroll
        for (int c = 0; c < 15; ++c) {
            const float d = ex2(mr[c] - mr[c + 1]);
            s0 = s0 * d + ld[c][0]; s1 = s1 * d + ld[c][1];
            if (isn) { float* dst = C.NS() + (size_t)(bh * 16 + c + 1) * 256 + off; *(f32x4*)dst = s0; *(f32x4*)(dst + 4) = s1; }
            else { v4u w; w.x = pk2(s0[0], s0[1]); w.y = pk2(s0[2], s0[3]); w.z = pk2(s1[0], s1[1]); w.w = pk2(s1[2], s1[3]);
                   *(v4u*)(C.SB() + ((size_t)(bh * 16 + c + 1) << 16) + off) = w; }
        }
    }
}
DI void mlstm_out_unit(const Ctx& C, LAS unsigned char* lds, int b, int h, int iq) {
    int tid = C.tid(); asm volatile("" : "+v"(tid));
    const int lane = tid & 63, wid = __builtin_amdgcn_readfirstlane(tid >> 6), r32 = lane & 31, hi = lane >> 5;
    const int rg = wid & 3, dvh = wid >> 2, bh = b * 4 + h, c = iq >> 1;
    const int ql = 32 * rg + r32, qabs = 128 * iq + ql;
    const size_t rowb = (size_t)b * SEQ;
    LAS float* wsf = (LAS float*)(lds + LDS_MISC) + wid * 64;
    LAS float* u2l = (LAS float*)(lds + LDS_MISC + 2048);
    LAS float* nl = (LAS float*)(lds + LDS_MISC + 5120);
    LAS float* stg = (LAS float*)lds;
    const float* u2p = C.u2() + (size_t)bh * SEQ;
    f32x16 o[4];
#pragma unroll
    for (int d = 0; d < 4; ++d)
#pragma unroll
        for (int r = 0; r < 16; ++r) o[d][r] = 0.f;
    float den = 0.f, den_i = 0.f;
    const int nintra = 2 * (iq & 1) + 2, tt0 = 4 * c;
    const bf16* Kg = C.KC() + (size_t)bh * SEQ * 256;
    const bf16* Vg = C.PROJ() + PO_MV + (size_t)bh * SEQ * 256;
    const bf16* Sg = C.SB() + ((size_t)(bh * 16 + c) << 16);
    const float* ng = C.NS() + (size_t)(bh * 16 + c) * 256;
    const unsigned voK_ = (unsigned)lane * 512u, voS_ = ((unsigned)(lane >> 2) * 256u + (lane & 3) * 8u) * 2u, voV_ = voS_;
#define ML_K(tt, R) do { const unsigned Kd_ = (unsigned)__builtin_amdgcn_readfirstlane(lds_u32(lds) + (R) * 32768u + wid * 1024u); const bf16* kb_ = Kg + (size_t)(64 * (tt)) * 256 + wid * 8; \
        glds16s<0>(kb_, voK_, Kd_); glds16s<0>(kb_ + 64, voK_, Kd_ + 8192u); glds16s<0>(kb_ + 128, voK_, Kd_ + 16384u); glds16s<0>(kb_ + 192, voK_, Kd_ + 24576u); } while (0)
#define ML_V(tt, R) do { const unsigned Vd_ = (unsigned)__builtin_amdgcn_readfirstlane(lds_u32(lds) + (R) * 32768u + wid * 1024u); const bf16* vb_ = Vg + (size_t)(64 * (tt) + 16 * (wid & 3)) * 256 + (wid >> 2) * 32; \
        glds16s<0>(vb_, voV_, Vd_); glds16s<0>(vb_ + 64, voV_, Vd_ + 8192u); glds16s<0>(vb_ + 128, voV_, Vd_ + 16384u); glds16s<0>(vb_ + 192, voV_, Vd_ + 24576u); } while (0)
#define ML_S(sl, R) do { const unsigned Vd_ = (unsigned)__builtin_amdgcn_readfirstlane(lds_u32(lds) + (R) * 32768u + wid * 1024u); const bf16* sb_ = Sg + (size_t)(64 * (sl) + 16 * (wid & 3)) * 256 + (wid >> 2) * 32; \
        glds16s<0>(sb_, voS_, Vd_); glds16s<0>(sb_ + 64, voS_, Vd_ + 8192u); glds16s<0>(sb_ + 128, voS_, Vd_ + 16384u); glds16s<0>(sb_ + 192, voS_, Vd_ + 24576u); } while (0)
    LAS float* gnl = (LAS float*)(lds + LDS_MISC + 6144);
    if (wid == 0) glds16s<0>(u2p + 256 * c, (unsigned)lane * 16u, (unsigned)__builtin_amdgcn_readfirstlane(lds_u32(u2l)));
    if (wid == 2) glds16s<0>(C.m_norm_g + h * 256, (unsigned)lane * 16u, (unsigned)__builtin_amdgcn_readfirstlane(lds_u32(gnl)));
    if (c >= 1) {
        if (wid == 1) glds16s<0>(ng, (unsigned)lane * 16u, (unsigned)__builtin_amdgcn_readfirstlane(lds_u32(nl)));
        ML_S(0, 0); ML_S(1, 1); ML_S(2, 2); ML_S(3, 3);
    } else {
        ML_K(tt0, 0); ML_V(tt0, 1); ML_K(tt0 + 1, 2);
    }
    bf16x8 qf[16];
    { const bf16* qp = C.QC() + ((size_t)bh * SEQ + qabs) * 256 + 8 * hi;
#pragma unroll
      for (int ks = 0; ks < 16; ++ks) qf[ks] = *(const bf16x8*)(qp + 16 * ks); }
    const float mx2 = C.mx2()[(size_t)bh * SEQ + qabs];
    const float mref2 = (c >= 1) ? C.mx2()[(size_t)bh * SEQ + 256 * c - 1] : 0.f;
#define ML_USEQ() do { _Pragma("unroll") for (int ks = 0; ks < 16; ++ks) asm volatile("" :: "v"(qf[ks])); asm volatile("" :: "v"(mx2), "v"(mref2)); } while (0)
    if (c >= 1) {
        const int vpn = ((lane >> 4) & 1) * 32 + (lane & 3) * 8 + (8 * hi + ((lane & 15) >> 2)) * 64;
#pragma unroll
        for (int k = 0; k < 4; ++k) {
            if (k == 0) { WAITBAR(12); ML_USEQ(); } else WAITBAR(8);
            if (k == 1) ML_K(tt0, 0); else if (k == 2) ML_V(tt0, 1); else if (k == 3) ML_K(tt0 + 1, 2);
            const LAS unsigned char* Vt = lds + k * 32768 + (4 * dvh) * 4096 + vpn;
#pragma unroll
            for (int s = 0; s < 4; ++s)
#pragma unroll
                for (int db = 0; db < 4; ++db) {
                    const s16x4 lo = vtr(Vt + db * 4096 + s * 1024), h4 = vtr(Vt + db * 4096 + s * 1024 + 256);
                    const bf16x8 sf = __builtin_shufflevector(lo, h4, 0, 1, 2, 3, 4, 5, 6, 7);
                    o[db] = MFMA32(qf[4 * k + s], sf, o[db]);
                    if (db == 3) asm volatile("" ::: "memory");
                }
        }
        float dq = 0.f;
#pragma unroll
        for (int ks = 0; ks < 16; ++ks) { float qv[8]; unpack8(__builtin_bit_cast(v4u, qf[ks]), qv);
            const f32x4 na = *(const LAS f32x4*)(nl + 16 * ks + 8 * hi), nb = *(const LAS f32x4*)(nl + 16 * ks + 8 * hi + 4);
            dq += ((qv[0] * na[0] + qv[1] * na[1]) + (qv[2] * na[2] + qv[3] * na[3])) + ((qv[4] * nb[0] + qv[5] * nb[1]) + (qv[6] * nb[2] + qv[7] * nb[3])); }
        dq += __shfl_xor(dq, 32);
        const float fq = ex2(mref2 - mx2);
        den_i = fq * dq;
        if (hi == 0) wsf[r32] = fq;
        __builtin_amdgcn_fence(__ATOMIC_RELEASE, "wavefront"); __builtin_amdgcn_wave_barrier(); __builtin_amdgcn_fence(__ATOMIC_ACQUIRE, "wavefront");
#pragma unroll
        for (int k4 = 0; k4 < 4; ++k4) { const f32x4 a = *(const LAS f32x4*)(wsf + 8 * k4 + 4 * hi);
#pragma unroll
            for (int e = 0; e < 4; ++e)
#pragma unroll
                for (int db = 0; db < 4; ++db) o[db][4 * k4 + e] *= a[e]; }
        __builtin_amdgcn_fence(__ATOMIC_RELEASE, "wavefront"); __builtin_amdgcn_wave_barrier(); __builtin_amdgcn_fence(__ATOMIC_ACQUIRE, "wavefront");
    }
    for (int i = 0; i < nintra; ++i) {
        const int tt = tt0 + i;
        if (i == 0) { WAITBAR(4); if (c == 0) ML_USEQ(); ML_V(tt0 + 1, 3); }
        else { WAITBAR(0); if (i + 1 < nintra) { ML_K(tt + 1, 2 * ((i + 1) & 1)); ML_V(tt + 1, 2 * ((i + 1) & 1) + 1); } }
        const LAS unsigned char* Kt = lds + (i & 1) * 65536; const LAS unsigned char* Vt = Kt + 32768;
        const LAS float* u2t = u2l + 64 * i;
        const int kv0 = 64 * tt - 128 * iq;
        if (kv0 > 32 * rg + 31) continue;
        const int lim = ql - kv0;
        const LAS unsigned char* vp = Vt + (4 * dvh) * 4096 + ((lane >> 4) & 1) * 32 + (lane & 3) * 8 + (4 * hi + ((lane & 15) >> 2)) * 64;
#pragma unroll
        for (int hf = 0; hf < 2; ++hf) {
            f32x16 p;
#pragma unroll
            for (int r = 0; r < 16; ++r) p[r] = 0.f;
            { const LAS unsigned char* kb = Kt + hi * 1024 + r32 * 16 + hf * 512;
#pragma unroll
              for (int ks = 0; ks < 16; ++ks) { const bf16x8 b0 = *(const LAS bf16x8*)(kb + ks * 2048); p = MFMA32(b0, qf[ks], p); } }
            float ps = 0.f;
#pragma unroll
            for (int k4 = 0; k4 < 4; ++k4) {
                const f32x4 ua = *(const LAS f32x4*)(u2t + 32 * hf + 8 * k4 + 4 * hi);
#pragma unroll
                for (int e = 0; e < 4; ++e) { const int r = 4 * k4 + e, kv = 32 * hf + 8 * k4 + 4 * hi + e;
                    const float wa = (kv <= lim) ? ex2(ua[e] - mx2) * p[r] : 0.f; p[r] = wa; ps += wa; }
            }
            den += ps;
            const bf16x8 pa0 = pack_p(p, 0), pa1 = pack_p(p, 1);
#pragma unroll
            for (int db = 0; db < 4; ++db) {
#pragma unroll
                for (int s = 0; s < 2; ++s) {
                    const s16x4 lo = vtr(vp + db * 4096 + (2 * hf + s) * 1024), hh = vtr(vp + db * 4096 + (2 * hf + s) * 1024 + 512);
                    const bf16x8 vf = __builtin_shufflevector(lo, hh, 0, 1, 2, 3, 4, 5, 6, 7);
                    o[db] = MFMA32(s == 0 ? pa0 : pa1, vf, o[db]);
                }
            }
        }
    }
#undef ML_K
#undef ML_V
#undef ML_S
#undef ML_USEQ
    const int erow = tid >> 2, eseg = tid & 3;
    const size_t grow = rowb + 128 * iq + erow;
    v4u mgv[8];
    { const bf16* mg = C.PROJ() + PO_MG + ((size_t)bh * SEQ + 128 * iq + erow) * 256 + eseg * 64;
#pragma unroll
      for (int q = 0; q < 8; ++q) mgv[q] = *(const v4u*)(mg + 8 * ((q + 2 * eseg) & 7)); }
    const LAS float* gn = gnl + eseg * 64;
    den += __shfl_xor(den, 32);
    den += den_i;
    const float f = 1.f / fmaxf(fabsf(den), 1.f);
    if (hi == 0) wsf[r32] = f;
    __builtin_amdgcn_fence(__ATOMIC_RELEASE, "wavefront"); __builtin_amdgcn_wave_barrier(); __builtin_amdgcn_fence(__ATOMIC_ACQUIRE, "wavefront");
    float fr[16];
#pragma unroll
    for (int k4 = 0; k4 < 4; ++k4) { const f32x4 a = *(const LAS f32x4*)(wsf + 8 * k4 + 4 * hi); fr[4 * k4] = a.x; fr[4 * k4 + 1] = a.y; fr[4 * k4 + 2] = a.z; fr[4 * k4 + 3] = a.w; }
    LBAR();
#pragma unroll
    for (int db = 0; db < 4; ++db)
#pragma unroll
        for (int r = 0; r < 16; ++r) stg[(32 * rg + crow(r, hi)) * STG_PITCH + 128 * dvh + 32 * db + r32] = o[db][r] * fr[r];
    LBAR();
    {
        const LAS float* sp = stg + erow * STG_PITCH + eseg * 64;
        f32x4 hvv[16];
#pragma unroll
        for (int q = 0; q < 16; ++q) hvv[q] = *(const LAS f32x4*)(sp + 4 * ((q + 4 * eseg) & 15));
        float s1 = 0.f;
#pragma unroll
        for (int q = 0; q < 16; ++q) s1 += (hvv[q].x + hvv[q].y) + (hvv[q].z + hvv[q].w);
        s1 += __shfl_xor(s1, 1); s1 += __shfl_xor(s1, 2);
        const float mu = s1 * (1.f / 256.f);
        float s2 = 0.f;
#pragma unroll
        for (int q = 0; q < 16; ++q) { const float d0 = hvv[q].x - mu, d1 = hvv[q].y - mu, d2 = hvv[q].z - mu, d3 = hvv[q].w - mu; s2 += (d0 * d0 + d1 * d1) + (d2 * d2 + d3 * d3); }
        s2 += __shfl_xor(s2, 1); s2 += __shfl_xor(s2, 2);
        const float rstd = 1.f / sqrtf(s2 * (1.f / 256.f) + EPSV);
        bf16* dst = C.MIX() + grow * DM + h * 256 + eseg * 64;
#pragma unroll
        for (int q = 0; q < 8; ++q) { const int qq = (q + 2 * eseg) & 7;
            float vg[8], y[8]; unpack8(mgv[q], vg);
            const f32x4 a = hvv[2 * q], cc = hvv[2 * q + 1];
            const f32x4 ga = *(const LAS f32x4*)(gn + 8 * qq), gc = *(const LAS f32x4*)(gn + 8 * qq + 4);
            const float hv[8] = {a.x, a.y, a.z, a.w, cc.x, cc.y, cc.z, cc.w}, gg[8] = {ga.x, ga.y, ga.z, ga.w, gc.x, gc.y, gc.z, gc.w};
#pragma unroll
            for (int e = 0; e < 8; ++e) y[e] = (hv[e] - mu) * rstd * gg[e] * vg[e];
            *(v4u*)(dst + 8 * qq) = pack8(y);
        }
    }
    LBAR();
}

struct Args { const void* in[21]; float* out; unsigned char* ws; };
__global__ void __launch_bounds__(NTHREADS, 2) mega_fwd(Args a) {
    extern __shared__ __attribute__((aligned(16))) unsigned char lds_raw[];
    LAS unsigned char* lds = (LAS unsigned char*)lds_raw;
    cg::grid_group grid = cg::this_grid();
    Ctx C;
    C.x = (const float*)a.in[0]; C.p = (const float*)a.in[1]; C.positions = (const int*)a.in[2]; C.norm_g = (const float*)a.in[3]; C.w_in = (const float*)a.in[4];
    C.conv_w = (const float*)a.in[5]; C.conv_b = (const float*)a.in[6]; C.b_ig = (const float*)a.in[7]; C.b_fg = (const float*)a.in[8]; C.m_norm_g = (const float*)a.in[9];
    C.pos_k = (const float*)a.in[10]; C.pos_v = (const float*)a.in[11]; C.ck_w1 = (const float*)a.in[12]; C.ck_w2 = (const float*)a.in[13]; C.cv_w1 = (const float*)a.in[14]; C.cv_w2 = (const float*)a.in[15];
    C.w_out = (const float*)a.in[16]; C.gate_w = (const float*)a.in[17]; C.ple_w = (const float*)a.in[18]; C.ple_g = (const float*)a.in[19]; C.final_g = (const float*)a.in[20];
    C.out = a.out; C.ws = a.ws;
    unsigned char* ws = a.ws;
    if (threadIdx.x < 8) ((volatile LAS unsigned*)(lds + LDS_MISC + 4096))[threadIdx.x] = 0u;
    __syncthreads();
    C.wbase = (int)__builtin_amdgcn_readfirstlane((int)threadIdx.x) & ~63;
    XcdBarrier bar = xcd_barrier_post((unsigned*)ws, (volatile LAS unsigned*)(lds + LDS_MISC + 4096), C.tid() == 0);
#define GSYNC() xcd_barrier(bar, C.tid() == 0)
    C.G = gridDim.x; { const int bx = blockIdx.x; C.vcu = (C.G % 8 == 0) ? (bx % 8) * (C.G / 8) + bx / 8 : bx; }

#ifndef PROBE_SEL
#define PROBE_SEL 0
#endif
#if PROBE_SEL
    unsigned long long ts_[12]; int nts_ = 0;
#define STAMP() do { ts_[nts_++] = __builtin_amdgcn_s_memrealtime(); } while (0)
#else
#define STAMP() do { } while (0)
#endif
    STAMP();
#ifndef PHMASK
#define PHMASK 0xffff
#endif
#if PHMASK & 1
    phase0(C, lds);
#endif
    if (a.ws == nullptr) grid.sync();
    if (C.tid() == 0) __hip_atomic_fetch_or((unsigned*)(ws + 16384) + 64 * ((int)blockIdx.x & 7) + 40, 1u << xb_xcc_id(), __ATOMIC_RELAXED, __HIP_MEMORY_SCOPE_AGENT);
    GSYNC(); STAMP();
    bool loc_ok;
    { unsigned all = 0u, okb = (C.G == 256) ? 1u : 0u;
      for (int k = 0; k < 8; ++k) { const unsigned mk = xb_ld((unsigned*)(ws + 16384) + 64 * k + 40); okb &= (__builtin_popcount(mk) == 1) ? 1u : 0u; all |= mk; }
      okb &= (__builtin_popcount(all) == 8) ? 1u : 0u;
      loc_ok = __builtin_amdgcn_readfirstlane((int)okb) != 0; }
#define LSYNC() do { if (loc_ok) xcd_barrier_local(bar, C.tid() == 0); else xcd_barrier(bar, C.tid() == 0); } while (0)
#if PHMASK & 2
    { pg8::Gemm g{C.XN(), C.WinT(), NT, DINP, DM, DM, DM};
      EpiProj E{C.PROJ(), C.gates(), C.rope()};
      const int bx = (int)blockIdx.x;
      if (C.G == 256) {
          if (bx & 1) {
              P1Order S0; S0.init(bx, 0); pg8::Unit u0; S0.next(0, u0);
              float* part = (float*)(C.ws + WS_MIX) + (size_t)(bx >> 1) * 65536;
              int kh = DM / 2; asm volatile("" : "+s"(kh));
              pg8::Gemm gh{C.XN(), C.WinT(), NT, DINP, kh, DM, DM};
              { HalfUnit H{u0.pm, u0.pn, 0, nullptr}; EpiPartSave EP{part}; pg8::gemm_phase<EpiPartSave, HalfUnit, true, true>(lds, gh, H, EP, C.tid()); }
              { P1Order S; S.init(bx, 1); pg8::gemm_phase<EpiProj, P1Order, true, true>(lds, g, S, E, C.tid()); }
              { HalfUnit H{u0.pm, u0.pn, 1, part}; pg8::gemm_phase<EpiProj, HalfUnit, true, true>(lds, gh, H, E, C.tid()); }
          } else {
              P1Order S; S.init(bx, 0);
              pg8::gemm_phase<EpiProj, P1Order, true, true>(lds, g, S, E, C.tid());
              if ((bx >> 3) >= 16) late_weights(C, lds, ((bx >> 3) - 16) * 4 + ((bx & 7) >> 1), 64);
          }
      } else {
          pg8::StaticOrder S; S.init(NT, DINP, C.G, bx);
          pg8::gemm_phase<EpiProj, pg8::StaticOrder, true, true>(lds, g, S, E, C.tid());
          late_weights(C, lds, bx, C.G);
      }
    }
#endif
    GSYNC(); STAMP();
#if PHMASK & 4
    phase2(C, lds);
#endif
    LSYNC(); STAMP();
#if PHMASK & 8
    { int kc = 256; asm volatile("" : "+s"(kc)); pg8::Gemm g{C.PROJ() + PO_KV6, C.Wc1T(), 8192, 256, kc, DM, 1024}; CmpOrder S; S.init(C.G, (int)blockIdx.x);
      EpiCmpPart E{C.HIDP()};
      pg8::gemm_phase<EpiCmpPart, CmpOrder, true, true>(lds, g, S, E, C.tid()); }
#endif
#if PHMASK & 32
    for (int v = C.vcu; v < 256; v += C.G) mlstm_delta_unit(C, lds, v >> 4, v & 15);
#endif
    LSYNC(); STAMP();
#if PHMASK & 16
    phase3b(C, lds);
#endif
#if PHMASK & 32
    mlstm_scan(C);
#endif
    LSYNC(); STAMP();
    for (int v = C.vcu; v < 256; v += C.G) {
        const int bg = v >> 4, s = v & 15, b = bg >> 2, gh = bg & 3;
#if PROBE_SEL == 7
        unsigned long long tm0 = __builtin_amdgcn_s_memrealtime();
#endif
        for (int ph = 0; ph < 2; ++ph) {
            if ((ph == 0) != ((v & 1) != 0)) {
#if PHMASK & 32
                for (int k = 0; k < 2; ++k) mlstm_out_unit(C, lds, b, gh, 2 * s + k);
#endif
            } else {
#if PHMASK & 64
                { bf16x8 qpre[4];
#pragma unroll
                  for (int d0 = 0; d0 < 4; ++d0) qpre[d0] = __builtin_bit_cast(bf16x8, (v4u){0u, 0u, 0u, 0u});
                  const unsigned quad = __builtin_amdgcn_readfirstlane((s == 0 ? 0x0910243fu : (s == 1 ? 0x0c161d3eu : (s == 2 ? 0x000e3a3du : (s == 3 ? 0x040a373cu : (s == 4 ? 0x1215183bu : (s == 5 ? 0x11141c39u : (s == 6 ? 0x06172938u : (s == 7 ? 0x02232636u : (s == 8 ? 0x01193335u : (s == 9 ? 0x051e2734u : (s == 10 ? 0x03202a32u : (s == 11 ? 0x081b2831u : (s == 12 ? 0x0d132c30u : (s == 13 ? 0x0722252fu : (s == 14 ? 0x0f1f212eu : (s == 15 ? 0x0b1a2b2du : 0u)))))))))))))))));
                  for (int k = 0; k < 4; ++k) { const int qbk = (int)((quad >> (8 * k)) & 0xffu), nqb = k < 3 ? (int)((quad >> (8 * k + 8)) & 0xffu) : -1;
                      nsa_unit(C, lds, b, gh, qbk, nqb, qpre, k > 0); } }
#endif
            }
        }
#if PROBE_SEL == 7
        unsigned long long tm2 = __builtin_amdgcn_s_memrealtime();
        ts_[8] = 0; ts_[9] = tm2 - tm1; ts_[4] = 0; ts_[5] = tm1 - tm0;
#endif
    }
    GSYNC(); STAMP();
    for (int ph = 0; ph < 2; ++ph) {
        if ((ph == 0) != ((blockIdx.x & 1) != 0)) {
#if PHMASK & 128
            pg8::Gemm g{C.MIX(), C.WoutT(), NT, DM, DM, DM, DM}; P5Order S; S.init(NT, DM, C.G, (int)blockIdx.x);
            EpiX1 E{C.x, C.X1B()};
            pg8::gemm_phase<EpiX1, P5Order, true, true>(lds, g, S, E, C.tid());
#endif
        } else {
#if PHMASK & 256
            int kple = PLE; asm volatile("" : "+s"(kple)); pg8::Gemm g{C.PB(), C.WpleT(), NT, DM, kple, PLE, PLE}; P5Order S; S.init(NT, DM, C.G, (int)blockIdx.x);
            EpiPl E{C.PL(), C.plss()};
            pg8::gemm_phase<EpiPl, P5Order, true, true>(lds, g, S, E, C.tid());
#endif
        }
    }
    LSYNC(); STAMP();
#if PHMASK & 512
    for (int rnd = 1; rnd >= 0; --rnd) {
        pg8::Gemm g{C.X1B(), C.WgateT(), NT, DM, DM, DM, DM}; OneUnit S{32 * rnd + 4 * ((int)blockIdx.x & 7) + (((int)blockIdx.x >> 3) & 3), (int)blockIdx.x >> 5};
        EpiGateNorm E{C.out, C.X1B(), C.PL(), C.plss(), C.ple_g, C.final_g, (unsigned*)C.x2ss(), (unsigned*)(C.ws + 16384), lds};
        pg8::gemm_phase<EpiGateNorm, OneUnit, true, true>(lds, g, S, E, C.tid());
    }
#endif
    STAMP(); STAMP();
#if PROBE_SEL
    STAMP();
    __syncthreads();
#if PROBE_SEL == 6
    unsigned long long tq0 = __builtin_amdgcn_s_memrealtime();
    grid.sync(); grid.sync(); grid.sync(); grid.sync();
    unsigned long long tq1 = __builtin_amdgcn_s_memrealtime();
    ts_[8] = tq0; ts_[9] = tq1;
#endif
    if (blockIdx.x == 0) {
        float t1, t2; float sc1 = 0.01f, sc2 = 0.005f;
        if (PROBE_SEL == 1) { t1 = (float)(ts_[2] - ts_[1]); t2 = (float)(ts_[6] - ts_[5]); }
        else if (PROBE_SEL == 2) { t1 = (float)(ts_[7] - ts_[6]); t2 = (float)(ts_[8] - ts_[7]); }
        else if (PROBE_SEL == 3) { t1 = (float)(ts_[1] - ts_[0]); t2 = (float)(ts_[5] - ts_[2]); }
        else if (PROBE_SEL == 4) { t1 = (float)(ts_[3] - ts_[2]); t2 = (float)(ts_[4] - ts_[3]); sc1 = 0.1f; sc2 = 0.025f; }
        else if (PROBE_SEL == 8) { t1 = (float)(ts_[9] - ts_[0]); t2 = 0.f; sc1 = 0.001f; sc2 = 0.01f; }
        else if (PROBE_SEL == 7) { t1 = (float)(ts_[9] - ts_[8]); t2 = (float)(ts_[5] - ts_[4]); sc1 = 0.01f; sc2 = 0.005f; }
        else { t1 = (float)(ts_[9] - ts_[8]); t2 = (float)(ts_[5] - ts_[4]); sc1 = 0.1f; sc2 = 0.025f; }
        const float d1 = t1 * 0.01f * sc1;
        const float d2 = t2 * 0.01f * sc2;
        if (C.tid() == 0) C.out[0] += d1;
        for (int i = C.tid(); i < DM; i += NTHREADS) C.out[DM + i] += d2;
    }
#endif
}

extern "C" void kernel_launch(void* const* d_in, const int* in_sizes, int n_in, void* d_out, int out_size, void* d_ws, size_t ws_size, hipStream_t stream) {
    static int grid = 0;
    if (grid == 0) {
        if (n_in != 21 || in_sizes[0] != NT * DM || out_size != NT * DM || ws_size < WS_END) {
            fprintf(stderr, "kernel_launch: unexpected problem (n_in %d, in0 %d, out %d, ws %zu); nothing launched\n", n_in, n_in > 0 ? in_sizes[0] : -1, out_size, ws_size); grid = -1; return; }
        int dev = 0, cus = 0, per_cu = 0;
        if (hipGetDevice(&dev) != hipSuccess || hipDeviceGetAttribute(&cus, hipDeviceAttributeMultiprocessorCount, dev) != hipSuccess) { grid = -1; return; }
        if (hipFuncSetAttribute((const void*)mega_fwd, hipFuncAttributeMaxDynamicSharedMemorySize, LDS_BYTES) != hipSuccess) { fprintf(stderr, "kernel_launch: hipFuncSetAttribute failed\n"); grid = -1; return; }
        if (hipOccupancyMaxActiveBlocksPerMultiprocessor(&per_cu, (const void*)mega_fwd, NTHREADS, LDS_BYTES) != hipSuccess || per_cu < 1) {
            fprintf(stderr, "kernel_launch: occupancy query says %d blocks/CU; nothing launched\n", per_cu); grid = -1; return; }
        grid = cus * 1;
        if (grid != 256) { fprintf(stderr, "kernel_launch: built for 256 CUs (got %d); nothing launched\n", cus); grid = -1; return; }
    }
    if (grid < 0) return;
    if (hipMemsetAsync(d_ws, 0, 32768 + (size_t)NT * 4, stream) != hipSuccess) { fprintf(stderr, "kernel_launch: memset failed\n"); return; }
    Args a{};
    for (int i = 0; i < 21; ++i) a.in[i] = d_in[i];
    a.out = (float*)d_out; a.ws = (unsigned char*)d_ws;
    void* args[] = {&a};
    hipError_t e = hipLaunchCooperativeKernel((const void*)mega_fwd, dim3(grid), dim3(NTHREADS), args, LDS_BYTES, stream);
    if (e != hipSuccess) fprintf(stderr, "cooperative launch failed: %s (grid %d)\n", hipGetErrorString(e), grid);
}
```
